# Optimizing an MI355X kernel written in HIP

```python
import jax, jax.numpy as jnp
from jax import lax
import numpy as np

D_MODEL = 4096
BATCH = 2
SEQ = 8192
DEPTH = 4

GRID_W = 64
N_MIXERS = 2
Q_BLOCK = 128
ROPE_THETA = 10000.0
EPS = 1e-6
D_FF = 3 * D_MODEL // 2
HEAD_DIM = 128
TOK_W = 3 * D_MODEL // 4
A_HEADS = TOK_W // HEAD_DIM
A_NOPE = HEAD_DIM
A_ROPE = 64
A_V = HEAD_DIM
A_Q_LORA = D_MODEL // 4
A_KV_LORA = D_MODEL // 8
B_HEADS = TOK_W // HEAD_DIM
B_KV_HEADS = B_HEADS // 4
B_HD = HEAD_DIM
MEM_TOKENS = 256
MEM_HEADS = 4
MEM_HD = D_MODEL // (4 * MEM_HEADS)
MEM_W = MEM_HEADS * MEM_HD
MIX_W = TOK_W + MEM_W
A_IN = A_Q_LORA + A_KV_LORA + A_ROPE + MEM_W
B_IN = B_HEADS * B_HD + 2 * B_KV_HEADS * B_HD + MEM_W
N_A = (DEPTH + N_MIXERS - 1) // N_MIXERS
N_B = DEPTH // N_MIXERS

kernel_name = "hybrid_mla_axial_gqa_macaron_memory"


def rms_norm(x, g):
    xf = x.astype(jnp.float32)
    y = xf * lax.rsqrt(jnp.mean(xf * xf, axis=-1, keepdims=True) + EPS)
    return (y * g.astype(jnp.float32)).astype(x.dtype)


def swiglu(x, w_gu, w_down):
    g, up = jnp.split(x @ w_gu, 2, axis=-1)
    return (jax.nn.silu(g) * up) @ w_down


def axial_rope_tables(seq_len, rot_dim):
    rows = seq_len // GRID_W
    row, col = jnp.meshgrid(jnp.arange(rows), jnp.arange(GRID_W), indexing="ij")
    row = row.reshape(-1).astype(jnp.float32)
    col = col.reshape(-1).astype(jnp.float32)
    axis_dim = rot_dim // 2
    inv_freq = ROPE_THETA ** (-jnp.arange(0, axis_dim, 2, dtype=jnp.float32) / axis_dim)
    ang = jnp.concatenate([row[:, None] * inv_freq, col[:, None] * inv_freq], axis=-1)
    return jnp.cos(ang), jnp.sin(ang)


def apply_rope(x, cos, sin):
    xf = x.astype(jnp.float32).reshape(x.shape[:-1] + (x.shape[-1] // 2, 2))
    x0, x1 = xf[..., 0], xf[..., 1]
    out = jnp.stack([x0 * cos - x1 * sin, x0 * sin + x1 * cos], axis=-1)
    return out.reshape(x.shape).astype(x.dtype)


def mla_attention(q_nope, q_pe, k_nope, k_pe, v):
    b, s, h, _ = q_nope.shape
    nb = s // Q_BLOCK
    qn = q_nope.reshape(b, nb, Q_BLOCK, h, A_NOPE).transpose(1, 0, 2, 3, 4)
    qp = q_pe.reshape(b, nb, Q_BLOCK, h, A_ROPE).transpose(1, 0, 2, 3, 4)
    scale = (A_NOPE + A_ROPE) ** -0.5

    def block(args):
        qn_b, qp_b = args
        sc = jnp.einsum("bqhd,bkhd->bhqk", qn_b, k_nope) + jnp.einsum("bqhr,bkr->bhqk", qp_b, k_pe)
        p = jax.nn.softmax(sc.astype(jnp.float32) * scale, axis=-1).astype(v.dtype)
        return jnp.einsum("bhqk,bkhd->bqhd", p, v)

    o = lax.map(block, (qn, qp))
    return o.transpose(1, 0, 2, 3, 4).reshape(b, s, h * A_V)


def gqa_attention(q, k, v):
    b, s, h, d = q.shape
    kvh = k.shape[2]
    g = h // kvh
    nb = s // Q_BLOCK
    qb = q.reshape(b, nb, Q_BLOCK, kvh, g, d).transpose(1, 0, 2, 3, 4, 5)
    scale = d ** -0.5

    def block(q_b):
        sc = jnp.einsum("bqkgd,bskd->bkgqs", q_b, k)
        p = jax.nn.softmax(sc.astype(jnp.float32) * scale, axis=-1).astype(v.dtype)
        return jnp.einsum("bkgqs,bskd->bqkgd", p, v)

    o = lax.map(block, qb)
    return o.transpose(1, 0, 2, 3, 4, 5).reshape(b, s, h * d)


def memory_attention(q, k, v):
    b, s = q.shape[:2]
    sc = jnp.einsum("bshd,bmhd->bhsm", q, k)
    p = jax.nn.softmax(sc.astype(jnp.float32) * (MEM_HD ** -0.5), axis=-1).astype(v.dtype)
    return jnp.einsum("bhsm,bmhd->bshd", p, v).reshape(b, s, MEM_W)


def mla_mixer(u, w_in, q_a_norm, kv_a_norm, w_q_b, w_kv_b,
              q_nope_norm, q_pe_norm, k_nope_norm, k_pe_norm, cos, sin):
    b, s, _ = u.shape
    proj = u @ w_in
    c_q, c_kv, k_pe, q_mem = jnp.split(
        proj, [A_Q_LORA, A_Q_LORA + A_KV_LORA, A_Q_LORA + A_KV_LORA + A_ROPE], axis=-1)
    q = (rms_norm(c_q, q_a_norm) @ w_q_b).reshape(b, s, A_HEADS, A_NOPE + A_ROPE)
    q_nope = rms_norm(q[..., :A_NOPE], q_nope_norm)
    q_pe = apply_rope(rms_norm(q[..., A_NOPE:], q_pe_norm), cos[:, None, :], sin[:, None, :])
    kv = (rms_norm(c_kv, kv_a_norm) @ w_kv_b).reshape(b, s, A_HEADS, A_NOPE + A_V)
    k_nope = rms_norm(kv[..., :A_NOPE], k_nope_norm)
    v = kv[..., A_NOPE:]
    k_pe = apply_rope(rms_norm(k_pe, k_pe_norm), cos, sin)
    return mla_attention(q_nope, q_pe, k_nope, k_pe, v), q_mem


def gqa_mixer(u, w_in, q_norm, k_norm, cos, sin):
    b, s, _ = u.shape
    proj = u @ w_in
    qw, kw = B_HEADS * B_HD, B_KV_HEADS * B_HD
    q, k, v, q_mem = jnp.split(proj, [qw, qw + kw, qw + 2 * kw], axis=-1)
    q = apply_rope(rms_norm(q.reshape(b, s, B_HEADS, B_HD), q_norm), cos[:, None, :], sin[:, None, :])
    k = apply_rope(rms_norm(k.reshape(b, s, B_KV_HEADS, B_HD), k_norm), cos[:, None, :], sin[:, None, :])
    v = v.reshape(b, s, B_KV_HEADS, B_HD)
    return gqa_attention(q, k, v), q_mem


def setup_inputs(seed: int = 0) -> dict:
    key = jax.random.key(seed)
    ks = jax.random.split(key, 26)
    f32 = jnp.float32

    def w(k, shape, fan_in):
        return jax.random.normal(k, shape, f32) * (fan_in ** -0.5)

    def g(k, shape):
        return 1.0 + 0.01 * jax.random.normal(k, shape, f32)

    return {
        "x": jax.random.normal(ks[0], (BATCH, SEQ, D_MODEL), f32),
        "mem": jax.random.normal(ks[1], (BATCH, MEM_TOKENS, D_MODEL), f32),
        "ffn1_norm": g(ks[2], (DEPTH, D_MODEL)),
        "ffn1_w_gu": w(ks[3], (DEPTH, D_MODEL, 2 * D_FF), D_MODEL),
        "ffn1_w_down": w(ks[4], (DEPTH, D_FF, D_MODEL), D_FF),
        "mix_norm": g(ks[5], (DEPTH, D_MODEL)),
        "w_o": w(ks[6], (DEPTH, MIX_W, D_MODEL), MIX_W),
        "mem_norm": g(ks[7], (DEPTH, D_MODEL)),
        "w_mem_kv": w(ks[8], (DEPTH, D_MODEL, 2 * MEM_W), D_MODEL),
        "mem_q_norm": g(ks[9], (DEPTH, MEM_HD)),
        "mem_k_norm": g(ks[10], (DEPTH, MEM_HD)),
        "ffn2_norm": g(ks[11], (DEPTH, D_MODEL)),
        "ffn2_w_gu": w(ks[12], (DEPTH, D_MODEL, 2 * D_FF), D_MODEL),
        "ffn2_w_down": w(ks[13], (DEPTH, D_FF, D_MODEL), D_FF),
        "a_w_in": w(ks[14], (N_A, D_MODEL, A_IN), D_MODEL),
        "a_q_a_norm": g(ks[15], (N_A, A_Q_LORA)),
        "a_kv_a_norm": g(ks[16], (N_A, A_KV_LORA)),
        "a_w_q_b": w(ks[17], (N_A, A_Q_LORA, A_HEADS * (A_NOPE + A_ROPE)), A_Q_LORA),
        "a_w_kv_b": w(ks[18], (N_A, A_KV_LORA, A_HEADS * (A_NOPE + A_V)), A_KV_LORA),
        "a_q_nope_norm": g(ks[19], (N_A, A_NOPE)),
        "a_q_pe_norm": g(ks[20], (N_A, A_ROPE)),
        "a_k_nope_norm": g(ks[21], (N_A, A_NOPE)),
        "a_k_pe_norm": g(ks[22], (N_A, A_ROPE)),
        "b_w_in": w(ks[23], (N_B, D_MODEL, B_IN), D_MODEL),
        "b_q_norm": g(ks[24], (N_B, B_HD)),
        "b_k_norm": g(ks[25], (N_B, B_HD)),
    }


def reference(x, mem, ffn1_norm, ffn1_w_gu, ffn1_w_down, mix_norm, w_o,
              mem_norm, w_mem_kv, mem_q_norm, mem_k_norm,
              ffn2_norm, ffn2_w_gu, ffn2_w_down,
              a_w_in, a_q_a_norm, a_kv_a_norm, a_w_q_b, a_w_kv_b,
              a_q_nope_norm, a_q_pe_norm, a_k_nope_norm, a_k_pe_norm,
              b_w_in, b_q_norm, b_k_norm):
    b, s, _ = x.shape
    m = mem.shape[1]
    cos_a, sin_a = axial_rope_tables(s, A_ROPE)
    cos_b, sin_b = axial_rope_tables(s, B_HD)
    for i in range(DEPTH):
        x = x + 0.5 * swiglu(rms_norm(x, ffn1_norm[i]), ffn1_w_gu[i], ffn1_w_down[i])
        u = rms_norm(x, mix_norm[i])
        j = i // N_MIXERS
        if i % N_MIXERS == 0:
            tok, q_mem = mla_mixer(u, a_w_in[j], a_q_a_norm[j], a_kv_a_norm[j], a_w_q_b[j], a_w_kv_b[j],
                                   a_q_nope_norm[j], a_q_pe_norm[j], a_k_nope_norm[j], a_k_pe_norm[j],
                                   cos_a, sin_a)
        else:
            tok, q_mem = gqa_mixer(u, b_w_in[j], b_q_norm[j], b_k_norm[j], cos_b, sin_b)
        mem_kv = (rms_norm(mem, mem_norm[i]) @ w_mem_kv[i]).reshape(b, m, 2, MEM_HEADS, MEM_HD)
        mk = rms_norm(mem_kv[:, :, 0], mem_k_norm[i])
        mv = mem_kv[:, :, 1]
        mq = rms_norm(q_mem.reshape(b, s, MEM_HEADS, MEM_HD), mem_q_norm[i])
        mo = memory_attention(mq, mk, mv)
        x = x + jnp.concatenate([tok, mo], axis=-1) @ w_o[i]
        x = x + 0.5 * swiglu(rms_norm(x, ffn2_norm[i]), ffn2_w_gu[i], ffn2_w_down[i])
    return x
```

```cpp
#include <hip/hip_runtime.h>
#include <hip/hip_bf16.h>
#include <cstdio>
#include <cstdint>
namespace pg8 {
#define PG8_LAS __attribute__((address_space(3)))
typedef unsigned short bf16_t;
typedef short bf16x8 __attribute__((ext_vector_type(8)));
typedef float f32x4 __attribute__((ext_vector_type(4)));
typedef unsigned u32x4 __attribute__((ext_vector_type(4)));
constexpr int BM = 256, BK = 64, HALF = 128, HTB = HALF * BK * 2  , STAGE_BYTES = 8 * HTB, NXCD = 8, WGM = 8;

__host__ __device__ __forceinline__ int lds_byte(int r, int c) { const int st = (r >> 4) * 2 + (c >> 5), rr = r & 15, cc = c & 31, ob = rr * 64 + cc * 2; return st * 1024 + (ob ^ (((ob >> 9) & 1) << 5)); }
__host__ __device__ __forceinline__ void stage_rc(int b, int& R, int& C) { const int st = b / 1024, sb = b % 1024, swz = sb ^ (((sb >> 9) & 1) << 5); R = (st >> 1) * 16 + swz / 64; C = (st & 1) * 32 + (swz % 64) / 2; }
__host__ __device__ __forceinline__ int perm32(int rho) { const int n = rho >> 4, i = rho & 15; return 8 * (i >> 2) + 4 * n + (i & 3); }

__device__ __forceinline__ int opq_tid() { int t = threadIdx.x; asm volatile("" : "+v"(t)); return t; }
struct Unit { int pm, pn; };
struct Gemm { const bf16_t* A; const bf16_t* Bt; int M, N, K; };

struct StaticOrder {
    int nM, nN, nwg, G, c;
    __host__ __device__ void init(int M, int N, int G_, int c_) { nM = M / BM; nN = N / BM; nwg = nM * nN; G = G_; c = c_; }
    __host__ __device__ bool next(int i, Unit& u) const {
        const long L = (long)i * G + c; if (L >= nwg) return false;
        int wgid = (int)L; { const int q = nwg / NXCD, r = nwg % NXCD, xcd = wgid % NXCD, off = wgid / NXCD; wgid = (xcd < r ? xcd * (q + 1) : r * (q + 1) + (xcd - r) * q) + off; }
        const int nig = WGM * nN, gid = wgid / nig, fm = gid * WGM, gsz = (nM - fm) < WGM ? (nM - fm) : WGM;
        u.pm = fm + ((wgid % nig) % gsz); u.pn = (wgid % nig) / gsz; return true;
    }
    __device__ __forceinline__ void a_ready(const Unit&) const {}
    __device__ __forceinline__ void done(const Unit&) const {}
};

__device__ __forceinline__ unsigned cvt_pk_bf16(float lo, float hi) { unsigned r; asm volatile("v_cvt_pk_bf16_f32 %0, %1, %2" : "=v"(r) : "v"(lo), "v"(hi)); return r; }
typedef float f32x2 __attribute__((ext_vector_type(2)));
struct EpiSwiGLU {
    static constexpr bool PERM = true, AFTER_DRAIN = false;
    bf16_t* H; int ldh;
    __device__ __forceinline__ void operator()(const f32x4 (&acc)[2][2][4][2], const Unit& u, int wr, int wc, int fr, int fq) const {
        const int row0 = u.pm * BM + wr * 64 + fr, col0 = u.pn * HALF + wc * 32 + 8 * fq;
#pragma unroll
        for (int ai = 0; ai < 2; ++ai)
#pragma unroll
            for (int m = 0; m < 4; ++m) { bf16_t* rowp = H + (size_t)(row0 + ai * HALF + m * 16) * ldh + col0;
                float h[8];
#pragma unroll
                for (int n = 0; n < 2; ++n)
#pragma unroll
                    for (int j = 0; j < 4; ++j) { const float g = acc[ai][0][m][n][j], up = acc[ai][1][m][n][j];
                        const float e = __builtin_amdgcn_exp2f(g * (-1.4426950408889634f)); h[n * 4 + j] = g * __builtin_amdgcn_rcpf(1.0f + e) * up; }
                u32x4 w; w.x = cvt_pk_bf16(h[0], h[1]); w.y = cvt_pk_bf16(h[2], h[3]); w.z = cvt_pk_bf16(h[4], h[5]); w.w = cvt_pk_bf16(h[6], h[7]);
                *(u32x4*)rowp = w; }
    }
};
struct EpiResid {
    static constexpr bool PERM = false, AFTER_DRAIN = false;
    const float* base; float* out; int ldc; float alpha;
    __device__ __forceinline__ void operator()(const f32x4 (&acc)[2][2][4][2], const Unit& u, int wr, int wc, int fr, int fq) const {
        const int row0 = u.pm * BM + wr * 64 + fr, col0 = u.pn * BM + wc * 32 + 4 * fq;
#pragma unroll
        for (int ai = 0; ai < 2; ++ai)
#pragma unroll
            for (int m = 0; m < 4; ++m) { const size_t off = (size_t)(row0 + ai * HALF + m * 16) * ldc + col0;
                f32x4 bs[2][2];
#pragma unroll
                for (int bj = 0; bj < 2; ++bj)
#pragma unroll
                    for (int n = 0; n < 2; ++n) bs[bj][n] = *(const f32x4*)(base + off + bj * HALF + n * 16);
#pragma unroll
                for (int bj = 0; bj < 2; ++bj)
#pragma unroll
                    for (int n = 0; n < 2; ++n) *(f32x4*)(out + off + bj * HALF + n * 16) = bs[bj][n] + acc[ai][bj][m][n] * alpha;
                if (m & 1) asm volatile("" ::: "memory"); }
    }
};
template <int T1, int T2, int T3, size_t O0, size_t O1, size_t O2, size_t O3, int L0, int L1, int L2, int L3> struct EpiBf16Seg {
    static constexpr bool PERM = true, AFTER_DRAIN = false;
    unsigned char* ws;
    __device__ __forceinline__ void operator()(const f32x4 (&acc)[2][2][4][2], const Unit& u, int wr, int wc, int fr, int fq) const {
        const int pn = u.pn;
        const size_t off = pn >= T3 ? O3 : (pn >= T2 ? O2 : (pn >= T1 ? O1 : O0));
        const int ts = pn >= T3 ? T3 : (pn >= T2 ? T2 : (pn >= T1 ? T1 : 0)), ldc = pn >= T3 ? L3 : (pn >= T2 ? L2 : (pn >= T1 ? L1 : L0));
        bf16_t* base = (bf16_t*)(ws + off);
        const int row0 = u.pm * BM + wr * 64 + fr, col0 = (pn - ts) * BM + wc * 32 + 8 * fq;
#pragma unroll
        for (int ai = 0; ai < 2; ++ai)
#pragma unroll
            for (int m = 0; m < 4; ++m) { bf16_t* rowp = base + (size_t)(row0 + ai * HALF + m * 16) * ldc + col0;
#pragma unroll
                for (int bj = 0; bj < 2; ++bj) { const f32x4 v0 = acc[ai][bj][m][0], v1 = acc[ai][bj][m][1];
                    u32x4 w; w.x = cvt_pk_bf16(v0[0], v0[1]); w.y = cvt_pk_bf16(v0[2], v0[3]); w.z = cvt_pk_bf16(v1[0], v1[1]); w.w = cvt_pk_bf16(v1[2], v1[3]);
                    *(u32x4*)(rowp + bj * HALF) = w; } }
    }
};
template <size_t O0, int L0> using EpiBf16One = EpiBf16Seg<(1 << 30), (1 << 30), (1 << 30), O0, 0, 0, 0, L0, 0, 0, 0>;

template <class Epi, class Sched, bool ALIGN_EPI = false, bool SP2 = false>
__device__ __forceinline__ void gemm_phase(PG8_LAS unsigned char* lds, const Gemm g, const Sched& S, const Epi& E) {
    const int tid = opq_tid(), wid = __builtin_amdgcn_readfirstlane(tid >> 6), lane = tid & 63, wr = wid >> 2, wc = wid & 3, fr = lane & 15, fq = lane >> 4;
    const int K = g.K, nt = K / BK;
    unsigned voffA[2], voffB[2];
#pragma unroll
    for (int i = 0; i < 2; ++i) { int R, C; stage_rc(tid * 16 + i * 8192, R, C); const int Rb = Epi::PERM ? ((R & ~31) + perm32(R & 31)) : R;
        voffA[i] = (unsigned)(R * K + C) * 2u; voffB[i] = (unsigned)(Rb * K + C) * 2u; }
    const size_t kstep = (size_t)(BK * 2);
    const size_t hstep = (size_t)HALF * K * 2;
    const size_t tstep = 2 * hstep;
    const unsigned ldsw = (unsigned)wid * 1024u;
    const int aoff = lds_byte(wr * 64 + fr, fq * 8), boff = lds_byte(wc * 32 + fr, fq * 8);
#define PG8_SA(b, h) (((b) * 2 + (h)) * HTB)
#define PG8_SB(b, h) ((4 + (b) * 2 + (h)) * HTB)
#define PG8_STAGE(bufoff, gbase, voff) do { _Pragma("unroll") for (int _i = 0; _i < 2; ++_i) \
        __builtin_amdgcn_global_load_lds((const unsigned*)((const char*)(gbase) + (voff)[_i]), (PG8_LAS unsigned*)(lds + (bufoff) + ldsw + _i * 8192), 16, 0, 0); } while (0)
#define PG8_LDA(dst, b, h) do { _Pragma("unroll") for (int m = 0; m < 4; ++m) _Pragma("unroll") for (int k = 0; k < 2; ++k) dst[m][k] = *(const PG8_LAS bf16x8*)(lds + PG8_SA(b, h) + aoff + m * 2048 + k * 1024); } while (0)
#define PG8_LDB(dst, b, h) do { _Pragma("unroll") for (int n = 0; n < 2; ++n) _Pragma("unroll") for (int k = 0; k < 2; ++k) dst[n][k] = *(const PG8_LAS bf16x8*)(lds + PG8_SB(b, h) + boff + n * 2048 + k * 1024); } while (0)
#define PG8_MMA(ai, bj, At, Bt) do { __builtin_amdgcn_s_setprio(1); _Pragma("unroll") for (int m = 0; m < 4; ++m) _Pragma("unroll") for (int n = 0; n < 2; ++n) _Pragma("unroll") for (int k = 0; k < 2; ++k) \
        acc[ai][bj][m][n] = __builtin_amdgcn_mfma_f32_16x16x32_bf16(Bt[n][k], At[m][k], acc[ai][bj][m][n], 0, 0, 0); __builtin_amdgcn_s_setprio(0); } while (0)
#define PG8_WAIT_V(n) asm volatile("s_waitcnt vmcnt(" #n ")" ::: "memory")
#define PG8_WAIT_L(n) asm volatile("s_waitcnt lgkmcnt(" #n ")" ::: "memory")
#define PG8_BAR __builtin_amdgcn_s_barrier()
#define PG8_SCHED __builtin_amdgcn_sched_barrier(0)
    Unit cur, nxt; int ui = 0;
    if (!S.next(0, cur)) return;
    f32x4 acc[2][2][4][2];
#pragma unroll
    for (int a = 0; a < 2; ++a)
#pragma unroll
        for (int b = 0; b < 2; ++b)
#pragma unroll
            for (int m = 0; m < 4; ++m)
#pragma unroll
                for (int n = 0; n < 2; ++n) acc[a][b][m][n] = (f32x4){0.f, 0.f, 0.f, 0.f};
    bf16x8 At[4][2], B0[2][2], B1[2][2];
    const char* cA = (const char*)g.A + (size_t)cur.pm * tstep; const char* cB = (const char*)g.Bt + (size_t)cur.pn * tstep;
    S.a_ready(cur);
    if constexpr (SP2) {
        PG8_STAGE(PG8_SB(0, 0), cB, voffB); PG8_STAGE(PG8_SB(0, 1), cB + hstep, voffB); PG8_STAGE(PG8_SA(0, 0), cA, voffA); PG8_STAGE(PG8_SA(0, 1), cA + hstep, voffA);
        if (wr == 1) PG8_BAR;
        PG8_WAIT_V(2); PG8_BAR;
        PG8_STAGE(PG8_SB(1, 0), cB + kstep, voffB); PG8_STAGE(PG8_SA(1, 0), cA + kstep, voffA); PG8_STAGE(PG8_SB(1, 1), cB + hstep + kstep, voffB);
        PG8_WAIT_V(6); PG8_BAR;
    } else {
        PG8_STAGE(PG8_SB(0, 0), cB, voffB); PG8_STAGE(PG8_SA(0, 0), cA, voffA); PG8_STAGE(PG8_SB(0, 1), cB + hstep, voffB); PG8_STAGE(PG8_SA(0, 1), cA + hstep, voffA);
        if (wr == 1) PG8_BAR;
        PG8_WAIT_V(4); PG8_BAR;
        PG8_STAGE(PG8_SB(1, 0), cB + kstep, voffB); PG8_STAGE(PG8_SA(1, 0), cA + kstep, voffA); PG8_STAGE(PG8_SB(1, 1), cB + hstep + kstep, voffB);
        PG8_WAIT_V(6); PG8_BAR;
    }
    for (;;) {
        const bool has_next = S.next(ui + 1, nxt);
        const char* nA = has_next ? (const char*)g.A + (size_t)nxt.pm * tstep : cA; const char* nB = has_next ? (const char*)g.Bt + (size_t)nxt.pn * tstep : cB;
        for (int t = 0; t < nt; t += 2) {
            const bool last = (t == nt - 2);
            const char* a1 = cA + (size_t)(t + 1) * kstep;
            const char* a2 = last ? nA : cA + (size_t)(t + 2) * kstep; const char* b2 = last ? nB : cB + (size_t)(t + 2) * kstep;
            const char* a3 = a2 + kstep; const char* b3 = b2 + kstep;
            if (last && has_next) S.a_ready(nxt);
            if constexpr (SP2) {
            PG8_LDB(B0, 0, 0); PG8_LDB(B1, 0, 1); PG8_SCHED; PG8_LDA(At, 0, 0); PG8_STAGE(PG8_SA(1, 1), a1 + hstep, voffA);
            PG8_WAIT_V(8); PG8_WAIT_L(0); PG8_BAR; PG8_MMA(0, 0, At, B0); PG8_MMA(0, 1, At, B1); PG8_BAR; PG8_SCHED;
            PG8_LDA(At, 0, 1); PG8_STAGE(PG8_SB(0, 0), b2, voffB); PG8_STAGE(PG8_SB(0, 1), b2 + hstep, voffB); PG8_STAGE(PG8_SA(0, 0), a2, voffA);
            PG8_WAIT_V(8); PG8_WAIT_L(0); PG8_BAR; PG8_MMA(1, 0, At, B0); PG8_MMA(1, 1, At, B1); PG8_BAR; PG8_SCHED;
            PG8_LDB(B0, 1, 0); PG8_LDB(B1, 1, 1); PG8_SCHED; PG8_LDA(At, 1, 0); PG8_STAGE(PG8_SA(0, 1), a2 + hstep, voffA);
            PG8_WAIT_V(8); PG8_WAIT_L(0); PG8_BAR; PG8_MMA(0, 0, At, B0); PG8_MMA(0, 1, At, B1); PG8_BAR; PG8_SCHED;
            PG8_LDA(At, 1, 1); PG8_STAGE(PG8_SB(1, 0), b3, voffB); PG8_STAGE(PG8_SB(1, 1), b3 + hstep, voffB); PG8_STAGE(PG8_SA(1, 0), a3, voffA);
            PG8_WAIT_V(8); PG8_WAIT_L(0); PG8_BAR; PG8_MMA(1, 0, At, B0); PG8_MMA(1, 1, At, B1); PG8_BAR; PG8_SCHED;
            } else {
            PG8_LDB(B0, 0, 0); PG8_SCHED; PG8_LDA(At, 0, 0); PG8_STAGE(PG8_SA(1, 1), a1 + hstep, voffA);
            PG8_WAIT_L(8); PG8_BAR; PG8_WAIT_L(0); PG8_MMA(0, 0, At, B0); PG8_BAR; PG8_SCHED;
            PG8_LDB(B1, 0, 1); PG8_STAGE(PG8_SB(0, 0), b2, voffB);
            PG8_BAR; PG8_WAIT_L(0); PG8_MMA(0, 1, At, B1); PG8_BAR;
            PG8_LDA(At, 0, 1); PG8_STAGE(PG8_SA(0, 0), a2, voffA);
            PG8_BAR; PG8_WAIT_L(0); PG8_MMA(1, 0, At, B0); PG8_BAR; PG8_SCHED;
            PG8_STAGE(PG8_SB(0, 1), b2 + hstep, voffB);
            PG8_WAIT_V(6); PG8_BAR; PG8_MMA(1, 1, At, B1); PG8_BAR;
            PG8_LDB(B0, 1, 0); PG8_SCHED; PG8_LDA(At, 1, 0); PG8_STAGE(PG8_SA(0, 1), a2 + hstep, voffA);
            PG8_WAIT_L(8); PG8_BAR; PG8_WAIT_L(0); PG8_MMA(0, 0, At, B0); PG8_BAR; PG8_SCHED;
            PG8_LDB(B1, 1, 1); PG8_STAGE(PG8_SB(1, 0), b3, voffB);
            PG8_BAR; PG8_WAIT_L(0); PG8_MMA(0, 1, At, B1); PG8_BAR;
            PG8_LDA(At, 1, 1); PG8_STAGE(PG8_SA(1, 0), a3, voffA);
            PG8_BAR; PG8_WAIT_L(0); PG8_MMA(1, 0, At, B0); PG8_BAR; PG8_SCHED;
            PG8_STAGE(PG8_SB(1, 1), b3 + hstep, voffB);
            PG8_WAIT_V(6); PG8_BAR; PG8_MMA(1, 1, At, B1); PG8_BAR;
            }
        }
        if constexpr (ALIGN_EPI) { if (wr == 0) PG8_BAR; }
        if constexpr (!Epi::AFTER_DRAIN) { E(acc, cur, wr, wc, fr, fq); S.done(cur); }
        if (!has_next) break;
#pragma unroll
        for (int a = 0; a < 2; ++a)
#pragma unroll
            for (int b = 0; b < 2; ++b)
#pragma unroll
                for (int m = 0; m < 4; ++m)
#pragma unroll
                    for (int n = 0; n < 2; ++n) acc[a][b][m][n] = (f32x4){0.f, 0.f, 0.f, 0.f};
        cur = nxt; cA = nA; cB = nB; ++ui;
        if constexpr (ALIGN_EPI) { if (wr == 1) PG8_BAR; }
    }
    PG8_WAIT_V(0);
    if constexpr (!ALIGN_EPI) { if (wr == 0) PG8_BAR; }
    PG8_BAR;
    if constexpr (Epi::AFTER_DRAIN) { E.fused(acc, cur, wr, wc, fr, fq, lds, wid, lane); S.done(cur); }
#undef PG8_SA
#undef PG8_SB
#undef PG8_STAGE
#undef PG8_LDA
#undef PG8_LDB
#undef PG8_MMA
#undef PG8_WAIT_V
#undef PG8_WAIT_L
#undef PG8_BAR
#undef PG8_SCHED
}
}
namespace att {
using bf16x8 = __attribute__((ext_vector_type(8))) short;
using s16x4  = __attribute__((ext_vector_type(4))) short;
using f32x16 = __attribute__((ext_vector_type(16))) float;
using f32x4  = __attribute__((ext_vector_type(4))) float;
using u32x4  = __attribute__((ext_vector_type(4))) unsigned;
typedef unsigned short bf16_t;
constexpr int NW = 8, QBLK = 32, KVBLK = 64, DV = 128;
constexpr float THR = 8.f;
constexpr int SHM_V = KVBLK * DV * 2;
template <int DQK> struct Cfg { static constexpr int KROW = DQK * 2 + 16  , SHM_K = KVBLK * KROW, NKC = DQK / 64, LDS_BYTES = 2 * SHM_V + 2 * SHM_K + NW * 64 * 4;
    static constexpr float SCALE = DQK == 128 ? 0.088388347648318440f : 0.072168783648703220f; };
#define SBAR() __builtin_amdgcn_sched_barrier(0)
__device__ __forceinline__ int crow(int r, int hi) { return (r & 3) + 8 * (r >> 2) + 4 * hi; }
__device__ __forceinline__ unsigned cvtpk(float lo, float hi) { unsigned r; asm volatile("v_cvt_pk_bf16_f32 %0, %1, %2" : "=v"(r) : "v"(lo), "v"(hi)); return r; }
__device__ __forceinline__ float bf2f(short s) { return __uint_as_float(((unsigned)(unsigned short)s) << 16); }
template <int DQK> __device__ __forceinline__ int kswz(int row, int colB) { return row * Cfg<DQK>::KROW + colB; }

template <int DQK> __device__ __forceinline__ void partialSM(f32x16& p0, f32x16& p1, float& m_reg, float& mn, float& alpha) {
  constexpr float SCALE = Cfg<DQK>::SCALE, C = SCALE * 1.4426950408889634f;
  float pmax = p0[0];
#pragma unroll
  for (int r = 1; r < 16; ++r) pmax = fmaxf(pmax, p0[r]);
#pragma unroll
  for (int r = 0; r < 16; ++r) pmax = fmaxf(pmax, p1[r]);
  { auto rr = __builtin_amdgcn_permlane32_swap(__float_as_uint(pmax), __float_as_uint(pmax), false, false);
    pmax = fmaxf(__uint_as_float(rr[0]), __uint_as_float(rr[1])); }
  if (__builtin_expect(__all(pmax - m_reg <= THR / SCALE), 1)) { mn = m_reg; alpha = 1.f; }
  else { mn = fmaxf(m_reg, pmax); alpha = __builtin_amdgcn_exp2f((m_reg - mn) * C); m_reg = mn; }
  const float mnC = -mn * C;
#pragma unroll
  for (int r = 0; r < 16; ++r) p0[r] = fmaf(p0[r], C, mnC);
#pragma unroll
  for (int r = 0; r < 16; ++r) p1[r] = fmaf(p1[r], C, mnC);
#pragma unroll
  for (int r = 0; r < 16; ++r) p0[r] = __builtin_amdgcn_exp2f(p0[r]);
}
#define ATT_PK4(P, BASE, OUT) do { unsigned a0 = cvtpk(P[BASE + 0], P[BASE + 1]), a1 = cvtpk(P[BASE + 2], P[BASE + 3]);   \
    unsigned b0 = cvtpk(P[BASE + 4], P[BASE + 5]), b1 = cvtpk(P[BASE + 6], P[BASE + 7]);                              \
    auto r0 = __builtin_amdgcn_permlane32_swap(a0, b0, false, false); auto r1 = __builtin_amdgcn_permlane32_swap(a1, b1, false, false); \
    u32x4 w = {r0[0], r1[0], r0[1], r1[1]}; OUT = __builtin_bit_cast(bf16x8, w); } while (0)
__device__ __forceinline__ void finishSM(f32x16& p0, f32x16& p1, float alpha, float& l_reg, bf16x8& pa0, bf16x8& pa1, bf16x8& pa2, bf16x8& pa3) {
#pragma unroll
  for (int r = 0; r < 16; ++r) p1[r] = __builtin_amdgcn_exp2f(p1[r]);
  float ps = 0;
#pragma unroll
  for (int r = 0; r < 16; ++r) ps += p0[r];
#pragma unroll
  for (int r = 0; r < 16; ++r) ps += p1[r];
  { auto rr = __builtin_amdgcn_permlane32_swap(__float_as_uint(ps), __float_as_uint(ps), false, false);
    ps = __uint_as_float(rr[0]) + __uint_as_float(rr[1]); }
  l_reg = l_reg * alpha + ps;
  ATT_PK4(p0, 0, pa0); ATT_PK4(p0, 8, pa1); ATT_PK4(p1, 0, pa2); ATT_PK4(p1, 8, pa3);
}
template <int DQK> __device__ __forceinline__ void qkt(f32x16& p0, f32x16& p1, const char* Ks, const bf16x8 (&qr)[DQK / 16], int r32, int hi) {
  p0 = f32x16{}; p1 = f32x16{};
#pragma unroll
  for (int d0 = 0; d0 < DQK / 16; ++d0) { const int cb = (d0 * 16 + hi * 8) * 2;
    const bf16x8 b0 = *reinterpret_cast<const bf16x8*>(Ks + kswz<DQK>(r32, cb));
    const bf16x8 b1 = *reinterpret_cast<const bf16x8*>(Ks + kswz<DQK>(32 + r32, cb));
    p0 = __builtin_amdgcn_mfma_f32_32x32x16_bf16(b0, qr[d0], p0, 0, 0, 0);
    p1 = __builtin_amdgcn_mfma_f32_32x32x16_bf16(b1, qr[d0], p1, 0, 0, 0); }
}
__device__ __forceinline__ int v_st(int k, int c) { const int kk = (k & ~0xC) | ((k & 4) << 1) | ((k & 8) >> 1); return ((kk >> 3) * 4 + (c >> 5)) * 512 + ((kk & 7) * 32 + (c & 31)) * 2; }
__device__ __forceinline__ int v_rd_base(int lane) { return ((lane & 3) << 3) | (((lane >> 2) & 3) << 6) | (((lane >> 4) & 1) << 5) | (((lane >> 5) & 1) << 8); }
constexpr int v_rd_off(int d0, int ks, int half) { return d0 * 512 + ks * 4096 + half * 2048; }
template <int OFF> __device__ __forceinline__ s16x4 tr_read(int vb) { s16x4 r; asm volatile("ds_read_b64_tr_b16 %0, %1 offset:%2" : "=&v"(r) : "v"(vb), "i"(OFF) : "memory"); return r; }
template <int D0> __device__ __forceinline__ void pv_one(f32x16& od, int vb, bf16x8 pa0, bf16x8 pa1, bf16x8 pa2, bf16x8 pa3) {
  const s16x4 l0 = tr_read<v_rd_off(D0, 0, 0)>(vb), h0 = tr_read<v_rd_off(D0, 0, 1)>(vb), l1 = tr_read<v_rd_off(D0, 1, 0)>(vb), h1 = tr_read<v_rd_off(D0, 1, 1)>(vb);
  const s16x4 l2 = tr_read<v_rd_off(D0, 2, 0)>(vb), h2 = tr_read<v_rd_off(D0, 2, 1)>(vb), l3 = tr_read<v_rd_off(D0, 3, 0)>(vb), h3 = tr_read<v_rd_off(D0, 3, 1)>(vb);
  asm volatile("s_waitcnt lgkmcnt(0)" ::: "memory"); SBAR();
#define ATT_PK(L, H) (bf16x8){L[0], L[1], L[2], L[3], H[0], H[1], H[2], H[3]}
  od = __builtin_amdgcn_mfma_f32_32x32x16_bf16(pa0, ATT_PK(l0, h0), od, 0, 0, 0);
  od = __builtin_amdgcn_mfma_f32_32x32x16_bf16(pa1, ATT_PK(l1, h1), od, 0, 0, 0);
  od = __builtin_amdgcn_mfma_f32_32x32x16_bf16(pa2, ATT_PK(l2, h2), od, 0, 0, 0);
  od = __builtin_amdgcn_mfma_f32_32x32x16_bf16(pa3, ATT_PK(l3, h3), od, 0, 0, 0);
#undef ATT_PK
}
__device__ __forceinline__ void pv_d0(f32x16* o, int vb, bf16x8 pa0, bf16x8 pa1, bf16x8 pa2, bf16x8 pa3) {
  pv_one<0>(o[0], vb, pa0, pa1, pa2, pa3); pv_one<1>(o[1], vb, pa0, pa1, pa2, pa3); pv_one<2>(o[2], vb, pa0, pa1, pa2, pa3); pv_one<3>(o[3], vb, pa0, pa1, pa2, pa3);
}
template <int DQK, int SDEPTH>
__device__ __forceinline__ void attn_unit(const bf16x8 (&qr)[DQK / 16], const bf16_t* __restrict__ Kh, int ldk, const bf16_t* __restrict__ Vh, int ldv,
                                          bf16_t* __restrict__ Ob, int ldo, int seq, char* lds) {
  using C = Cfg<DQK>; constexpr int SHM_K = C::SHM_K, NKC = C::NKC, CPR = DQK / 8;
  const int tid = pg8::opq_tid(), wid = tid >> 6, lane = tid & 63, r32 = lane & 31, hi = lane >> 5;
  char* V_lds = lds; char* K_lds = lds + 2 * SHM_V;
  float* ws = (float*)(lds + 2 * SHM_V + 2 * SHM_K) + wid * 64; float* li_l = ws; float* al_l = ws + 32;
  float m_reg = -1e30f, l_reg = 0; f32x16 o[4] = {};
  const int srow = tid >> 3, sch = tid & 7;
  const unsigned koff = (unsigned)(srow * ldk + sch * 8) * 2u, voff = (unsigned)(srow * ldv + sch * 8) * 2u;
  const int kdst = kswz<DQK>(srow, sch * 16), vdst = v_st(srow, sch * 8);
  const int vb0 = (int)(uintptr_t)V_lds + v_rd_base(lane);
  struct { bf16x8 vs[2], ks[NKC]; } sr_[SDEPTH];
#define ATT_LD8(p) (*reinterpret_cast<const bf16x8*>(p))
#define SLOAD(i, k0) do { const char* vg_ = (const char*)Vh + (size_t)(k0) * ldv * 2; const char* kg_ = (const char*)Kh + (size_t)(k0) * ldk * 2; \
    _Pragma("unroll") for (int q_ = 0; q_ < 2; ++q_) sr_[i].vs[q_] = ATT_LD8(vg_ + voff + q_ * 128); \
    _Pragma("unroll") for (int q_ = 0; q_ < NKC; ++q_) sr_[i].ks[q_] = ATT_LD8(kg_ + koff + q_ * 128); } while (0)
#define SWRITE(b, i) do { _Pragma("unroll") for (int q_ = 0; q_ < 2; ++q_) *(bf16x8*)(V_lds + (b) * SHM_V + vdst + q_ * 1024) = sr_[i].vs[q_]; \
    _Pragma("unroll") for (int q_ = 0; q_ < NKC; ++q_) *(bf16x8*)(K_lds + (b) * SHM_K + kdst + q_ * 128) = sr_[i].ks[q_]; } while (0)
#define SWAIT() do { if constexpr (SDEPTH == 1) asm volatile("s_waitcnt vmcnt(0)" ::: "memory"); else if constexpr (NKC == 2) asm volatile("s_waitcnt vmcnt(4)" ::: "memory"); else asm volatile("s_waitcnt vmcnt(5)" ::: "memory"); } while (0)
#define RESC(a) do { if (__any((a) < 1.f)) { if (hi == 0) al_l[r32] = (a); asm volatile("s_waitcnt lgkmcnt(0)" ::: "memory"); \
    _Pragma("unroll") for (int d = 0; d < 4; ++d) _Pragma("unroll") for (int r = 0; r < 16; ++r) o[d][r] *= al_l[crow(r, hi)]; } } while (0)
  f32x16 pA0, pA1, pB0, pB1; float mnA, mnB, alA, alB; bf16x8 pa0, pa1, pa2, pa3; const int NT = seq / KVBLK;
  constexpr int SE = 0, SO = SDEPTH - 1;
  SLOAD(SE, 0); asm volatile("s_waitcnt vmcnt(0)" ::: "memory"); SWRITE(0, SE); __syncthreads();
  qkt<DQK>(pA0, pA1, K_lds, qr, r32, hi); partialSM<DQK>(pA0, pA1, m_reg, mnA, alA);
  SLOAD(SO, KVBLK); if constexpr (SDEPTH == 2) { if (2 < NT) SLOAD(SE, 2 * KVBLK); }
  SWAIT(); SWRITE(1, SO); __syncthreads();
  for (int j = 1; j + 1 < NT; j += 2) {
    SBAR(); qkt<DQK>(pB0, pB1, K_lds + SHM_K, qr, r32, hi);
    finishSM(pA0, pA1, alA, l_reg, pa0, pa1, pa2, pa3); SBAR();
    SLOAD(SO, (j + SDEPTH) * KVBLK); SBAR();
    pv_d0(o, vb0, pa0, pa1, pa2, pa3); partialSM<DQK>(pB0, pB1, m_reg, mnB, alB);
    __syncthreads(); SWAIT(); SWRITE(0, SE);
    RESC(alB); __syncthreads();
    SBAR(); qkt<DQK>(pA0, pA1, K_lds, qr, r32, hi);
    finishSM(pB0, pB1, alB, l_reg, pa0, pa1, pa2, pa3); SBAR();
    if (SDEPTH == 1 || j + 3 < NT) SLOAD(SE, (j + 1 + SDEPTH) * KVBLK); SBAR();
    pv_d0(o, vb0 + SHM_V, pa0, pa1, pa2, pa3); partialSM<DQK>(pA0, pA1, m_reg, mnA, alA);
    __syncthreads(); SWAIT(); SWRITE(1, SO);
    RESC(alA); __syncthreads();
  }
  SBAR(); qkt<DQK>(pB0, pB1, K_lds + SHM_K, qr, r32, hi);
  finishSM(pA0, pA1, alA, l_reg, pa0, pa1, pa2, pa3); SBAR();
  pv_d0(o, vb0, pa0, pa1, pa2, pa3); partialSM<DQK>(pB0, pB1, m_reg, mnB, alB);
  __syncthreads(); RESC(alB);
  finishSM(pB0, pB1, alB, l_reg, pa0, pa1, pa2, pa3); SBAR();
  pv_d0(o, vb0 + SHM_V, pa0, pa1, pa2, pa3);
  if (hi == 0) li_l[r32] = l_reg; asm volatile("s_waitcnt lgkmcnt(0)" ::: "memory");
  float rli[16];
#pragma unroll
  for (int r = 0; r < 16; ++r) rli[r] = __builtin_amdgcn_rcpf(li_l[crow(r, hi)]);
  bf16_t* Ow = Ob + (long)(wid * QBLK) * ldo;
#pragma unroll
  for (int r = 0; r < 16; ++r) { const int orow = crow(r, hi);
#pragma unroll
    for (int d0 = 0; d0 < 4; ++d0) Ow[(long)orow * ldo + d0 * 32 + r32] = (bf16_t)(cvtpk(o[d0][r] * rli[r], 0.f) & 0xffffu); }
#undef SLOAD
#undef SWRITE
#undef SWAIT
#undef RESC
#undef ATT_LD8
}

constexpr int MROW = 528, MEM_LDS_BYTES = 256 * MROW;
__device__ __forceinline__ void mem_attn_unit(const bf16_t* __restrict__ Qb, int ldq, const float* __restrict__ gq, float eps, const bf16_t* __restrict__ Kt, int ldk, const bf16_t* __restrict__ VT,
                                              bf16_t* __restrict__ Ob, int ldo, char* lds, float* wsl) {
  const int tid = pg8::opq_tid(), wid = tid >> 6, lane = tid & 63, r32 = lane & 31, hi = lane >> 5;
  const bf16_t* qp = Qb + (long)(wid * QBLK + r32) * ldq + hi * 8;
  float ss = 0.f;
#pragma unroll
  for (int d0 = 0; d0 < 16; ++d0) { const bf16x8 q = *reinterpret_cast<const bf16x8*>(qp + d0 * 16);
#pragma unroll
    for (int e = 0; e < 8; ++e) { const float f = bf2f(q[e]); ss += f * f; } }
  { auto rr = __builtin_amdgcn_permlane32_swap(__float_as_uint(ss), __float_as_uint(ss), false, false); ss = __uint_as_float(rr[0]) + __uint_as_float(rr[1]); }
  const float rstd = 1.0f / sqrtf(ss * (1.0f / 256.0f) + eps);
  { const int srow = tid >> 5, sch = tid & 31;
#pragma unroll 4
    for (int i = 0; i < 16; ++i) *(bf16x8*)(lds + (srow + 16 * i) * MROW + sch * 16) = *reinterpret_cast<const bf16x8*>(Kt + (long)(srow + 16 * i) * ldk + sch * 8); }
  __syncthreads();
  f32x16 s[8];
#pragma unroll
  for (int kb = 0; kb < 8; ++kb) s[kb] = f32x16{};
  const char* rd = lds + r32 * MROW + hi * 16;
#pragma unroll
  for (int d0 = 0; d0 < 16; ++d0) {
    const bf16x8 qraw = *reinterpret_cast<const bf16x8*>(qp + d0 * 16);
    const f32x4 g0 = *(const f32x4*)(gq + d0 * 16 + hi * 8), g1 = *(const f32x4*)(gq + d0 * 16 + hi * 8 + 4);
    float x[8];
#pragma unroll
    for (int e = 0; e < 4; ++e) { x[e] = bf2f(qraw[e]) * rstd * g0[e]; x[4 + e] = bf2f(qraw[4 + e]) * rstd * g1[e]; }
    const u32x4 w = {cvtpk(x[0], x[1]), cvtpk(x[2], x[3]), cvtpk(x[4], x[5]), cvtpk(x[6], x[7])}; const bf16x8 qf = __builtin_bit_cast(bf16x8, w);
#pragma unroll
    for (int kb = 0; kb < 8; ++kb) { const bf16x8 kf = *reinterpret_cast<const bf16x8*>(rd + kb * 32 * MROW + d0 * 32); s[kb] = __builtin_amdgcn_mfma_f32_32x32x16_bf16(kf, qf, s[kb], 0, 0, 0); } }
  constexpr float C = 0.0625f * 1.4426950408889634f;
  float mx = s[0][0];
#pragma unroll
  for (int kb = 0; kb < 8; ++kb)
#pragma unroll
    for (int r = 0; r < 16; ++r) mx = fmaxf(mx, s[kb][r]);
  { auto rr = __builtin_amdgcn_permlane32_swap(__float_as_uint(mx), __float_as_uint(mx), false, false); mx = fmaxf(__uint_as_float(rr[0]), __uint_as_float(rr[1])); }
  const float mC = -mx * C; float ps = 0.f;
#pragma unroll
  for (int kb = 0; kb < 8; ++kb)
#pragma unroll
    for (int r = 0; r < 16; ++r) { s[kb][r] = __builtin_amdgcn_exp2f(fmaf(s[kb][r], C, mC)); ps += s[kb][r]; }
  { auto rr = __builtin_amdgcn_permlane32_swap(__float_as_uint(ps), __float_as_uint(ps), false, false); ps = __uint_as_float(rr[0]) + __uint_as_float(rr[1]); }
  bf16x8 pa[16];
#pragma unroll
  for (int kb = 0; kb < 8; ++kb) { ATT_PK4(s[kb], 0, pa[2 * kb]); ATT_PK4(s[kb], 8, pa[2 * kb + 1]); }
  __syncthreads();
  { const int srow = tid >> 5, sch = tid & 31;
#pragma unroll 4
    for (int i = 0; i < 16; ++i) *(bf16x8*)(lds + (srow + 16 * i) * MROW + sch * 16) = *reinterpret_cast<const bf16x8*>(VT + (long)(srow + 16 * i) * 256 + sch * 8); }
  __syncthreads();
  float* li_l = wsl + wid * 64;
  if (hi == 0) li_l[r32] = ps; asm volatile("s_waitcnt lgkmcnt(0)" ::: "memory");
  bf16_t* Ow = Ob + (long)(wid * QBLK) * ldo;
#pragma unroll
  for (int half = 0; half < 2; ++half) {
    f32x16 o[4];
#pragma unroll
    for (int c = 0; c < 4; ++c) o[c] = f32x16{};
#pragma unroll
    for (int ks = 0; ks < 16; ++ks)
#pragma unroll
      for (int c = 0; c < 4; ++c) { const bf16x8 vf = *reinterpret_cast<const bf16x8*>(rd + (half * 4 + c) * 32 * MROW + ks * 32); o[c] = __builtin_amdgcn_mfma_f32_32x32x16_bf16(pa[ks], vf, o[c], 0, 0, 0); }
#pragma unroll
    for (int r = 0; r < 16; ++r) { const int orow = crow(r, hi); const float rl = __builtin_amdgcn_rcpf(li_l[orow]);
#pragma unroll
      for (int c = 0; c < 4; ++c) Ow[(long)orow * ldo + (half * 4 + c) * 32 + r32] = (bf16_t)(cvtpk(o[c][r] * rl, 0.f) & 0xffffu); } }
  __syncthreads();
}
#undef SBAR
#undef ATT_PK4
}

#define GAS __attribute__((address_space(1)))
#define LAS __attribute__((address_space(3)))
typedef unsigned short bf16;
typedef unsigned v4u __attribute__((ext_vector_type(4)));
typedef float f32x4 __attribute__((ext_vector_type(4)));
typedef short bf16x8 __attribute__((ext_vector_type(8)));
typedef GAS unsigned gu32;
typedef GAS unsigned long long gu64;
#define RLX_AGENT __ATOMIC_RELAXED, __HIP_MEMORY_SCOPE_AGENT
#define LDS_WAIT() asm volatile("s_waitcnt lgkmcnt(0)" ::: "memory")
#define VM_WAIT() asm volatile("s_waitcnt vmcnt(0)" ::: "memory")
__device__ __forceinline__ unsigned long long rt() { return __builtin_amdgcn_s_memrealtime(); }
__device__ __forceinline__ unsigned f2bf(float f) { unsigned u = __builtin_bit_cast(unsigned, f); return (u + 0x7fffu + ((u >> 16) & 1u)) >> 16; }
__device__ __forceinline__ unsigned pk2(float lo, float hi) { return f2bf(lo) | (f2bf(hi) << 16); }

#define XB_TMO      128
#define XB_XCNT(j)  (256  + 64 * (j))
#define XB_XSUB(j)  (1280 + 64 * (j))
#define XB_XGEN(j)  (2304 + 64 * (j))
#define XB_TOP      3328
#define XB_TOPGEN   3392
#define XCD_BAR_WORDS 3456
#define XB_SPIN_CAP (1u << 18)

__device__ __forceinline__ unsigned xb_ld(unsigned* p)              { return __hip_atomic_load(p, __ATOMIC_RELAXED, __HIP_MEMORY_SCOPE_AGENT); }
__device__ __forceinline__ unsigned xb_add(unsigned* p, unsigned v) { return __hip_atomic_fetch_add(p, v, __ATOMIC_RELAXED, __HIP_MEMORY_SCOPE_AGENT); }
__device__ __forceinline__ unsigned xb_xcc_id() { return (unsigned)__builtin_amdgcn_s_getreg((3 << 11) | 20) & 0xFu; }
#define XB_SPIN(cond, bar) do { unsigned _sp = 0; while (cond) { __builtin_amdgcn_s_sleep(1); \
    if ((++_sp & 255u) == 0u) { if (xb_ld(&(bar)[XB_TMO])) break; if (_sp > XB_SPIN_CAP) { atomicAdd(&(bar)[XB_TMO], 1u); break; } } } } while (0)

struct XcdBarrier {
    unsigned* bar; unsigned x;
    volatile LAS unsigned* st;
};

__device__ __forceinline__ XcdBarrier xcd_barrier_post(unsigned* bar, volatile LAS unsigned* st) {
    XcdBarrier b; b.bar = bar; b.x = xb_xcc_id(); b.st = st;
    if (threadIdx.x == 0) (void)xb_add(&bar[XB_XCNT(b.x)], 1u);
    return b;
}
__device__ __forceinline__ void xcd_barrier_complete(unsigned* bar, unsigned x, unsigned& nloc, unsigned& nx) {
    const unsigned G = gridDim.x * gridDim.y * gridDim.z;
    unsigned sum, cnt, mine, sp = 0u;
    for (;;) {
        sum = 0u; cnt = 0u; mine = 0u;
#pragma unroll
        for (unsigned j = 0; j < 16; ++j) { const unsigned c = xb_ld(&bar[XB_XCNT(j)]); sum += c; cnt += (c > 0u) ? 1u : 0u; mine = (j == x) ? c : mine; }
        if (sum == G) break;
        __builtin_amdgcn_s_sleep(1);
        if ((++sp & 255u) == 0u) { if (xb_ld(&bar[XB_TMO])) break; if (sp > XB_SPIN_CAP) { atomicAdd(&bar[XB_TMO], 1u); break; } }
    }
    nloc = mine > 0u ? mine : 1u; nx = cnt > 0u ? cnt : 1u;
}

__device__ __forceinline__ void xcd_barrier(const XcdBarrier& b) {
    asm volatile("s_waitcnt vmcnt(0)" ::: "memory");
    __syncthreads();
    if (threadIdx.x == 0) {
        unsigned* bar = b.bar;
        __builtin_amdgcn_s_waitcnt(0);
        unsigned nloc = b.st[0], nx = b.st[1];
        if (nloc == 0u) { xcd_barrier_complete(bar, b.x, nloc, nx); b.st[0] = nloc; b.st[1] = nx; }
        const unsigned old = xb_add(&bar[XB_XSUB(b.x)], 1u);
        const unsigned gen = old / nloc;
        if (old + 1u == (gen + 1u) * nloc) {
            __builtin_amdgcn_fence(__ATOMIC_RELEASE, "agent");
            asm volatile("s_waitcnt vmcnt(0)" ::: "memory");
            const unsigned og = xb_add(&bar[XB_TOP], 1u);
            const unsigned tg = og / nx;
            if (og + 1u == (tg + 1u) * nx) xb_add(&bar[XB_TOPGEN], 1u);
            else XB_SPIN(xb_ld(&bar[XB_TOPGEN]) == tg, bar);
            __builtin_amdgcn_fence(__ATOMIC_ACQUIRE, "agent");
            xb_add(&bar[XB_XGEN(b.x)], 1u);
            asm volatile("s_waitcnt vmcnt(0)" ::: "memory");
        } else {
            XB_SPIN(xb_ld(&bar[XB_XGEN(b.x)]) == gen, bar);
            __builtin_amdgcn_fence(__ATOMIC_ACQUIRE, "agent");
            asm volatile("s_waitcnt vmcnt(0)" ::: "memory");
        }
    }
    __syncthreads();
}
constexpr int NWAVES = 8;
constexpr int BATCH = 2, SEQ = 8192, DM = 4096, DFF = 6144, DEPTH = 4, M = BATCH * SEQ;
constexpr int MEMT = 256, MEMR = BATCH * MEMT;
constexpr int NH = 24, HD = 128, TOKW = 3072, MEMW = 1024, MEMHD = 256;
constexpr int A_QL = 1024, A_KVL = 512, A_ROPE = 64, A_IN = 2624, A_INP = 2816, A_QBN = 4608, A_KVBN = 6144, A_KW = NH * 192;
constexpr int B_IN = 5632, B_KVH = 6, B_KW = B_KVH * HD;
constexpr float EPS = 1e-6f;

constexpr size_t MiB = 1u << 20;
constexpr size_t CTL_ZERO_BYTES = 1 * MiB;
constexpr size_t WS_CTL = 0;
constexpr size_t WS_ROPE = 1 * MiB;
constexpr size_t WS_COSA = WS_ROPE, WS_SINA = WS_ROPE + 1 * MiB, WS_COSB = WS_ROPE + 2 * MiB, WS_SINB = WS_ROPE + 4 * MiB;
constexpr size_t WS_PAR = 7 * MiB;
constexpr int PAR_MQ = 0, PAR_QN = 1024, PAR_QP = 1280, PAR_KN = 1408, PAR_KP = 1664, PAR_BQ = 1792, PAR_BK = 2048, PAR_N = 2304;
constexpr size_t WS_W = 8 * MiB;
constexpr size_t SZ_GU = (size_t)2 * DFF * DM * 2, SZ_DN = (size_t)DM * DFF * 2, SZ_WO = (size_t)DM * DM * 2;
constexpr size_t SZ_LAYER = 2 * SZ_GU + 2 * SZ_DN + SZ_WO;
constexpr size_t OFF_GU1 = 0, OFF_DN1 = SZ_GU, OFF_GU2 = SZ_GU + SZ_DN, OFF_DN2 = 2 * SZ_GU + SZ_DN, OFF_WO = 2 * SZ_GU + 2 * SZ_DN;
constexpr size_t WS_WMEM = WS_W + DEPTH * SZ_LAYER;
constexpr size_t SZ_AIN = (size_t)A_INP * DM * 2, SZ_AQB = (size_t)A_QBN * A_QL * 2, SZ_AKVB = (size_t)A_KVBN * A_KVL * 2, SZ_A = SZ_AIN + SZ_AQB + SZ_AKVB;
constexpr size_t WS_WA = WS_WMEM + 64 * MiB;
constexpr size_t SZ_BIN = (size_t)B_IN * DM * 2;
constexpr size_t WS_WB = WS_WA + 2 * SZ_A;
constexpr size_t WS_ACT = WS_WB + 2 * SZ_BIN;
constexpr size_t WS_XN = WS_ACT;
constexpr size_t WS_H = WS_XN + (size_t)M * DM * 2;
constexpr size_t WS_O = WS_H + (size_t)M * DFF * 2;
constexpr size_t WS_QM = WS_O + (size_t)M * DM * 2;
constexpr size_t WS_T0 = WS_QM + (size_t)M * MEMW * 2;
constexpr size_t WS_CQ = WS_T0, WS_CKV = WS_CQ + (size_t)M * 1024 * 2, WS_CQN = WS_CKV + (size_t)M * 768 * 2, WS_CKVN = WS_CQN + (size_t)M * 1024 * 2;
constexpr size_t WS_QA = WS_CKVN + (size_t)M * 512 * 2, WS_KVR = WS_QA + (size_t)M * A_QBN * 2, WS_K192 = WS_KVR + (size_t)M * A_KVBN * 2, WS_AEND = WS_K192 + (size_t)M * A_KW * 2;
constexpr size_t WS_QB = WS_T0, WS_KBR = WS_QB + (size_t)M * TOKW * 2, WS_VB = WS_KBR + (size_t)M * B_KW * 2, WS_KB = WS_VB + (size_t)M * B_KW * 2;
constexpr size_t WS_MEMN = WS_AEND;
constexpr size_t WS_MEMKV = WS_MEMN + (size_t)MEMR * DM * 2;
constexpr size_t WS_MK = WS_MEMKV + (size_t)MEMR * 8192 * 2;
constexpr size_t WS_MVT = WS_MK + (size_t)DEPTH * MEMR * 1024 * 2;
constexpr size_t WS_END = WS_MVT + (size_t)DEPTH * MEMR * 1024 * 2;
constexpr int CW_BAR = 4096;

constexpr int RING_OFF = 0, RING_BYTES = 131072;
constexpr int LDSCTL_OFF = att::MEM_LDS_BYTES, MISC_OFF = LDSCTL_OFF + 320, WSL_OFF = LDSCTL_OFF + 2048;
constexpr int LDS_BYTES = 147456;
static_assert(att::Cfg<192>::LDS_BYTES <= RING_BYTES && att::MEM_LDS_BYTES >= RING_BYTES && WSL_OFF + 2048 <= LDS_BYTES, "LDS map");

typedef float f32x4 __attribute__((ext_vector_type(4)));
typedef short bf16x8 __attribute__((ext_vector_type(8)));

struct Args { const float* in[26]; float* out; unsigned char* ws; };

__device__ __forceinline__ unsigned char* opq_ptr(unsigned char* p) { GAS unsigned char* g = (GAS unsigned char*)p; asm volatile("" : "+s"(g)); return (unsigned char*)g; }
struct Frame { LAS unsigned char* lds; int tid, lane, wave, vcu, G, bx, gw, NGW; };

template <int O> __device__ __forceinline__ float xor_add(float v) {
    if constexpr (O == 32) { auto rr = __builtin_amdgcn_permlane32_swap(__float_as_uint(v), __float_as_uint(v), false, false); return __uint_as_float(rr[0]) + __uint_as_float(rr[1]); }
    else return v + __int_as_float(__builtin_amdgcn_ds_swizzle(__float_as_int(v), (O << 10) | 0x1f));
}
template <int LANES> __device__ __forceinline__ float group_sum(float v) {
    if constexpr (LANES > 1) v = xor_add<1>(v);
    if constexpr (LANES > 2) v = xor_add<2>(v);
    if constexpr (LANES > 4) v = xor_add<4>(v);
    if constexpr (LANES > 8) v = xor_add<8>(v);
    if constexpr (LANES > 16) v = xor_add<16>(v);
    if constexpr (LANES > 32) v = xor_add<32>(v);
    return v;
}
__device__ __forceinline__ float wave_sum(float v) { return group_sum<64>(v); }
__device__ __forceinline__ float bf2f(short s) { return __uint_as_float(((unsigned)(unsigned short)s) << 16); }

__device__ __forceinline__ int dst_row(int kind, int n0, int row_off) {
    switch (kind) {
        case 1: { const int up = n0 >= DFF, f = up ? n0 - DFF : n0; return 256 * (f >> 7) + (f & 127) + (up ? 128 : 0); }
        case 2: return n0 < 1024 ? n0 : (n0 < 1600 ? n0 + 1024 : n0 - 576);
        case 3: { const int h = n0 / 192, d = n0 % 192; return d < 128 ? h * 128 + d : 3072 + h * 64 + (d - 128); }
        case 4: { const int h = n0 >> 8, d = n0 & 255; return d < 128 ? h * 128 + d : 3072 + h * 128 + (d - 128); }
        default: return n0 + row_off;
    }
}
__device__ __forceinline__ void transpose_item(const float* W, int K, int N, bf16* WT, int kind, int row_off, const float* gain, LAS float* scr, int item, int lane) {
    const int nblk = N / 32, kb = item / nblk, nb = item % nblk, k0 = 64 * kb, n0 = 32 * nb;
    const int r0 = dst_row(kind, n0, row_off);
#pragma unroll 8
    for (int i = 0; i < 32; ++i) { const int kk = 2 * i + (lane >> 5); scr[kk * 33 + (lane & 31)] = W[(size_t)(k0 + kk) * N + n0 + (lane & 31)] * (gain ? gain[k0 + kk] : 1.0f); }
    LDS_WAIT(); asm volatile("" ::: "memory");
    const int c = lane & 7;
#pragma unroll
    for (int j = 0; j < 4; ++j) { const int n = (lane >> 3) + 8 * j; const LAS float* s = scr + (8 * c) * 33 + n;
        v4u o; o.x = pk2(s[0 * 33], s[1 * 33]); o.y = pk2(s[2 * 33], s[3 * 33]); o.z = pk2(s[4 * 33], s[5 * 33]); o.w = pk2(s[6 * 33], s[7 * 33]);
        *(GAS v4u*)(WT + (size_t)(r0 + n) * K + k0 + 8 * c) = o; }
    LDS_WAIT(); asm volatile("" ::: "memory");
}
__device__ __forceinline__ void convert_weight(const Frame& F, const float* W, int K, int N, bf16* WT, int kind, int row_off, const float* gain) {
    LAS float* scr = (LAS float*)(F.lds + RING_OFF + F.wave * 16384);
    const int nitems = (K / 64) * (N / 32); const int lane = pg8::opq_tid() & 63;
    for (int it = F.gw; it < nitems; it += F.NGW) transpose_item(W, K, N, WT, kind, row_off, gain, scr, it, lane);
}
__device__ __forceinline__ void xnorm_rows(const Frame& F, const float* x, bf16* xn, int nrows) {
    const int lane = pg8::opq_tid() & 63;
    for (int m = F.gw; m < nrows; m += F.NGW) {
        const GAS f32x4* xr = (const GAS f32x4*)(x + (size_t)m * DM) + lane;
        f32x4 v[16]; float s = 0.f;
#pragma unroll
        for (int j = 0; j < 16; ++j) { v[j] = xr[64 * j]; s += (v[j].x * v[j].x + v[j].y * v[j].y) + (v[j].z * v[j].z + v[j].w * v[j].w); }
        const float rstd = 1.0f / sqrtf(wave_sum(s) * (1.0f / DM) + EPS);
        GAS unsigned long long* o8 = (GAS unsigned long long*)(xn + (size_t)m * DM) + lane;
#pragma unroll
        for (int j = 0; j < 16; ++j) o8[64 * j] = (unsigned long long)pk2(v[j].x * rstd, v[j].y * rstd) | ((unsigned long long)pk2(v[j].z * rstd, v[j].w * rstd) << 32);
    }
}
template <int L, bool GAIN, bool ROPE, int REP>
__device__ __forceinline__ void seg_norm(const Frame& F, const bf16* src, long src_ld, int src_ss, int spr, long nseg, bf16* dst, long dst_ld, int dst_ss, const float* gain, const float* cs, const float* sn) {
    constexpr int LPS = (L / 8 >= 64) ? 64 : L / 8, CPL = L / 8 / LPS, SPW = 64 / LPS;
    const int lane = pg8::opq_tid() & 63, sl = lane % LPS, sg = lane / LPS;
    for (long s0 = (long)F.gw * SPW; s0 < nseg; s0 += (long)F.NGW * SPW) {
        const long seg = s0 + sg, row = seg / spr; const int si = (int)(seg % spr);
        const bf16* sp = src + row * src_ld + (long)si * src_ss;
        bf16x8 raw[CPL]; float ss = 0.f;
#pragma unroll
        for (int c = 0; c < CPL; ++c) { raw[c] = *(const bf16x8*)(sp + (c * LPS + sl) * 8);
#pragma unroll
            for (int e = 0; e < 8; ++e) { const float f = bf2f(raw[c][e]); ss += f * f; } }
        ss = group_sum<LPS>(ss);
        const float rstd = 1.0f / sqrtf(ss * (1.0f / L) + EPS);
        const int pos = (int)(row % SEQ);
#pragma unroll
        for (int c = 0; c < CPL; ++c) { const int e0 = (c * LPS + sl) * 8; float x[8];
#pragma unroll
            for (int e = 0; e < 8; ++e) x[e] = bf2f(raw[c][e]) * rstd;
            if (GAIN) { const f32x4 g0 = *(const f32x4*)(gain + e0), g1 = *(const f32x4*)(gain + e0 + 4);
#pragma unroll
                for (int e = 0; e < 4; ++e) { x[e] *= g0[e]; x[4 + e] *= g1[e]; } }
            if (ROPE) { const f32x4 cv = *(const f32x4*)(cs + (size_t)pos * (L / 2) + e0 / 2), sv = *(const f32x4*)(sn + (size_t)pos * (L / 2) + e0 / 2);
#pragma unroll
                for (int p = 0; p < 4; ++p) { const float a = x[2 * p], b = x[2 * p + 1]; x[2 * p] = a * cv[p] - b * sv[p]; x[2 * p + 1] = a * sv[p] + b * cv[p]; } }
            v4u w; w.x = pk2(x[0], x[1]); w.y = pk2(x[2], x[3]); w.z = pk2(x[4], x[5]); w.w = pk2(x[6], x[7]);
            bf16* dp = dst + row * dst_ld + (long)si * dst_ss + e0;
#pragma unroll
            for (int r = 0; r < REP; ++r) *(v4u*)(dp + (long)r * dst_ss) = w; }
    }
}
__device__ __forceinline__ void sincos_d(float ang, float& c, float& s) {
    const double a = (double)ang, k = __builtin_rint(a * 0.63661977236758134308), r = __builtin_fma(-k, 1.57079632679489661923, a) - k * 6.123233995736766e-17, r2 = r * r;
    double sp = -7.6471637318198164759e-13; sp = sp * r2 + 1.6059043836821614599e-10; sp = sp * r2 - 2.5052108385441718775e-08; sp = sp * r2 + 2.7557319223985890653e-06; sp = sp * r2 - 1.9841269841269841270e-04;
    sp = sp * r2 + 8.3333333333333333333e-03; sp = sp * r2 - 1.6666666666666666667e-01; sp = sp * r2 * r + r;
    double cp = 4.7794773323873852974e-14; cp = cp * r2 - 1.1470745597729724714e-11; cp = cp * r2 + 2.0876756987868098979e-09; cp = cp * r2 - 2.7557319223985890653e-07; cp = cp * r2 + 2.4801587301587301587e-05;
    cp = cp * r2 - 1.3888888888888888889e-03; cp = cp * r2 + 4.1666666666666666667e-02; cp = cp * r2 - 0.5; cp = cp * r2 + 1.0;
    const int q = ((int)k) & 3;
    const double cc = (q == 0) ? cp : (q == 1) ? -sp : (q == 2) ? -cp : sp, sv = (q == 0) ? sp : (q == 1) ? cp : (q == 2) ? -sp : -cp;
    c = (float)cc; s = (float)sv;
}
__device__ __forceinline__ float inv_freq(int axis_dim, int j) {
    constexpr float FA[16] = {1.f, 0.562341332f, 0.316227764f, 0.177827939f, 0.100000001f, 0.0562341325f, 0.0316227749f, 0.0177827943f, 0.00999999978f, 0.00562341325f, 0.00316227763f, 0.00177827943f, 0.00100000005f, 0.000562341302f, 0.000316227757f, 0.00017782794f};
    constexpr float FB[32] = {1.f, 0.749894261f, 0.562341332f, 0.421696514f, 0.316227764f, 0.237137377f, 0.177827939f, 0.133352131f, 0.100000001f, 0.0749894157f, 0.0562341325f, 0.0421696529f, 0.0316227749f, 0.0237137377f, 0.0177827943f, 0.0133352149f,
                              0.00999999978f, 0.00749894185f, 0.00562341325f, 0.00421696482f, 0.00316227763f, 0.00237137359f, 0.00177827943f, 0.00133352145f, 0.00100000005f, 0.000749894243f, 0.000562341302f, 0.000421696517f, 0.000316227757f, 0.00023713737f, 0.00017782794f, 0.00013335215f};
    return axis_dim == 32 ? FA[j] : FB[j];
}

#ifndef ATT_SD_A
#define ATT_SD_A 1
#endif
#ifndef ATT_SD_B
#define ATT_SD_B 1
#endif
__device__ __forceinline__ int opq_i(int v) { asm volatile("" : "+s"(v)); return v; }
__device__ __forceinline__ Frame make_frame(LAS unsigned char* lds) {
    Frame F; F.lds = lds; F.tid = pg8::opq_tid(); F.lane = F.tid & 63; F.wave = __builtin_amdgcn_readfirstlane(F.tid >> 6);
    F.G = opq_i((int)gridDim.x); F.bx = opq_i((int)blockIdx.x); F.vcu = (F.G % 8 == 0) ? (F.bx % 8) * (F.G / 8) + F.bx / 8 : F.bx;
    F.gw = F.vcu * NWAVES + F.wave; F.NGW = F.G * NWAVES; return F;
}
template <class Epi> __device__ __forceinline__ void gemm_site(LAS unsigned char* ldsp, const void* A, const void* Bt, int Mr, int N, int K, const Epi& E) {
    const Frame F = make_frame(ldsp);
    pg8::Gemm g{(const pg8::bf16_t*)A, (const pg8::bf16_t*)Bt, Mr, N, K}; pg8::StaticOrder S; S.init(Mr, N, F.G, F.bx);
    pg8::gemm_phase<Epi, pg8::StaticOrder, true, true>(F.lds + RING_OFF, g, S, E);
}
__global__ void __launch_bounds__(NWAVES * 64, 2) fwd_kernel(Args args) {
    extern __shared__ __attribute__((aligned(16))) unsigned char lds[];
    LAS unsigned char* const ldsp = (LAS unsigned char*)lds;
    unsigned char* const ws = args.ws;
    { const int tid = threadIdx.x; for (int u = tid; u < (LDS_BYTES - LDSCTL_OFF) / 4; u += NWAVES * 64) ((LAS unsigned*)(ldsp + LDSCTL_OFF))[u] = 0u; }
    __syncthreads();
    XcdBarrier bar = xcd_barrier_post((unsigned*)(ws + WS_CTL) + CW_BAR, (volatile LAS unsigned*)(ldsp + MISC_OFF) + 8);
#define GRID_BAR() xcd_barrier(bar)
#define WSP (opq_ptr(ws))
#define OUTP ((float*)opq_ptr((unsigned char*)args.out))

    {
        const Frame F = make_frame(ldsp);
        for (int job = 0; job < 32; ++job) {
            const float* W; const float* gain = nullptr; int K, N, kind = 0, row_off = 0; size_t dst;
            if (job < 24) { const int l = job / 6, t = job % 6; const size_t lo = WS_W + (size_t)l * SZ_LAYER;
                if (t == 0)      { W = args.in[3] + (size_t)l * DM * 2 * DFF; K = DM; N = 2 * DFF; dst = lo + OFF_GU1; kind = 1; gain = args.in[2] + l * DM; }
                else if (t == 1) { W = args.in[4] + (size_t)l * DFF * DM; K = DFF; N = DM; dst = lo + OFF_DN1; }
                else if (t == 2) { W = args.in[12] + (size_t)l * DM * 2 * DFF; K = DM; N = 2 * DFF; dst = lo + OFF_GU2; kind = 1; gain = args.in[11] + l * DM; }
                else if (t == 3) { W = args.in[13] + (size_t)l * DFF * DM; K = DFF; N = DM; dst = lo + OFF_DN2; }
                else if (t == 4) { W = args.in[6] + (size_t)l * DM * DM; K = DM; N = DM; dst = lo + OFF_WO; }
                else             { W = args.in[8] + (size_t)l * DM * 2048; K = DM; N = 2048; dst = WS_WMEM; row_off = l * 2048; gain = args.in[7] + l * DM; }
            } else { const int j = (job - 24) >> 2, t = (job - 24) & 3; const size_t ao = WS_WA + (size_t)j * SZ_A;
                if (t == 0)      { W = args.in[14] + (size_t)j * DM * A_IN; K = DM; N = A_IN; dst = ao; kind = 2; gain = args.in[5] + (2 * j) * DM; }
                else if (t == 1) { W = args.in[17] + (size_t)j * A_QL * A_QBN; K = A_QL; N = A_QBN; dst = ao + SZ_AIN; kind = 3; gain = args.in[15] + j * A_QL; }
                else if (t == 2) { W = args.in[18] + (size_t)j * A_KVL * A_KVBN; K = A_KVL; N = A_KVBN; dst = ao + SZ_AIN + SZ_AQB; kind = 4; gain = args.in[16] + j * A_KVL; }
                else             { W = args.in[23] + (size_t)j * DM * B_IN; K = DM; N = B_IN; dst = WS_WB + (size_t)j * SZ_BIN; gain = args.in[5] + (2 * j + 1) * DM; }
            }
            convert_weight(F, W, K, N, (bf16*)(ws + dst), kind, row_off, gain);
        }
        for (int j = 0; j < 2; ++j) {
            const v4u z = {0u, 0u, 0u, 0u}; GAS v4u* p = (GAS v4u*)(ws + WS_WA + (size_t)j * SZ_A + (size_t)A_IN * DM * 2); const int n16 = (A_INP - A_IN) * DM * 2 / 16;
            for (int i = F.gw * 64 + F.lane; i < n16; i += F.NGW * 64) p[i] = z; }
        { float* par = (float*)(ws + WS_PAR);
          for (int i = F.gw * 64 + F.lane; i < PAR_N; i += F.NGW * 64) {
              float v;
              if (i < PAR_QN) v = args.in[9][i]; else if (i < PAR_QP) v = args.in[19][i - PAR_QN]; else if (i < PAR_KN) v = args.in[20][i - PAR_QP]; else if (i < PAR_KP) v = args.in[21][i - PAR_KN];
              else if (i < PAR_BQ) v = args.in[22][i - PAR_KP]; else if (i < PAR_BK) v = args.in[24][i - PAR_BQ]; else v = args.in[25][i - PAR_BK];
              par[i] = v; } }
        { float* cA = (float*)(ws + WS_COSA); float* sA = (float*)(ws + WS_SINA); float* cB = (float*)(ws + WS_COSB); float* sB = (float*)(ws + WS_SINB);
          for (int i = F.gw * 64 + F.lane; i < SEQ * 32; i += F.NGW * 64) { const int t = i >> 5, p = i & 31; const float pos = (float)(p < 16 ? (t >> 6) : (t & 63)); float c, s; sincos_d(pos * inv_freq(32, p & 15), c, s); cA[i] = c; sA[i] = s; }
          for (int i = F.gw * 64 + F.lane; i < SEQ * 64; i += F.NGW * 64) { const int t = i >> 6, p = i & 63; const float pos = (float)(p < 32 ? (t >> 6) : (t & 63)); float c, s; sincos_d(pos * inv_freq(64, p & 31), c, s); cB[i] = c; sB[i] = s; } }
        xnorm_rows(F, args.in[1], (bf16*)(ws + WS_MEMN), MEMR);
        xnorm_rows(F, args.in[0], (bf16*)(ws + WS_XN), M);
    }
    GRID_BAR();
    { unsigned char* const w = WSP; typedef pg8::EpiBf16One<WS_MEMKV, 8192> EpiT; const EpiT E{w};
      gemm_site<EpiT>(ldsp, w + WS_MEMN, w + WS_WMEM, MEMR, 8192, DM, E); }
    GRID_BAR();
    {
        const Frame F = make_frame(ldsp); unsigned char* const w = WSP;
        for (int l = 0; l < DEPTH; ++l)
            seg_norm<256, true, false, 1>(F, (const bf16*)(w + WS_MEMKV) + l * 2048, 8192, 256, 4, (long)MEMR * 4, (bf16*)(w + WS_MK) + (size_t)l * MEMR * 1024, 1024, 256, args.in[10] + l * MEMHD, nullptr, nullptr);
        const bf16* mkv = (const bf16*)(w + WS_MEMKV); bf16* vt = (bf16*)(w + WS_MVT);
        for (int i = F.gw * 64 + F.lane; i < DEPTH * BATCH * 4 * 256 * 32; i += F.NGW * 64) {
            const int col = i & 255, kc = (i >> 8) & 31, mh = (i >> 13) & 3, b = (i >> 15) & 1, l = i >> 16;
            const bf16* sp = mkv + (size_t)(b * 256 + kc * 8) * 8192 + l * 2048 + 1024 + mh * 256 + col;
            v4u o; o.x = (unsigned)sp[0] | ((unsigned)sp[8192] << 16); o.y = (unsigned)sp[2 * 8192] | ((unsigned)sp[3 * 8192] << 16); o.z = (unsigned)sp[4 * 8192] | ((unsigned)sp[5 * 8192] << 16); o.w = (unsigned)sp[6 * 8192] | ((unsigned)sp[7 * 8192] << 16);
            *(v4u*)(vt + ((size_t)((l * 2 + b) * 4 + mh) * 256 + col) * 256 + kc * 8) = o; }
    }

    for (int l = 0; l < DEPTH; ++l) {
        const size_t wl_off = WS_W + (size_t)l * SZ_LAYER;
        const bool isA = (l & 1) == 0; const int j = l >> 1;
        for (int f = 0; f < 2; ++f) {
            if (l != 0 || f != 0) { const Frame F = make_frame(ldsp); xnorm_rows(F, OUTP, (bf16*)(WSP + WS_XN), M); GRID_BAR(); }
            { unsigned char* const w = WSP; const pg8::EpiSwiGLU E{(pg8::bf16_t*)(w + WS_H), DFF};
              gemm_site<pg8::EpiSwiGLU>(ldsp, w + WS_XN, w + wl_off + (f ? OFF_GU2 : OFF_GU1), M, 2 * DFF, DM, E); }
            GRID_BAR();
            { unsigned char* const w = WSP; float* const o = OUTP; const pg8::EpiResid E{(l == 0 && f == 0) ? args.in[0] : (const float*)o, o, DM, 0.5f};
              gemm_site<pg8::EpiResid>(ldsp, w + WS_H, w + wl_off + (f ? OFF_DN2 : OFF_DN1), M, DM, DFF, E); }
            GRID_BAR();
            if (f != 0) continue;
            { const Frame F = make_frame(ldsp); xnorm_rows(F, OUTP, (bf16*)(WSP + WS_XN), M); }
            GRID_BAR();
            {
                unsigned char* const w = WSP;
                typedef pg8::EpiBf16Seg<4, 8, (1 << 30), WS_CQ, WS_QM, WS_CKV, 0, 1024, 1024, 768, 0> EpiA; typedef pg8::EpiBf16Seg<12, 15, 18, WS_QB, WS_KBR, WS_VB, WS_QM, 3072, 768, 768, 1024> EpiB;
                if (isA) { const EpiA E{w}; gemm_site<EpiA>(ldsp, w + WS_XN, w + WS_WA + (size_t)j * SZ_A, M, A_INP, DM, E); }
                else     { const EpiB E{w}; gemm_site<EpiB>(ldsp, w + WS_XN, w + WS_WB + (size_t)j * SZ_BIN, M, B_IN, DM, E); }
            }
            GRID_BAR();
            if (isA) {
                {
                    const Frame F = make_frame(ldsp); unsigned char* const w = WSP;
                    seg_norm<1024, false, false, 1>(F, (const bf16*)(w + WS_CQ), 1024, 0, 1, M, (bf16*)(w + WS_CQN), 1024, 0, nullptr, nullptr, nullptr);
                    seg_norm<512, false, false, 1>(F, (const bf16*)(w + WS_CKV), 768, 0, 1, M, (bf16*)(w + WS_CKVN), 512, 0, nullptr, nullptr, nullptr);
                    seg_norm<64, true, true, 24>(F, (const bf16*)(w + WS_CKV) + 512, 768, 0, 1, M, (bf16*)(w + WS_K192) + 128, A_KW, 192, (const float*)(w + WS_PAR) + PAR_KP + j * 64, (const float*)(w + WS_COSA), (const float*)(w + WS_SINA));
                }
                GRID_BAR();
                { unsigned char* const w = WSP; typedef pg8::EpiBf16One<WS_QA, A_QBN> EpiT; const EpiT E{w};
                  gemm_site<EpiT>(ldsp, w + WS_CQN, w + WS_WA + (size_t)j * SZ_A + SZ_AIN, M, A_QBN, A_QL, E); }
                { unsigned char* const w = WSP; typedef pg8::EpiBf16One<WS_KVR, A_KVBN> EpiT; const EpiT E{w};
                  gemm_site<EpiT>(ldsp, w + WS_CKVN, w + WS_WA + (size_t)j * SZ_A + SZ_AIN + SZ_AQB, M, A_KVBN, A_KVL, E); }
                GRID_BAR();
                { const Frame F = make_frame(ldsp); unsigned char* const w = WSP;
                  seg_norm<128, true, false, 1>(F, (const bf16*)(w + WS_KVR), A_KVBN, 128, NH, (long)M * NH, (bf16*)(w + WS_K192), A_KW, 192, (const float*)(w + WS_PAR) + PAR_KN + j * 128, nullptr, nullptr); }
                GRID_BAR();
            } else {
                { const Frame F = make_frame(ldsp); unsigned char* const w = WSP;
                  seg_norm<128, true, true, 1>(F, (const bf16*)(w + WS_KBR), B_KW, 128, B_KVH, (long)M * B_KVH, (bf16*)(w + WS_KB), B_KW, 128, (const float*)(w + WS_PAR) + PAR_BK + j * 128, (const float*)(w + WS_COSB), (const float*)(w + WS_SINB)); }
                GRID_BAR();
            }
            if (isA) {
                const Frame F0 = make_frame(ldsp);
                for (int u = F0.vcu; u < BATCH * NH * (SEQ / 256); u += F0.G) {
                    const Frame F = make_frame(ldsp); const int r32 = F.lane & 31, hi = F.lane >> 5;
                    unsigned char* const w = WSP;
                    const int bh = u >> 5, qb = u & 31, b = bh / NH, h = bh % NH;
                    const long row = (long)b * SEQ + qb * 256 + F.wave * 32 + r32; const int pos = qb * 256 + F.wave * 32 + r32;
                    att::bf16x8 qr[12];
                    const bf16* qn = (const bf16*)(w + WS_QA) + row * A_QBN + h * 128 + hi * 8; const bf16* qp = (const bf16*)(w + WS_QA) + row * A_QBN + 3072 + h * 64 + hi * 8;
                    float ssn = 0.f, ssp = 0.f;
#pragma unroll
                    for (int d0 = 0; d0 < 8; ++d0) { qr[d0] = *(const att::bf16x8*)(qn + d0 * 16);
#pragma unroll
                        for (int e = 0; e < 8; ++e) { const float v = bf2f(qr[d0][e]); ssn += v * v; } }
#pragma unroll
                    for (int d0 = 0; d0 < 4; ++d0) { qr[8 + d0] = *(const att::bf16x8*)(qp + d0 * 16);
#pragma unroll
                        for (int e = 0; e < 8; ++e) { const float v = bf2f(qr[8 + d0][e]); ssp += v * v; } }
                    ssn = xor_add<32>(ssn); ssp = xor_add<32>(ssp);
                    const float rn = 1.0f / sqrtf(ssn * (1.0f / 128.0f) + EPS), rp = 1.0f / sqrtf(ssp * (1.0f / 64.0f) + EPS);
                    const float* gn = (const float*)(w + WS_PAR) + PAR_QN + j * 128 + hi * 8; const float* gp = (const float*)(w + WS_PAR) + PAR_QP + j * 64 + hi * 8;
                    const float* cs = (const float*)(w + WS_COSA) + (size_t)pos * 32 + hi * 4; const float* sn = (const float*)(w + WS_SINA) + (size_t)pos * 32 + hi * 4;
#pragma unroll
                    for (int d0 = 0; d0 < 8; ++d0) { const f32x4 g0 = *(const f32x4*)(gn + d0 * 16), g1 = *(const f32x4*)(gn + d0 * 16 + 4); float x[8];
#pragma unroll
                        for (int e = 0; e < 4; ++e) { x[e] = bf2f(qr[d0][e]) * rn * g0[e]; x[4 + e] = bf2f(qr[d0][4 + e]) * rn * g1[e]; }
                        v4u o; o.x = pk2(x[0], x[1]); o.y = pk2(x[2], x[3]); o.z = pk2(x[4], x[5]); o.w = pk2(x[6], x[7]); qr[d0] = __builtin_bit_cast(att::bf16x8, o); }
#pragma unroll
                    for (int d0 = 0; d0 < 4; ++d0) { const f32x4 g0 = *(const f32x4*)(gp + d0 * 16), g1 = *(const f32x4*)(gp + d0 * 16 + 4); float x[8];
#pragma unroll
                        for (int e = 0; e < 4; ++e) { x[e] = bf2f(qr[8 + d0][e]) * rp * g0[e]; x[4 + e] = bf2f(qr[8 + d0][4 + e]) * rp * g1[e]; }
                        const f32x4 cv = *(const f32x4*)(cs + d0 * 8), sv = *(const f32x4*)(sn + d0 * 8);
#pragma unroll
                        for (int p = 0; p < 4; ++p) { const float a = x[2 * p], c = x[2 * p + 1]; x[2 * p] = a * cv[p] - c * sv[p]; x[2 * p + 1] = a * sv[p] + c * cv[p]; }
                        v4u o; o.x = pk2(x[0], x[1]); o.y = pk2(x[2], x[3]); o.z = pk2(x[4], x[5]); o.w = pk2(x[6], x[7]); qr[8 + d0] = __builtin_bit_cast(att::bf16x8, o); }
                    att::attn_unit<192, ATT_SD_A>(qr, (const att::bf16_t*)(w + WS_K192) + (size_t)b * SEQ * A_KW + h * 192, A_KW, (const att::bf16_t*)(w + WS_KVR) + (size_t)b * SEQ * A_KVBN + 3072 + h * 128, A_KVBN,
                                                  (att::bf16_t*)(w + WS_O) + ((size_t)b * SEQ + qb * 256) * DM + h * 128, DM, SEQ, (char*)lds + RING_OFF);
                }
            } else {
                const Frame F0 = make_frame(ldsp);
                for (int u = F0.vcu; u < BATCH * NH * (SEQ / 256); u += F0.G) {
                    const Frame F = make_frame(ldsp); const int r32 = F.lane & 31, hi = F.lane >> 5;
                    unsigned char* const w = WSP;
                    const int bh = u >> 5, qb = u & 31, b = bh / NH, h = bh % NH;
                    const long row = (long)b * SEQ + qb * 256 + F.wave * 32 + r32; const int pos = qb * 256 + F.wave * 32 + r32;
                    att::bf16x8 qr[8];
                    const bf16* qn = (const bf16*)(w + WS_QB) + row * TOKW + h * 128 + hi * 8; float ssn = 0.f;
#pragma unroll
                    for (int d0 = 0; d0 < 8; ++d0) { qr[d0] = *(const att::bf16x8*)(qn + d0 * 16);
#pragma unroll
                        for (int e = 0; e < 8; ++e) { const float v = bf2f(qr[d0][e]); ssn += v * v; } }
                    ssn = xor_add<32>(ssn);
                    const float rn = 1.0f / sqrtf(ssn * (1.0f / 128.0f) + EPS);
                    const float* gn = (const float*)(w + WS_PAR) + PAR_BQ + j * 128 + hi * 8;
                    const float* cs = (const float*)(w + WS_COSB) + (size_t)pos * 64 + hi * 4; const float* sn = (const float*)(w + WS_SINB) + (size_t)pos * 64 + hi * 4;
#pragma unroll
                    for (int d0 = 0; d0 < 8; ++d0) { const f32x4 g0 = *(const f32x4*)(gn + d0 * 16), g1 = *(const f32x4*)(gn + d0 * 16 + 4); float x[8];
#pragma unroll
                        for (int e = 0; e < 4; ++e) { x[e] = bf2f(qr[d0][e]) * rn * g0[e]; x[4 + e] = bf2f(qr[d0][4 + e]) * rn * g1[e]; }
                        const f32x4 cv = *(const f32x4*)(cs + d0 * 8), sv = *(const f32x4*)(sn + d0 * 8);
#pragma unroll
                        for (int p = 0; p < 4; ++p) { const float a = x[2 * p], c = x[2 * p + 1]; x[2 * p] = a * cv[p] - c * sv[p]; x[2 * p + 1] = a * sv[p] + c * cv[p]; }
                        v4u o; o.x = pk2(x[0], x[1]); o.y = pk2(x[2], x[3]); o.z = pk2(x[4], x[5]); o.w = pk2(x[6], x[7]); qr[d0] = __builtin_bit_cast(att::bf16x8, o); }
                    const int kvh = h >> 2;
                    att::attn_unit<128, ATT_SD_B>(qr, (const att::bf16_t*)(w + WS_KB) + (size_t)b * SEQ * B_KW + kvh * 128, B_KW, (const att::bf16_t*)(w + WS_VB) + (size_t)b * SEQ * B_KW + kvh * 128, B_KW,
                                                  (att::bf16_t*)(w + WS_O) + ((size_t)b * SEQ + qb * 256) * DM + h * 128, DM, SEQ, (char*)lds + RING_OFF);
                }
            }
            __syncthreads();
            {
                const Frame F0 = make_frame(ldsp);
                for (int u = F0.vcu; u < BATCH * 4 * (SEQ / 256); u += F0.G) {
                    unsigned char* const w = WSP;
                    const int bm = u >> 5, qb = u & 31, b = bm >> 2, mh = bm & 3;
                    att::mem_attn_unit((const att::bf16_t*)(w + WS_QM) + ((size_t)b * SEQ + qb * 256) * MEMW + mh * 256, MEMW, (const float*)(w + WS_PAR) + PAR_MQ + l * MEMHD, EPS,
                                       (const att::bf16_t*)(w + WS_MK) + ((size_t)l * MEMR + b * 256) * 1024 + mh * 256, 1024, (const att::bf16_t*)(w + WS_MVT) + (size_t)((l * 2 + b) * 4 + mh) * 65536,
                                       (att::bf16_t*)(w + WS_O) + ((size_t)b * SEQ + qb * 256) * DM + TOKW + mh * 256, DM, (char*)lds + RING_OFF, (float*)((char*)lds + WSL_OFF));
                }
            }
            GRID_BAR();
            { unsigned char* const w = WSP; float* const o = OUTP; const pg8::EpiResid E{(const float*)o, o, DM, 1.0f};
              gemm_site<pg8::EpiResid>(ldsp, w + WS_O, w + wl_off + OFF_WO, M, DM, DM, E); }
            GRID_BAR();
        }
    }
#undef GRID_BAR
#undef WSP
#undef OUTP
}

extern "C" void kernel_launch(void* const* d_in, const int* in_sizes, int n_in, void* d_out, int out_size, void* d_ws, size_t ws_size, hipStream_t stream) {
    static int grid = 0;
    if (grid == 0) {
        if (n_in != 26 || in_sizes[0] != M * DM || out_size != M * DM || ws_size < WS_END) { fprintf(stderr, "kernel_launch: unexpected shapes (n_in %d, in0 %d, out %d, ws %zu, need %zu); nothing launched\n", n_in, n_in > 0 ? in_sizes[0] : -1, out_size, ws_size, (size_t)WS_END); grid = -1; return; }
        int dev = 0, cus = 0, per_cu = 0;
        if (hipGetDevice(&dev) != hipSuccess || hipDeviceGetAttribute(&cus, hipDeviceAttributeMultiprocessorCount, dev) != hipSuccess) { grid = -1; return; }
        if (hipFuncSetAttribute((const void*)fwd_kernel, hipFuncAttributeMaxDynamicSharedMemorySize, LDS_BYTES) != hipSuccess) { fprintf(stderr, "kernel_launch: hipFuncSetAttribute failed\n"); grid = -1; return; }
        if (hipOccupancyMaxActiveBlocksPerMultiprocessor(&per_cu, (const void*)fwd_kernel, NWAVES * 64, LDS_BYTES) != hipSuccess || per_cu < 1) fprintf(stderr, "kernel_launch: occupancy query says %d\n", per_cu);
        (void)hipGetLastError();
        grid = cus;
    }
    if (grid < 0) return;
    if (hipMemsetAsync((char*)d_ws + WS_CTL, 0, CTL_ZERO_BYTES, stream) != hipSuccess) return;
    Args a{};
    for (int i = 0; i < 26; ++i) a.in[i] = (const float*)d_in[i];
    a.out = (float*)d_out; a.ws = (unsigned char*)d_ws;
    hipLaunchKernelGGL(fwd_kernel, dim3(grid), dim3(NWAVES * 64), LDS_BYTES, stream, a);
    const hipError_t le = hipPeekAtLastError();
    if (le != hipSuccess) fprintf(stderr, "kernel_launch: launch failed: %s\n", hipGetErrorName(le));
}
```

```cpp
#include <hip/hip_runtime.h>
#include <hip/hip_bf16.h>
#include <cstdio>
#include <cstdint>
namespace pg8 {
#define PG8_LAS __attribute__((address_space(3)))
typedef unsigned short bf16_t;
typedef short bf16x8 __attribute__((ext_vector_type(8)));
typedef float f32x4 __attribute__((ext_vector_type(4)));
typedef unsigned u32x4 __attribute__((ext_vector_type(4)));
typedef __bf16 bf16x2_t __attribute__((ext_vector_type(2)));
constexpr int BM = 256, BK = 64, HALF = 128, HTB = HALF * BK * 2  , STAGE_BYTES = 8 * HTB, NXCD = 8, WGM = 8;

__host__ __device__ __forceinline__ int lds_byte(int r, int c) { const int st = (r >> 4) * 2 + (c >> 5), rr = r & 15, cc = c & 31, ob = rr * 64 + cc * 2; return st * 1024 + (ob ^ (((ob >> 9) & 1) << 5)); }
__host__ __device__ __forceinline__ void stage_rc(int b, int& R, int& C) { const int st = b / 1024, sb = b % 1024, swz = sb ^ (((sb >> 9) & 1) << 5); R = (st >> 1) * 16 + swz / 64; C = (st & 1) * 32 + (swz % 64) / 2; }
__host__ __device__ __forceinline__ int perm32(int rho) { const int n = rho >> 4, i = rho & 15; return 8 * (i >> 2) + 4 * n + (i & 3); }

__device__ __forceinline__ int opq_lane() { int l; asm volatile("v_mbcnt_lo_u32_b32 %0, -1, 0\n\tv_mbcnt_hi_u32_b32 %0, -1, %0" : "=v"(l)); return l; }
typedef int v8i_t __attribute__((ext_vector_type(8)));
typedef int i32x4_t __attribute__((ext_vector_type(4)));
typedef _Float16 f16x2_t __attribute__((ext_vector_type(2)));
typedef float f32x2_t __attribute__((ext_vector_type(2)));
__device__ __forceinline__ unsigned cvt_pk_f16(float lo, float hi) { const f32x2_t v = {lo, hi}; return __builtin_bit_cast(unsigned, __builtin_convertvector(v, f16x2_t)); }
__device__ __forceinline__ float f16_lo(unsigned w) { return (float)__builtin_bit_cast(f16x2_t, w)[0]; }
__device__ __forceinline__ float f16_hi(unsigned w) { return (float)__builtin_bit_cast(f16x2_t, w)[1]; }
struct Unit { int pm, pn; };
struct Gemm { const bf16_t* A; const bf16_t* Bt; int M, N, K; };

struct StaticOrder {
    int nM, nN, nwg, G, c;
    __host__ __device__ void init(int M, int N, int G_, int c_) { nM = M / BM; nN = N / BM; nwg = nM * nN; G = G_; c = c_; }
    __host__ __device__ bool next(int i, Unit& u) const {
        const long L = (long)i * G + c; if (L >= nwg) return false;
        int wgid = (int)L; { const int q = nwg / NXCD, r = nwg % NXCD, xcd = wgid % NXCD, off = wgid / NXCD; wgid = (xcd < r ? xcd * (q + 1) : r * (q + 1) + (xcd - r) * q) + off; }
        const int nig = WGM * nN, gid = wgid / nig, fm = gid * WGM, gsz = (nM - fm) < WGM ? (nM - fm) : WGM;
        u.pm = fm + ((wgid % nig) % gsz); u.pn = (wgid % nig) / gsz; return true;
    }
    __device__ __forceinline__ void a_ready(const Unit&) const {}
    __device__ __forceinline__ void done(const Unit&) const {}
};

__device__ __forceinline__ unsigned cvt_pk_bf16(float lo, float hi) { unsigned r; asm volatile("v_cvt_pk_bf16_f32 %0, %1, %2" : "=v"(r) : "v"(lo), "v"(hi)); return r; }
typedef float f32x2 __attribute__((ext_vector_type(2)));
__device__ __forceinline__ void acc_zero(f32x4 (&acc)[2][2][4][2]) {
#pragma unroll
    for (int a = 0; a < 2; ++a)
#pragma unroll
        for (int b = 0; b < 2; ++b)
#pragma unroll
            for (int m = 0; m < 4; ++m)
#pragma unroll
                for (int n = 0; n < 2; ++n) acc[a][b][m][n] = (f32x4){0.f, 0.f, 0.f, 0.f};
}
__device__ __forceinline__ float epi_xor1(float v) { return v + __int_as_float(__builtin_amdgcn_ds_swizzle(__float_as_int(v), (1 << 10) | 0x1f)); }
__device__ __forceinline__ float epi_xor16(float v) { return v + __int_as_float(__builtin_amdgcn_ds_swizzle(__float_as_int(v), (16 << 10) | 0x1f)); }
__device__ __forceinline__ float epi_xor32(float v) { auto rr = __builtin_amdgcn_permlane32_swap(__float_as_uint(v), __float_as_uint(v), false, false); return __uint_as_float(rr[0]) + __uint_as_float(rr[1]); }
template <int P0, int NP, int CNT> __device__ __forceinline__ void rstd_init(const float* rsp, int row0, int wr, int wc, PG8_LAS float* rs_lds) {
    const int idx = (wr * 4 + wc) * 64 + opq_lane(), row = idx >> 1, half = idx & 1;
    __builtin_amdgcn_s_barrier();
    const float* p = rsp + ((size_t)(row0 + row) * 16 + P0 + half * (NP / 2)); float s;
    if constexpr (NP == 16) { const f32x4 a = *(const f32x4*)p, b = *(const f32x4*)(p + 4); s = ((a[0] + a[1]) + (a[2] + a[3])) + ((b[0] + b[1]) + (b[2] + b[3])); }
    else if constexpr (NP == 4) { s = p[0] + p[1]; }
    else { static_assert(NP == 2, "partials"); s = p[0]; }
    s = epi_xor1(s);
    rs_lds[row] = 1.0f / sqrtf(s * (1.0f / CNT) + 1e-6f);
}
struct EpiSwiGLU {
    static constexpr bool PERM = true, AFTER_DRAIN = false, LAUNDER = false;
    bf16_t* H; int ldh; const float* rsp; PG8_LAS float* rs_lds;
    __device__ __forceinline__ void init(f32x4 (&acc)[2][2][4][2], const Unit& u, int wr, int wc, int, int, int prev  ) const {
        acc_zero(acc);
        if (prev == u.pm) return;
        const int idx = (wr * 4 + wc) * 64 + opq_lane(), row = idx >> 1, half = idx & 1;
        __builtin_amdgcn_s_barrier();
        const f32x4* p = (const f32x4*)(rsp + ((size_t)(u.pm * BM + row) * 16 + half * 8));
        const f32x4 a = p[0], b = p[1];
        const float s = epi_xor1(((a[0] + a[1]) + (a[2] + a[3])) + ((b[0] + b[1]) + (b[2] + b[3])));
        rs_lds[row] = 1.0f / sqrtf(s * (1.0f / 4096.0f) + 1e-6f);
    }
    __device__ __forceinline__ void operator()(const f32x4 (&acc)[2][2][4][2], const Unit& u, int wr, int wc, int fr, int fq) const {
        float rs[2][4];
#pragma unroll
        for (int ai = 0; ai < 2; ++ai)
#pragma unroll
            for (int m = 0; m < 4; ++m) rs[ai][m] = rs_lds[ai * HALF + wr * 64 + m * 16 + fr];
#pragma unroll
        for (int ai = 0; ai < 2; ++ai)
#pragma unroll
            for (int m = 0; m < 4; ++m) { bf16_t* rowp = H + ((size_t)((u.pm * 16 + ai * 8 + wr * 4 + m) * (ldh >> 5) + (u.pn * 4 + wc)) * 16 + fr) * 32 + 8 * fq;
                const float r = rs[ai][m]; float h[8];
#pragma unroll
                for (int n = 0; n < 2; ++n)
#pragma unroll
                    for (int j = 0; j < 4; ++j) { const float g = acc[ai][0][m][n][j] * r, up = acc[ai][1][m][n][j] * r;
                        const float e = __builtin_amdgcn_exp2f(g * (-1.4426950408889634f)); h[n * 4 + j] = g * __builtin_amdgcn_rcpf(1.0f + e) * up; }
                u32x4 w; w.x = cvt_pk_bf16(h[0], h[1]); w.y = cvt_pk_bf16(h[2], h[3]); w.z = cvt_pk_bf16(h[4], h[5]); w.w = cvt_pk_bf16(h[6], h[7]);
                *(u32x4*)rowp = w; }
    }
};
struct EpiResidB {
    static constexpr bool PERM = true, AFTER_DRAIN = false, LAUNDER = false;
    bf16_t* xh; bf16_t* xb; float alpha; float* rsp; PG8_LAS float* red; unsigned char* x8;
    __device__ __forceinline__ void init(f32x4 (&acc)[2][2][4][2], const Unit&, int, int, int, int, int) const { acc_zero(acc); }
    __device__ __forceinline__ void operator()(const f32x4 (&acc)[2][2][4][2], const Unit& u, int wr, int wc, int fr, int fq) const {
        const size_t o0_ = ((size_t)((u.pm * 16 + wr * 4) * 128 + (u.pn * 8 + wc)) * 16 + fr) * 32 + 8 * fq;
        bf16_t* p0 = xh + o0_; bf16_t* pb = xb + o0_;
        float ss[2][4];
        u32x4 bs[2][4][2];
#pragma unroll
        for (int ai = 0; ai < 2; ++ai)
#pragma unroll
            for (int m = 0; m < 4; ++m)
#pragma unroll
                for (int bj = 0; bj < 2; ++bj) bs[ai][m][bj] = *(const u32x4*)(p0 + (size_t)((ai * 8 + m) * 128 + bj * 4) * 512);
#pragma unroll
        for (int ai = 0; ai < 2; ++ai)
#pragma unroll
            for (int m = 0; m < 4; ++m)
#pragma unroll
                for (int bj = 0; bj < 2; ++bj) { const u32x4 b = bs[ai][m][bj]; const f32x4 a0 = acc[ai][bj][m][0] * alpha, a1 = acc[ai][bj][m][1] * alpha;
                    const float v0 = f16_lo(b.x) + a0[0], v1 = f16_hi(b.x) + a0[1], v2 = f16_lo(b.y) + a0[2], v3 = f16_hi(b.y) + a0[3];
                    const float v4 = f16_lo(b.z) + a1[0], v5 = f16_hi(b.z) + a1[1], v6 = f16_lo(b.w) + a1[2], v7 = f16_hi(b.w) + a1[3];
                    u32x4 w; w.x = cvt_pk_f16(v0, v1); w.y = cvt_pk_f16(v2, v3); w.z = cvt_pk_f16(v4, v5); w.w = cvt_pk_f16(v6, v7); *(u32x4*)(p0 + (size_t)((ai * 8 + m) * 128 + bj * 4) * 512) = w;
                    { u32x4 z; z.x = cvt_pk_bf16(v0, v1); z.y = cvt_pk_bf16(v2, v3); z.z = cvt_pk_bf16(v4, v5); z.w = cvt_pk_bf16(v6, v7); *(u32x4*)(pb + (size_t)((ai * 8 + m) * 128 + bj * 4) * 512) = z; }
                    float q = (bj == 0) ? 0.f : ss[ai][m]; float f[8];
#pragma unroll
                    for (int e = 0; e < 4; ++e) { f[2 * e] = f16_lo(w[e]); f[2 * e + 1] = f16_hi(w[e]); q += f[2 * e] * f[2 * e] + f[2 * e + 1] * f[2 * e + 1]; }
                    ss[ai][m] = q;
                    if (x8) { typedef unsigned v2u_t __attribute__((ext_vector_type(2))); v2u_t w8;
                        w8.x = (unsigned)__builtin_amdgcn_cvt_pk_fp8_f32(f[2], f[3], __builtin_amdgcn_cvt_pk_fp8_f32(f[0], f[1], 0, false), true);
                        w8.y = (unsigned)__builtin_amdgcn_cvt_pk_fp8_f32(f[6], f[7], __builtin_amdgcn_cvt_pk_fp8_f32(f[4], f[5], 0, false), true);
                        *(v2u_t*)(x8 + ((size_t)((u.pm * 16 + ai * 8 + wr * 4 + m) * 64 + u.pn * 4 + bj * 2 + (wc >> 1)) * 16 + fr) * 64 + (wc & 1) * 32 + 8 * fq) = w8; } }
#pragma unroll
        for (int ai = 0; ai < 2; ++ai) { float v = 0.f;
#pragma unroll
            for (int m = 0; m < 4; ++m) { const float t = epi_xor32(epi_xor16(ss[ai][m])); v = (fq == m) ? t : v; }
            red[wc * 256 + ai * HALF + wr * 64 + fq * 16 + fr] = v; }
        asm volatile("s_waitcnt lgkmcnt(0)" ::: "memory"); __builtin_amdgcn_s_barrier();
        if (wr * 4 + wc < 4) { const int row = (wr * 4 + wc) * 64 + fq * 16 + fr;
            rsp[(size_t)(u.pm * BM + row) * 16 + u.pn] = (red[row] + red[256 + row]) + (red[512 + row] + red[768 + row]); }
    }
};
struct EpiResidOut {
    static constexpr bool PERM = true, AFTER_DRAIN = false, LAUNDER = false;
    const bf16_t* xb; float* out; int ldc; float alpha;
    __device__ __forceinline__ void init(f32x4 (&acc)[2][2][4][2], const Unit&, int, int, int, int, int) const { acc_zero(acc); }
    __device__ __forceinline__ void operator()(const f32x4 (&acc)[2][2][4][2], const Unit& u, int wr, int wc, int fr, int fq) const {
        const bf16_t* p0 = xb + ((size_t)((u.pm * 16 + wr * 4) * 128 + (u.pn * 8 + wc)) * 16 + fr) * 32 + 8 * fq;
        float* o0 = out + (size_t)(u.pm * BM + wr * 64 + fr) * ldc + u.pn * BM + wc * 32 + 8 * fq;
#pragma unroll
        for (int ai = 0; ai < 2; ++ai)
#pragma unroll
            for (int m = 0; m < 4; ++m) {
#pragma unroll
                for (int bj = 0; bj < 2; ++bj) { const u32x4 b = *(const u32x4*)(p0 + (size_t)((ai * 8 + m) * 128 + bj * 4) * 512); const f32x4 a0 = acc[ai][bj][m][0] * alpha, a1 = acc[ai][bj][m][1] * alpha;
                    float* o = o0 + (size_t)(ai * HALF + m * 16) * ldc + bj * HALF;
                    *(f32x4*)o = (f32x4){f16_lo(b.x) + a0[0], f16_hi(b.x) + a0[1], f16_lo(b.y) + a0[2], f16_hi(b.y) + a0[3]};
                    *(f32x4*)(o + 4) = (f32x4){f16_lo(b.z) + a1[0], f16_hi(b.z) + a1[1], f16_lo(b.w) + a1[2], f16_hi(b.w) + a1[3]}; }
                if (m & 1) asm volatile("" ::: "memory"); }
    }
};
template <bool NORM, int T1, int T2, int T3, size_t O0, size_t O1, size_t O2, size_t O3, int L0, int L1, int L2, int L3, int P0 = 0, int NP = 16, int CNT = 4096> struct EpiBf16Seg {
    static constexpr bool PERM = true, AFTER_DRAIN = false, LAUNDER = (NP != 16);
    unsigned char* ws; const float* rsp; PG8_LAS float* rs_lds;
    __device__ __forceinline__ void init(f32x4 (&acc)[2][2][4][2], const Unit& u, int wr, int wc, int, int, int prev  ) const {
        acc_zero(acc);
        if constexpr (NORM) { if (prev != u.pm) rstd_init<P0, NP, CNT>(rsp, u.pm * BM, wr, wc, rs_lds); }
    }
    __device__ __forceinline__ void operator()(const f32x4 (&acc)[2][2][4][2], const Unit& u, int wr, int wc, int fr, int fq) const {
        const int pn = u.pn;
        const size_t off = pn >= T3 ? O3 : (pn >= T2 ? O2 : (pn >= T1 ? O1 : O0));
        const int ts = pn >= T3 ? T3 : (pn >= T2 ? T2 : (pn >= T1 ? T1 : 0)), ldc = pn >= T3 ? L3 : (pn >= T2 ? L2 : (pn >= T1 ? L1 : L0));
        bf16_t* base = (bf16_t*)(ws + off);
        const int row0 = u.pm * BM + wr * 64 + fr, col0 = (pn - ts) * BM + wc * 32 + 8 * fq;
        float rs[2][4];
#pragma unroll
        for (int ai = 0; ai < 2; ++ai)
#pragma unroll
            for (int m = 0; m < 4; ++m) rs[ai][m] = NORM ? rs_lds[ai * HALF + wr * 64 + m * 16 + fr] : 1.0f;
#pragma unroll
        for (int ai = 0; ai < 2; ++ai)
#pragma unroll
            for (int m = 0; m < 4; ++m) { bf16_t* rowp = base + (size_t)(row0 + ai * HALF + m * 16) * ldc + col0;
#pragma unroll
                for (int bj = 0; bj < 2; ++bj) { const f32x4 v0 = acc[ai][bj][m][0] * rs[ai][m], v1 = acc[ai][bj][m][1] * rs[ai][m];
                    u32x4 w; w.x = cvt_pk_bf16(v0[0], v0[1]); w.y = cvt_pk_bf16(v0[2], v0[3]); w.z = cvt_pk_bf16(v1[0], v1[1]); w.w = cvt_pk_bf16(v1[2], v1[3]);
                    *(u32x4*)(rowp + bj * HALF) = w; } }
    }
};
template <size_t O0, int L0> using EpiBf16One = EpiBf16Seg<false, (1 << 30), (1 << 30), (1 << 30), O0, 0, 0, 0, L0, 0, 0, 0>;
template <int NROWS, int SEQL, size_t OFF_VT, bool NORMC = false, size_t OFF_RSP = 0, int LDS_RS = 0, int P0 = 0, int NP = 16, int CNT = 4096> struct EpiVT8 {
    static constexpr bool PERM = true, AFTER_DRAIN = false, LAUNDER = true;
    unsigned char* ws; PG8_LAS unsigned char* lds;
    __device__ __forceinline__ void init(f32x4 (&acc)[2][2][4][2], const Unit& u, int wr, int wc, int, int, int prev  ) const {
        acc_zero(acc);
        if constexpr (NORMC) rstd_init<P0, NP, CNT>((const float*)(ws + OFF_RSP), u.pn * BM, wr, wc, (PG8_LAS float*)(lds + LDS_RS));
    }
    __device__ __forceinline__ void operator()(const f32x4 (&acc)[2][2][4][2], const Unit& u, int wr, int wc, int fr, int fq) const {
        const int key0 = u.pn * BM, b = key0 / SEQL, t0 = key0 - b * SEQL;
        unsigned char* const vt = ws + OFF_VT; PG8_LAS float* rs_lds = (PG8_LAS float*)(lds + LDS_RS);
        unsigned char* d0 = vt + ((size_t)b * NROWS + u.pm * BM + wr * 64 + fr) * SEQL + t0 + wc * 32 + 4 * fq;
        f32x4 cr[2][2];
#pragma unroll
        for (int bj = 0; bj < 2; ++bj)
#pragma unroll
            for (int n = 0; n < 2; ++n) cr[bj][n] = NORMC ? *(const PG8_LAS f32x4*)(rs_lds + bj * HALF + wc * 32 + 8 * fq + 4 * n) : (f32x4){1.f, 1.f, 1.f, 1.f};
#pragma unroll
        for (int ai = 0; ai < 2; ++ai)
#pragma unroll
            for (int m = 0; m < 4; ++m)
#pragma unroll
                for (int bj = 0; bj < 2; ++bj) { unsigned char* p = d0 + (size_t)(ai * HALF + m * 16) * SEQL + bj * HALF; const f32x4 v0 = acc[ai][bj][m][0] * cr[bj][0], v1 = acc[ai][bj][m][1] * cr[bj][1];
                    *(unsigned*)p = (unsigned)__builtin_amdgcn_cvt_pk_fp8_f32(v0[2], v0[3], __builtin_amdgcn_cvt_pk_fp8_f32(v0[0], v0[1], 0, false), true);
                    *(unsigned*)(p + 16) = (unsigned)__builtin_amdgcn_cvt_pk_fp8_f32(v1[2], v1[3], __builtin_amdgcn_cvt_pk_fp8_f32(v1[0], v1[1], 0, false), true); }
    }
};
template <int HSTRIDE, bool ROWN = false, int P0 = 0, int NP = 16, int CNT = 4096> struct EpiKN8 {
    static constexpr bool PERM = true, AFTER_DRAIN = false, LAUNDER = true;
    unsigned char* k8; int ldk; const float* gain; PG8_LAS float* red; const float* rsp; PG8_LAS float* rs_lds;
    __device__ __forceinline__ void init(f32x4 (&acc)[2][2][4][2], const Unit& u, int wr, int wc, int, int, int prev  ) const { acc_zero(acc); if constexpr (ROWN) { if (prev != u.pm) rstd_init<P0, NP, CNT>(rsp, u.pm * BM, wr, wc, rs_lds); } }
    __device__ __forceinline__ void operator()(const f32x4 (&acc)[2][2][4][2], const Unit& u, int wr, int wc, int fr, int fq) const {
        float rsx[2][4];
#pragma unroll
        for (int ai = 0; ai < 2; ++ai)
#pragma unroll
            for (int m = 0; m < 4; ++m) rsx[ai][m] = ROWN ? rs_lds[ai * HALF + wr * 64 + m * 16 + fr] : 1.0f;
#pragma unroll
        for (int ai = 0; ai < 2; ++ai)
#pragma unroll
            for (int bj = 0; bj < 2; ++bj) { float v = 0.f;
#pragma unroll
                for (int m = 0; m < 4; ++m) { const f32x4 a = acc[ai][bj][m][0], b = acc[ai][bj][m][1];
                    const float t = epi_xor32(epi_xor16(((a[0] * a[0] + a[1] * a[1]) + (a[2] * a[2] + a[3] * a[3]) + ((b[0] * b[0] + b[1] * b[1]) + (b[2] * b[2] + b[3] * b[3]))) * (rsx[ai][m] * rsx[ai][m]))); v = (fq == m) ? t : v; }
                red[((bj * 256 + ai * HALF + wr * 64 + fq * 16 + fr) << 2) + wc] = v; }
        asm volatile("s_waitcnt lgkmcnt(0)" ::: "memory"); __builtin_amdgcn_s_barrier();
        const f32x4 g0 = *(const f32x4*)(gain + wc * 32 + 8 * fq), g1 = *(const f32x4*)(gain + wc * 32 + 8 * fq + 4);
        unsigned char* d0 = k8 + (size_t)(u.pm * BM + wr * 64 + fr) * ldk + (u.pn * 2) * HSTRIDE + wc * 32 + 8 * fq;
        typedef unsigned v2u_t __attribute__((ext_vector_type(2)));
#pragma unroll
        for (int ai = 0; ai < 2; ++ai)
#pragma unroll
            for (int m = 0; m < 4; ++m)
#pragma unroll
                for (int bj = 0; bj < 2; ++bj) { const f32x4 s4 = *(const PG8_LAS f32x4*)(red + ((bj * 256 + ai * HALF + wr * 64 + m * 16 + fr) << 2));
                    const float rs = rsx[ai][m] * __builtin_amdgcn_rsqf(((s4[0] + s4[1]) + (s4[2] + s4[3])) * (1.0f / 128.0f) + 1e-6f);
                    const f32x4 a = acc[ai][bj][m][0] * rs * g0, b = acc[ai][bj][m][1] * rs * g1; v2u_t w8;
                    w8.x = (unsigned)__builtin_amdgcn_cvt_pk_fp8_f32(a[2], a[3], __builtin_amdgcn_cvt_pk_fp8_f32(a[0], a[1], 0, false), true);
                    w8.y = (unsigned)__builtin_amdgcn_cvt_pk_fp8_f32(b[2], b[3], __builtin_amdgcn_cvt_pk_fp8_f32(b[0], b[1], 0, false), true);
                    *(v2u_t*)(d0 + (size_t)(ai * HALF + m * 16) * ldk + bj * HSTRIDE) = w8; }
    }
};
template <int HSTRIDE, size_t OFF_K8, int ldk, size_t OFF_CS, size_t OFF_SN, int seq, size_t OFF_RSP, int LDS_RED, int LDS_RS> struct EpiKNR8 {
    static constexpr bool PERM = true, AFTER_DRAIN = false, LAUNDER = true;
    unsigned char* ws; const float* gain; PG8_LAS unsigned char* lds; float osc;
    __device__ __forceinline__ void init(f32x4 (&acc)[2][2][4][2], const Unit& u, int wr, int wc, int, int, int prev  ) const {
        acc_zero(acc);
        if (prev == u.pm) return;
        const int idx = (wr * 4 + wc) * 64 + opq_lane(), row = idx >> 1, half = idx & 1;
        __builtin_amdgcn_s_barrier();
        const float* rsp = (const float*)(ws + OFF_RSP); PG8_LAS float* rs_lds = (PG8_LAS float*)(lds + LDS_RS);
        const f32x4* p = (const f32x4*)(rsp + ((size_t)(u.pm * BM + row) * 16 + half * 8));
        const f32x4 a = p[0], b = p[1];
        const float s = epi_xor1(((a[0] + a[1]) + (a[2] + a[3])) + ((b[0] + b[1]) + (b[2] + b[3])));
        rs_lds[row] = 1.0f / sqrtf(s * (1.0f / 4096.0f) + 1e-6f);
    }
    __device__ __forceinline__ void operator()(const f32x4 (&acc)[2][2][4][2], const Unit& u, int wr, int wc, int fr, int fq) const {
        unsigned char* const k8 = ws + OFF_K8; const float* const cs = (const float*)(ws + OFF_CS); const float* const sn = (const float*)(ws + OFF_SN);
        PG8_LAS float* red = (PG8_LAS float*)(lds + LDS_RED); PG8_LAS float* rs_lds = (PG8_LAS float*)(lds + LDS_RS);
        float rsx[2][4];
#pragma unroll
        for (int ai = 0; ai < 2; ++ai)
#pragma unroll
            for (int m = 0; m < 4; ++m) rsx[ai][m] = rs_lds[ai * HALF + wr * 64 + m * 16 + fr];
#pragma unroll
        for (int ai = 0; ai < 2; ++ai)
#pragma unroll
            for (int bj = 0; bj < 2; ++bj) { float v = 0.f;
#pragma unroll
                for (int m = 0; m < 4; ++m) { const f32x4 a = acc[ai][bj][m][0], b = acc[ai][bj][m][1];
                    const float t = epi_xor32(epi_xor16(((a[0] * a[0] + a[1] * a[1]) + (a[2] * a[2] + a[3] * a[3]) + ((b[0] * b[0] + b[1] * b[1]) + (b[2] * b[2] + b[3] * b[3]))) * (rsx[ai][m] * rsx[ai][m]))); v = (fq == m) ? t : v; }
                red[((bj * 256 + ai * HALF + wr * 64 + fq * 16 + fr) << 2) + wc] = v; }
        asm volatile("s_waitcnt lgkmcnt(0)" ::: "memory"); __builtin_amdgcn_s_barrier();
        const f32x4 g0 = *(const f32x4*)(gain + wc * 32 + 8 * fq), g1 = *(const f32x4*)(gain + wc * 32 + 8 * fq + 4);
        const int row0 = u.pm * BM + wr * 64 + fr;
        unsigned char* d0 = k8 + (size_t)row0 * ldk + (u.pn * 2) * HSTRIDE + wc * 32 + 8 * fq;
        typedef unsigned v2u_t __attribute__((ext_vector_type(2)));
#pragma unroll
        for (int ai = 0; ai < 2; ++ai)
#pragma unroll
            for (int m = 0; m < 4; ++m) { const int pos = (row0 + ai * HALF + m * 16) % seq;
                const f32x4 cv = *(const f32x4*)(cs + (size_t)pos * 64 + wc * 16 + 4 * fq), sv = *(const f32x4*)(sn + (size_t)pos * 64 + wc * 16 + 4 * fq);
#pragma unroll
                for (int bj = 0; bj < 2; ++bj) { const f32x4 s4 = *(const PG8_LAS f32x4*)(red + ((bj * 256 + ai * HALF + wr * 64 + m * 16 + fr) << 2));
                    const float rs = rsx[ai][m] * osc * __builtin_amdgcn_rsqf(((s4[0] + s4[1]) + (s4[2] + s4[3])) * (1.0f / 128.0f) + 1e-6f);
                    const f32x4 a = acc[ai][bj][m][0] * rs * g0, b = acc[ai][bj][m][1] * rs * g1;
                    const float x0 = a[0] * cv[0] - a[1] * sv[0], x1 = a[0] * sv[0] + a[1] * cv[0], x2 = a[2] * cv[1] - a[3] * sv[1], x3 = a[2] * sv[1] + a[3] * cv[1];
                    const float x4 = b[0] * cv[2] - b[1] * sv[2], x5 = b[0] * sv[2] + b[1] * cv[2], x6 = b[2] * cv[3] - b[3] * sv[3], x7 = b[2] * sv[3] + b[3] * cv[3];
                    v2u_t w8;
                    w8.x = (unsigned)__builtin_amdgcn_cvt_pk_fp8_f32(x2, x3, __builtin_amdgcn_cvt_pk_fp8_f32(x0, x1, 0, false), true);
                    w8.y = (unsigned)__builtin_amdgcn_cvt_pk_fp8_f32(x6, x7, __builtin_amdgcn_cvt_pk_fp8_f32(x4, x5, 0, false), true);
                    *(v2u_t*)(d0 + (size_t)(ai * HALF + m * 16) * ldk + bj * HSTRIDE) = w8; } }
    }
};
template <size_t OFF_CQ8, size_t OFF_CKV8, size_t OFF_KPE, int LDKPE, int KPE0, size_t OFF_RSPX, size_t OFF_RSPA, int LDS_RED, int LDS_RS> struct EpiA8 {
    static constexpr bool PERM = true, AFTER_DRAIN = false, LAUNDER = true;
    unsigned char* ws; PG8_LAS unsigned char* lds;
    __device__ __forceinline__ void init(f32x4 (&acc)[2][2][4][2], const Unit& u, int wr, int wc, int, int, int prev  ) const { acc_zero(acc); if (prev != u.pm) rstd_init<0, 16, 4096>((const float*)(ws + OFF_RSPX), u.pm * BM, wr, wc, (PG8_LAS float*)(lds + LDS_RS)); }
    __device__ __forceinline__ void operator()(const f32x4 (&acc)[2][2][4][2], const Unit& u, int wr, int wc, int fr, int fq) const {
        PG8_LAS float* rs_lds = (PG8_LAS float*)(lds + LDS_RS); PG8_LAS float* red = (PG8_LAS float*)(lds + LDS_RED);
        const int pn = u.pn, row0 = u.pm * BM + wr * 64 + fr;
        float rs[2][4];
#pragma unroll
        for (int ai = 0; ai < 2; ++ai)
#pragma unroll
            for (int m = 0; m < 4; ++m) rs[ai][m] = rs_lds[ai * HALF + wr * 64 + m * 16 + fr];
        if (pn >= 6) {
            bf16_t* base = (bf16_t*)(ws + OFF_KPE) + KPE0 + wc * 32 + 8 * fq;
#pragma unroll
            for (int ai = 0; ai < 2; ++ai)
#pragma unroll
                for (int m = 0; m < 4; ++m) { bf16_t* rowp = base + (size_t)(row0 + ai * HALF + m * 16) * LDKPE;
#pragma unroll
                    for (int bj = 0; bj < 2; ++bj) { const f32x4 v0 = acc[ai][bj][m][0] * rs[ai][m], v1 = acc[ai][bj][m][1] * rs[ai][m];
                        u32x4 w; w.x = cvt_pk_bf16(v0[0], v0[1]); w.y = cvt_pk_bf16(v0[2], v0[3]); w.z = cvt_pk_bf16(v1[0], v1[1]); w.w = cvt_pk_bf16(v1[2], v1[3]);
                        *(u32x4*)(rowp + bj * HALF) = w; } }
            return; }
        unsigned char* d0 = (pn < 4 ? ws + OFF_CQ8 + (size_t)row0 * 1024 + pn * BM : ws + OFF_CKV8 + (size_t)row0 * 512 + (pn - 4) * BM) + wc * 32 + 8 * fq;
        const int ldo = pn < 4 ? 1024 : 512;
        typedef unsigned v2u_t __attribute__((ext_vector_type(2)));
        float ss[2][4];
#pragma unroll
        for (int ai = 0; ai < 2; ++ai)
#pragma unroll
            for (int m = 0; m < 4; ++m) { float q = 0.f;
#pragma unroll
                for (int bj = 0; bj < 2; ++bj) { const f32x4 a = acc[ai][bj][m][0] * rs[ai][m], b = acc[ai][bj][m][1] * rs[ai][m]; v2u_t w8;
                    q += ((a[0] * a[0] + a[1] * a[1]) + (a[2] * a[2] + a[3] * a[3])) + ((b[0] * b[0] + b[1] * b[1]) + (b[2] * b[2] + b[3] * b[3]));
                    w8.x = (unsigned)__builtin_amdgcn_cvt_pk_fp8_f32(a[2], a[3], __builtin_amdgcn_cvt_pk_fp8_f32(a[0], a[1], 0, false), true);
                    w8.y = (unsigned)__builtin_amdgcn_cvt_pk_fp8_f32(b[2], b[3], __builtin_amdgcn_cvt_pk_fp8_f32(b[0], b[1], 0, false), true);
                    *(v2u_t*)(d0 + (size_t)(ai * HALF + m * 16) * ldo + bj * HALF) = w8; }
                ss[ai][m] = q; }
#pragma unroll
        for (int ai = 0; ai < 2; ++ai) { float v = 0.f;
#pragma unroll
            for (int m = 0; m < 4; ++m) { const float t = epi_xor32(epi_xor16(ss[ai][m])); v = (fq == m) ? t : v; }
            red[wc * 256 + ai * HALF + wr * 64 + fq * 16 + fr] = v; }
        asm volatile("s_waitcnt lgkmcnt(0)" ::: "memory"); __builtin_amdgcn_s_barrier();
        if (wr * 4 + wc < 4) { const int row = (wr * 4 + wc) * 64 + fq * 16 + fr;
            ((float*)(ws + OFF_RSPA))[(size_t)(u.pm * BM + row) * 16 + pn] = (red[row] + red[256 + row]) + (red[512 + row] + red[768 + row]); }
    }
};
template <size_t OFF_Q8, int LDQ, size_t OFF_CS, size_t OFF_SN, int seq, size_t OFF_RSPA, int LDS_RED, int LDS_RS> struct EpiQA8 {
    static constexpr bool PERM = true, AFTER_DRAIN = false, LAUNDER = true;
    unsigned char* ws; const float* gn; const float* gp; PG8_LAS unsigned char* lds; float osc;
    __device__ __forceinline__ void init(f32x4 (&acc)[2][2][4][2], const Unit& u, int wr, int wc, int, int, int prev  ) const { acc_zero(acc); if (prev != u.pm) rstd_init<0, 4, 1024>((const float*)(ws + OFF_RSPA), u.pm * BM, wr, wc, (PG8_LAS float*)(lds + LDS_RS)); }
    __device__ __forceinline__ void operator()(const f32x4 (&acc)[2][2][4][2], const Unit& u, int wr, int wc, int fr, int fq) const {
        PG8_LAS float* red = (PG8_LAS float*)(lds + LDS_RED); PG8_LAS float* rs_lds = (PG8_LAS float*)(lds + LDS_RS);
        const bool pe = u.pn >= 12;
        float rsx[2][4];
#pragma unroll
        for (int ai = 0; ai < 2; ++ai)
#pragma unroll
            for (int m = 0; m < 4; ++m) rsx[ai][m] = rs_lds[ai * HALF + wr * 64 + m * 16 + fr];
#pragma unroll
        for (int ai = 0; ai < 2; ++ai)
#pragma unroll
            for (int bj = 0; bj < 2; ++bj) { float v = 0.f;
#pragma unroll
                for (int m = 0; m < 4; ++m) { const f32x4 a = acc[ai][bj][m][0], b = acc[ai][bj][m][1];
                    const float t = epi_xor32(epi_xor16(((a[0] * a[0] + a[1] * a[1]) + (a[2] * a[2] + a[3] * a[3]) + ((b[0] * b[0] + b[1] * b[1]) + (b[2] * b[2] + b[3] * b[3]))) * (rsx[ai][m] * rsx[ai][m]))); v = (fq == m) ? t : v; }
                red[((bj * 256 + ai * HALF + wr * 64 + fq * 16 + fr) << 2) + wc] = v; }
        asm volatile("s_waitcnt lgkmcnt(0)" ::: "memory"); __builtin_amdgcn_s_barrier();
        const int row0 = u.pm * BM + wr * 64 + fr;
        const int d0i = pe ? (wc & 1) * 32 + 8 * fq : wc * 32 + 8 * fq;
        const float* gv = pe ? gp + d0i : gn + d0i;
        const f32x4 g0 = *(const f32x4*)gv, g1 = *(const f32x4*)(gv + 4);
        unsigned char* d0 = ws + OFF_Q8 + (size_t)row0 * LDQ + (pe ? (4 * (u.pn - 12) + (wc >> 1)) * 192 + 128 : (2 * u.pn) * 192) + d0i;
        const int hstep = pe ? 2 * 192 : 192;
        const float inv_n = pe ? (1.0f / 64.0f) : (1.0f / 128.0f);
        typedef unsigned v2u_t __attribute__((ext_vector_type(2)));
#pragma unroll
        for (int ai = 0; ai < 2; ++ai)
#pragma unroll
            for (int m = 0; m < 4; ++m) { f32x4 cv = {1.f, 1.f, 1.f, 1.f}, sv = {0.f, 0.f, 0.f, 0.f};
                if (pe) { const int pos = (row0 + ai * HALF + m * 16) % seq; cv = *(const f32x4*)((const float*)(ws + OFF_CS) + (size_t)pos * 32 + (d0i >> 1)); sv = *(const f32x4*)((const float*)(ws + OFF_SN) + (size_t)pos * 32 + (d0i >> 1)); }
#pragma unroll
                for (int bj = 0; bj < 2; ++bj) { const f32x4 s4 = *(const PG8_LAS f32x4*)(red + ((bj * 256 + ai * HALF + wr * 64 + m * 16 + fr) << 2));
                    const float ssum = pe ? ((wc & 2) ? s4[2] + s4[3] : s4[0] + s4[1]) : (s4[0] + s4[1]) + (s4[2] + s4[3]);
                    const float rs = rsx[ai][m] * osc * __builtin_amdgcn_rsqf(ssum * inv_n + 1e-6f);
                    const f32x4 a = acc[ai][bj][m][0] * rs * g0, b = acc[ai][bj][m][1] * rs * g1;
                    const float x0 = a[0] * cv[0] - a[1] * sv[0], x1 = a[0] * sv[0] + a[1] * cv[0], x2 = a[2] * cv[1] - a[3] * sv[1], x3 = a[2] * sv[1] + a[3] * cv[1];
                    const float x4 = b[0] * cv[2] - b[1] * sv[2], x5 = b[0] * sv[2] + b[1] * cv[2], x6 = b[2] * cv[3] - b[3] * sv[3], x7 = b[2] * sv[3] + b[3] * cv[3];
                    v2u_t w8;
                    w8.x = (unsigned)__builtin_amdgcn_cvt_pk_fp8_f32(x2, x3, __builtin_amdgcn_cvt_pk_fp8_f32(x0, x1, 0, false), true);
                    w8.y = (unsigned)__builtin_amdgcn_cvt_pk_fp8_f32(x6, x7, __builtin_amdgcn_cvt_pk_fp8_f32(x4, x5, 0, false), true);
                    *(v2u_t*)(d0 + (size_t)(ai * HALF + m * 16) * LDQ + bj * hstep) = w8; } }
    }
};

template <class Epi, class Sched, bool ALIGN_EPI = false, bool SP2 = false, bool ABLK = false, bool FP8 = false, bool BBLK = false  >
__device__ __forceinline__ void gemm_phase(PG8_LAS unsigned char* lds, const Gemm g, const Sched& S, const Epi& E, const int wv  , const int sc_w = 0x7f7f7f7f  , const int sc_a = 0x7f7f7f7f  ) {
    int wid = wv; asm volatile("" : "+s"(wid));
    const int lane = opq_lane(), tid = wid * 64 + lane, wr = wid >> 2, wc = wid & 3, fr = lane & 15, fq = lane >> 4;
    const int K = g.K, nt = K / BK;
    unsigned voffA[2], voffB[2];
#pragma unroll
    for (int i = 0; i < 2; ++i) { int R, C; stage_rc(tid * 16 + i * 8192, R, C); const int Rb = Epi::PERM ? ((R & ~31) + perm32(R & 31)) : R;
        voffA[i] = ABLK ? (unsigned)((((R >> 4) * (K >> 5) + (C >> 5)) * 16 + (R & 15)) * 32 + (C & 31)) * 2u : (unsigned)(R * K + C) * 2u; voffB[i] = BBLK ? (unsigned)((((Rb >> 4) * (K >> 5) + (C >> 5)) * 16 + (Rb & 15)) * 32 + (C & 31)) * 2u : (unsigned)(Rb * K + C) * 2u; }
    const size_t kstep = BBLK ? (size_t)2048 : (size_t)(BK * 2);
    const size_t hstep = BBLK ? (size_t)8 * (K >> 5) * 1024 : (size_t)HALF * K * 2;
    const size_t tstep = 2 * hstep;
    const size_t kstepA = ABLK ? (size_t)2048 : (size_t)(BK * 2), hstepA = ABLK ? (size_t)8 * (K >> 5) * 1024 : (size_t)HALF * K * 2, tstepA = 2 * hstepA;
    const unsigned ldsw = (unsigned)wid * 1024u;
    const int aoff = lds_byte(wr * 64 + fr, fq * 8), boff = lds_byte(wc * 32 + fr, fq * 8);
#define PG8_SA(b, h) (((b) * 2 + (h)) * HTB)
#define PG8_SB(b, h) ((4 + (b) * 2 + (h)) * HTB)
#define PG8_STAGE(bufoff, gbase, voff) do { _Pragma("unroll") for (int _i = 0; _i < 2; ++_i) { unsigned vo_ = (voff)[_i]; if constexpr (BBLK || Epi::LAUNDER) asm volatile("" : "+v"(vo_));   \
        __builtin_amdgcn_global_load_lds((const unsigned*)((const char*)(gbase) + vo_), (PG8_LAS unsigned*)(lds + (bufoff) + ldsw + _i * 8192), 16, 0, 0); } } while (0)
#define PG8_LD16A(off) (*(const PG8_LAS i32x4_t*)(abase8 + (off)))
#define PG8_LD16B(off) (*(const PG8_LAS i32x4_t*)(bbase8 + (off)))
#define PG8_LDA(dst, b, h) do { _Pragma("unroll") for (int m = 0; m < 4; ++m) { if constexpr (FP8) dst##8[m] = __builtin_shufflevector(PG8_LD16A(PG8_SA(b, h) + m * 2048), PG8_LD16A(PG8_SA(b, h) + m * 2048 + 1024), 0, 1, 2, 3, 4, 5, 6, 7); \
        else { _Pragma("unroll") for (int k = 0; k < 2; ++k) dst[m][k] = *(const PG8_LAS bf16x8*)(lds + PG8_SA(b, h) + aoff + m * 2048 + k * 1024); } } } while (0)
#define PG8_LDB(dst, b, h) do { _Pragma("unroll") for (int n = 0; n < 2; ++n) { if constexpr (FP8) dst##8[n] = __builtin_shufflevector(PG8_LD16B(PG8_SB(b, h) - 4 * HTB + n * 2048), PG8_LD16B(PG8_SB(b, h) - 4 * HTB + n * 2048 + 1024), 0, 1, 2, 3, 4, 5, 6, 7); \
        else { _Pragma("unroll") for (int k = 0; k < 2; ++k) dst[n][k] = *(const PG8_LAS bf16x8*)(lds + PG8_SB(b, h) + boff + n * 2048 + k * 1024); } } } while (0)
#define PG8_MMA(ai, bj, At, Bt) do { if constexpr (FP8) PG8_SCHED;   __builtin_amdgcn_s_setprio(1); _Pragma("unroll") for (int m = 0; m < 4; ++m) _Pragma("unroll") for (int n = 0; n < 2; ++n) { \
        if constexpr (FP8) acc[ai][bj][m][n] = __builtin_amdgcn_mfma_scale_f32_16x16x128_f8f6f4(Bt##8[n], At##8[m], acc[ai][bj][m][n], 0, 0, 0, sc_w, 0, sc_a); \
        else { _Pragma("unroll") for (int k = 0; k < 2; ++k) acc[ai][bj][m][n] = __builtin_amdgcn_mfma_f32_16x16x32_bf16(Bt[n][k], At[m][k], acc[ai][bj][m][n], 0, 0, 0); } } \
        __builtin_amdgcn_s_setprio(0); if constexpr (FP8) { _Pragma("unroll") for (int m = 0; m < 4; ++m) _Pragma("unroll") for (int n = 0; n < 2; ++n) asm volatile("" : "+v"(acc[ai][bj][m][n]));   PG8_SCHED; } } while (0)
#define PG8_WAIT_V(n) asm volatile("s_waitcnt vmcnt(" #n ")" ::: "memory")
#define PG8_WAIT_L(n) asm volatile("s_waitcnt lgkmcnt(" #n ")" ::: "memory")
#define PG8_BAR __builtin_amdgcn_s_barrier()
#define PG8_SCHED __builtin_amdgcn_sched_barrier(0)
    Unit cur, nxt; int ui = 0;
    if (!S.next(0, cur)) return;
    f32x4 acc[2][2][4][2];
    E.init(acc, cur, wr, wc, fr, fq, -1);
    bf16x8 At[4][2], B0[2][2], B1[2][2];
    v8i_t At8[4], B08[2], B18[2];
    PG8_LAS unsigned char* abase8 = lds + aoff; PG8_LAS unsigned char* bbase8 = lds + 4 * HTB + boff;
    if constexpr (FP8) { asm volatile("" : "+v"(abase8)); asm volatile("" : "+v"(bbase8)); }
    const char* cA = (const char*)g.A + (size_t)cur.pm * tstepA; const char* cB = (const char*)g.Bt + (size_t)cur.pn * tstep;
    S.a_ready(cur);
    if constexpr (SP2) {
        PG8_STAGE(PG8_SB(0, 0), cB, voffB); PG8_STAGE(PG8_SB(0, 1), cB + hstep, voffB); PG8_STAGE(PG8_SA(0, 0), cA, voffA); PG8_STAGE(PG8_SA(0, 1), cA + hstepA, voffA);
        if (wr == 1) PG8_BAR;
        PG8_WAIT_V(2); PG8_BAR;
        PG8_STAGE(PG8_SB(1, 0), cB + kstep, voffB); PG8_STAGE(PG8_SA(1, 0), cA + kstepA, voffA); PG8_STAGE(PG8_SB(1, 1), cB + hstep + kstep, voffB);
        PG8_WAIT_V(6); PG8_BAR;
    } else {
        PG8_STAGE(PG8_SB(0, 0), cB, voffB); PG8_STAGE(PG8_SA(0, 0), cA, voffA); PG8_STAGE(PG8_SB(0, 1), cB + hstep, voffB); PG8_STAGE(PG8_SA(0, 1), cA + hstepA, voffA);
        if (wr == 1) PG8_BAR;
        PG8_WAIT_V(4); PG8_BAR;
        PG8_STAGE(PG8_SB(1, 0), cB + kstep, voffB); PG8_STAGE(PG8_SA(1, 0), cA + kstepA, voffA); PG8_STAGE(PG8_SB(1, 1), cB + hstep + kstep, voffB);
        PG8_WAIT_V(6); PG8_BAR;
    }
    for (;;) {
        const bool has_next = S.next(ui + 1, nxt);
        const char* nA = has_next ? (const char*)g.A + (size_t)nxt.pm * tstepA : cA; const char* nB = has_next ? (const char*)g.Bt + (size_t)nxt.pn * tstep : cB;
        for (int t = 0; t < nt; t += 2) {
            const bool last = (t == nt - 2);
            const char* a1 = cA + (size_t)(t + 1) * kstepA;
            const char* a2 = last ? nA : cA + (size_t)(t + 2) * kstepA; const char* b2 = last ? nB : cB + (size_t)(t + 2) * kstep;
            const char* a3 = a2 + kstepA; const char* b3 = b2 + kstep;
            if (last && has_next) S.a_ready(nxt);
            if constexpr (SP2) {
            PG8_LDB(B0, 0, 0); PG8_LDB(B1, 0, 1); PG8_SCHED; PG8_LDA(At, 0, 0); PG8_STAGE(PG8_SA(1, 1), a1 + hstepA, voffA);
            PG8_WAIT_V(8); PG8_WAIT_L(0); PG8_BAR; PG8_MMA(0, 0, At, B0); PG8_MMA(0, 1, At, B1); PG8_BAR; PG8_SCHED;
            PG8_LDA(At, 0, 1); PG8_STAGE(PG8_SB(0, 0), b2, voffB); PG8_STAGE(PG8_SB(0, 1), b2 + hstep, voffB); PG8_STAGE(PG8_SA(0, 0), a2, voffA);
            PG8_WAIT_V(8); PG8_WAIT_L(0); PG8_BAR; PG8_MMA(1, 0, At, B0); PG8_MMA(1, 1, At, B1); PG8_BAR; PG8_SCHED;
            PG8_LDB(B0, 1, 0); PG8_LDB(B1, 1, 1); PG8_SCHED; PG8_LDA(At, 1, 0); PG8_STAGE(PG8_SA(0, 1), a2 + hstepA, voffA);
            PG8_WAIT_V(8); PG8_WAIT_L(0); PG8_BAR; PG8_MMA(0, 0, At, B0); PG8_MMA(0, 1, At, B1); PG8_BAR; PG8_SCHED;
            PG8_LDA(At, 1, 1); PG8_STAGE(PG8_SB(1, 0), b3, voffB); PG8_STAGE(PG8_SB(1, 1), b3 + hstep, voffB); PG8_STAGE(PG8_SA(1, 0), a3, voffA);
            PG8_WAIT_V(8); PG8_WAIT_L(0); PG8_BAR; PG8_MMA(1, 0, At, B0); PG8_MMA(1, 1, At, B1); PG8_BAR; PG8_SCHED;
            } else {
            PG8_LDB(B0, 0, 0); PG8_SCHED; PG8_LDA(At, 0, 0); PG8_STAGE(PG8_SA(1, 1), a1 + hstepA, voffA);
            PG8_WAIT_L(8); PG8_BAR; PG8_WAIT_L(0); PG8_MMA(0, 0, At, B0); PG8_BAR; PG8_SCHED;
            PG8_LDB(B1, 0, 1); PG8_STAGE(PG8_SB(0, 0), b2, voffB);
            PG8_BAR; PG8_WAIT_L(0); PG8_MMA(0, 1, At, B1); PG8_BAR;
            PG8_LDA(At, 0, 1); PG8_STAGE(PG8_SA(0, 0), a2, voffA);
            PG8_BAR; PG8_WAIT_L(0); PG8_MMA(1, 0, At, B0); PG8_BAR; PG8_SCHED;
            PG8_STAGE(PG8_SB(0, 1), b2 + hstep, voffB);
            PG8_WAIT_V(6); PG8_BAR; PG8_MMA(1, 1, At, B1); PG8_BAR;
            PG8_LDB(B0, 1, 0); PG8_SCHED; PG8_LDA(At, 1, 0); PG8_STAGE(PG8_SA(0, 1), a2 + hstepA, voffA);
            PG8_WAIT_L(8); PG8_BAR; PG8_WAIT_L(0); PG8_MMA(0, 0, At, B0); PG8_BAR; PG8_SCHED;
            PG8_LDB(B1, 1, 1); PG8_STAGE(PG8_SB(1, 0), b3, voffB);
            PG8_BAR; PG8_WAIT_L(0); PG8_MMA(0, 1, At, B1); PG8_BAR;
            PG8_LDA(At, 1, 1); PG8_STAGE(PG8_SA(1, 0), a3, voffA);
            PG8_BAR; PG8_WAIT_L(0); PG8_MMA(1, 0, At, B0); PG8_BAR; PG8_SCHED;
            PG8_STAGE(PG8_SB(1, 1), b3 + hstep, voffB);
            PG8_WAIT_V(6); PG8_BAR; PG8_MMA(1, 1, At, B1); PG8_BAR;
            }
        }
        if constexpr (ALIGN_EPI) { if (wr == 0) PG8_BAR; }
        if constexpr (!Epi::AFTER_DRAIN) { const int l2_ = opq_lane();   E(acc, cur, wr, wc, l2_ & 15, l2_ >> 4); S.done(cur); }
        if (!has_next) break;
        E.init(acc, nxt, wr, wc, fr, fq, cur.pm);
        cur = nxt; cA = nA; cB = nB; ++ui;
        if constexpr (ALIGN_EPI) { if (wr == 1) PG8_BAR; }
    }
    PG8_WAIT_V(0);
    if constexpr (!ALIGN_EPI) { if (wr == 0) PG8_BAR; }
    PG8_BAR;
    if constexpr (Epi::AFTER_DRAIN) { E.fused(acc, cur, wr, wc, fr, fq, lds, wid, lane); S.done(cur); }
#undef PG8_SA
#undef PG8_SB
#undef PG8_STAGE
#undef PG8_LDA
#undef PG8_LD16A
#undef PG8_LD16B
#undef PG8_LDB
#undef PG8_MMA
#undef PG8_WAIT_V
#undef PG8_WAIT_L
#undef PG8_BAR
#undef PG8_SCHED
}
}
#ifndef ATT_EARLY_A
#define ATT_EARLY_A true
#endif
#ifndef ATT_EARLY_B
#define ATT_EARLY_B true
#endif
namespace att {
using bf16x8 = __attribute__((ext_vector_type(8))) short;
using s16x4  = __attribute__((ext_vector_type(4))) short;
using f32x16 = __attribute__((ext_vector_type(16))) float;
using f32x4  = __attribute__((ext_vector_type(4))) float;
using u32x4  = __attribute__((ext_vector_type(4))) unsigned;
typedef unsigned short bf16_t;
constexpr int NW = 8, QBLK = 32, KVBLK = 64, DV = 128, OIMG_OFF = 98304;
constexpr float THR = 6.f;
constexpr int VROW = KVBLK + 16, SHM_V = DV * VROW;
typedef int v8i_t __attribute__((ext_vector_type(8)));
template <int DQK> struct Cfg { static constexpr int KROW = DQK + 16  , SHM_K = KVBLK * KROW, NS = DQK / 64, NKC = (DQK / 16 + 7) / 8, LDS_BYTES = 3 * SHM_V + 3 * SHM_K + NW * 64 * 4;
    static constexpr float SCALE = DQK == 128 ? 0.088388347648318440f : 0.072168783648703220f; };
#define SBAR() __builtin_amdgcn_sched_barrier(0)
__device__ __forceinline__ int crow(int r, int hi) { return (r & 3) + 8 * (r >> 2) + 4 * hi; }
__device__ __forceinline__ unsigned cvtpk(float lo, float hi) { unsigned r; asm volatile("v_cvt_pk_bf16_f32 %0, %1, %2" : "=v"(r) : "v"(lo), "v"(hi)); return r; }
__device__ __forceinline__ float bf2f(short s) { return __uint_as_float(((unsigned)(unsigned short)s) << 16); }
template <int DQK> __device__ __forceinline__ int kswz(int row, int colB) { return row * Cfg<DQK>::KROW + colB; }

constexpr float THRL = THR * 1.4426950408889634f;
template <bool FIRST> __device__ __forceinline__ void partialSM(f32x16& p0, f32x16& p1, f32x16& negm, float& alpha) {
  float pmax = p0[0];
#pragma unroll
  for (int r = 1; r < 16; ++r) pmax = fmaxf(pmax, p0[r]);
#pragma unroll
  for (int r = 0; r < 16; ++r) pmax = fmaxf(pmax, p1[r]);
  { auto rr = __builtin_amdgcn_permlane32_swap(__float_as_uint(pmax), __float_as_uint(pmax), false, false);
    pmax = fmaxf(__uint_as_float(rr[0]), __uint_as_float(rr[1])); }
  if (!FIRST && __builtin_expect(__all(pmax <= THRL), 1)) { alpha = 1.f; }
  else { const float delta = FIRST ? pmax : fmaxf(pmax, 0.f); const float nm = negm[0] - delta; alpha = __builtin_amdgcn_exp2f(-delta);
#pragma unroll
    for (int r = 0; r < 16; ++r) { p0[r] -= delta; p1[r] -= delta; }
#pragma unroll
    for (int r = 0; r < 16; ++r) negm[r] = nm; }
#pragma unroll
  for (int r = 0; r < 16; ++r) p0[r] = __builtin_amdgcn_exp2f(p0[r]);
}
#define ATT_PK4(P, BASE, OUT) do { unsigned a0 = cvtpk(P[BASE + 0], P[BASE + 1]), a1 = cvtpk(P[BASE + 2], P[BASE + 3]);   \
    unsigned b0 = cvtpk(P[BASE + 4], P[BASE + 5]), b1 = cvtpk(P[BASE + 6], P[BASE + 7]);                              \
    auto r0 = __builtin_amdgcn_permlane32_swap(a0, b0, false, false); auto r1 = __builtin_amdgcn_permlane32_swap(a1, b1, false, false); \
    u32x4 w = {r0[0], r1[0], r0[1], r1[1]}; OUT = __builtin_bit_cast(bf16x8, w); } while (0)
__device__ __forceinline__ unsigned pk4_fp8(float a, float b, float c, float d) { return (unsigned)__builtin_amdgcn_cvt_pk_fp8_f32(c, d, __builtin_amdgcn_cvt_pk_fp8_f32(a, b, 0, false), true); }
__device__ __forceinline__ void finishSM(f32x16& p0, f32x16& p1, v8i_t& pa) {
#pragma unroll
  for (int r = 0; r < 16; ++r) p1[r] = __builtin_amdgcn_exp2f(p1[r]);
#pragma unroll
  for (int i = 0; i < 4; ++i) { const unsigned d0 = pk4_fp8(p0[4 * i], p0[4 * i + 1], p0[4 * i + 2], p0[4 * i + 3]), d1 = pk4_fp8(p1[4 * i], p1[4 * i + 1], p1[4 * i + 2], p1[4 * i + 3]);
    auto rr = __builtin_amdgcn_permlane32_swap(d0, d1, false, false); pa[i] = (int)rr[0]; pa[4 + i] = (int)rr[1]; }
}
template <int DQK> __device__ __forceinline__ void qkt(f32x16& p0, f32x16& p1, const char* Ks, const v8i_t (&qf)[DQK / 64], const f32x16& negm, int r32, int hi) {
  p0 = negm; p1 = negm;
#pragma unroll
  for (int s = 0; s < DQK / 64; ++s) { const char* k0 = Ks + kswz<DQK>(r32, 64 * s + 32 * hi); const char* k1 = Ks + kswz<DQK>(32 + r32, 64 * s + 32 * hi);
    const u32x4 a0 = *reinterpret_cast<const u32x4*>(k0), a1 = *reinterpret_cast<const u32x4*>(k0 + 16), b0 = *reinterpret_cast<const u32x4*>(k1), b1 = *reinterpret_cast<const u32x4*>(k1 + 16);
    const v8i_t ka = {(int)a0.x, (int)a0.y, (int)a0.z, (int)a0.w, (int)a1.x, (int)a1.y, (int)a1.z, (int)a1.w}, kb = {(int)b0.x, (int)b0.y, (int)b0.z, (int)b0.w, (int)b1.x, (int)b1.y, (int)b1.z, (int)b1.w};
    p0 = __builtin_amdgcn_mfma_scale_f32_32x32x64_f8f6f4(ka, qf[s], p0, 0, 0, 0, 0x7f7f7f7f, 0, 0x7f7f7f7f);
    p1 = __builtin_amdgcn_mfma_scale_f32_32x32x64_f8f6f4(kb, qf[s], p1, 0, 0, 0, 0x7f7f7f7f, 0, 0x7f7f7f7f); }
}
__device__ __forceinline__ void pv_d0(f32x16* o, f32x16& osum, const char* Vs, const v8i_t& pa, int r32, int hi) {
  { const v8i_t ones = {0x38383838, 0x38383838, 0x38383838, 0x38383838, 0x38383838, 0x38383838, 0x38383838, 0x38383838};
    osum = __builtin_amdgcn_mfma_scale_f32_32x32x64_f8f6f4(pa, ones, osum, 0, 0, 0, 0x7f7f7f7f, 0, 0x7f7f7f7f); }
#pragma unroll
  for (int cb = 0; cb < 4; ++cb) { const char* vp = Vs + (cb * 32 + r32) * VROW + 32 * hi;
    const u32x4 a0 = *reinterpret_cast<const u32x4*>(vp), a1 = *reinterpret_cast<const u32x4*>(vp + 16);
    const v8i_t vf = {(int)a0.x, (int)a0.y, (int)a0.z, (int)a0.w, (int)a1.x, (int)a1.y, (int)a1.z, (int)a1.w};
    o[cb] = __builtin_amdgcn_mfma_scale_f32_32x32x64_f8f6f4(pa, vf, o[cb], 0, 0, 0, 0x7f7f7f7f, 0, 0x7f7f7f7f); }
}
template <int DQK, int SDEPTH, bool RING>
__device__ __forceinline__ void attn_unit(const v8i_t (&qr)[DQK / 64], const unsigned char* __restrict__ Kh, int ldk  , const unsigned char* __restrict__ Vh  , int ldv  ,
                                          unsigned char* __restrict__ Ob  , int ldo, int seq, char* lds, const int wv) {
  using C = Cfg<DQK>; constexpr int SHM_K = C::SHM_K, NKC = C::NKC, CPR = DQK / 16;
  int wid = wv; asm volatile("" : "+s"(wid));
  const int lane = pg8::opq_lane(), tid = wid * 64 + lane, r32 = lane & 31, hi = lane >> 5;
  constexpr int NSLOT = RING ? 3 : 2; constexpr bool EARLY_LD = (DQK == 128) ? ATT_EARLY_B : ATT_EARLY_A;
  char* V_lds = lds; char* K_lds = lds + NSLOT * SHM_V;
  float* ws = (float*)(lds + NSLOT * SHM_V + NSLOT * SHM_K) + wid * 64; float* li_l = ws; float* al_l = ws + 32;
  f32x16 o[4] = {}; f32x16 osum = {}, negm = {};
  const int srow = tid >> 3, sch = tid & 7;
  const unsigned koff = (unsigned)(srow * ldk + sch * 16), voff = (unsigned)((tid >> 2) * ldv + (tid & 3) * 16);
  const int kdst = kswz<DQK>(srow, sch * 16), vdst = (tid >> 2) * VROW + (tid & 3) * 16;
  struct { bf16x8 vs[1], ks[NKC]; } sr_[SDEPTH];
#define ATT_LD8(p) (*reinterpret_cast<const bf16x8*>(p))
#define SLOAD(i, k0) do { const char* vg_ = (const char*)Vh + (k0); const char* kg_ = (const char*)Kh + (size_t)(k0) * ldk; \
    sr_[i].vs[0] = ATT_LD8(vg_ + voff); \
    _Pragma("unroll") for (int q_ = 0; q_ < NKC; ++q_) if (sch + 8 * q_ < CPR) sr_[i].ks[q_] = ATT_LD8(kg_ + koff + q_ * 128); } while (0)
#define SWRITE(b, i) do { *(bf16x8*)(V_lds + (b) * SHM_V + vdst) = sr_[i].vs[0]; \
    _Pragma("unroll") for (int q_ = 0; q_ < NKC; ++q_) if (sch + 8 * q_ < CPR) *(bf16x8*)(K_lds + (b) * SHM_K + kdst + q_ * 128) = sr_[i].ks[q_]; } while (0)
#define SWAIT() do { if constexpr (SDEPTH == 1) asm volatile("s_waitcnt vmcnt(0)" ::: "memory"); else if constexpr (NKC == 1) asm volatile("s_waitcnt vmcnt(2)" ::: "memory"); else asm volatile("s_waitcnt vmcnt(3)" ::: "memory"); } while (0)
#define RESC(a) do { if (__any((a) < 1.f)) { if (hi == 0) al_l[r32] = (a); asm volatile("s_waitcnt lgkmcnt(0)" ::: "memory"); \
    _Pragma("unroll") for (int r = 0; r < 16; ++r) { const float f_ = al_l[crow(r, hi)]; osum[r] *= f_; _Pragma("unroll") for (int d = 0; d < 4; ++d) o[d][r] *= f_; } } } while (0)
  f32x16 pA0, pA1, pB0, pB1; float alA, alB; v8i_t pa; const int NT = seq / KVBLK;
  if constexpr (RING) {
  static_assert(SDEPTH == 1, "the three-slot ring stages one tile ahead");
#define ATT_STEP(PX0, PX1, PY0, PY1, ALY, SC, SP, SN, JJ) do { \
    SBAR(); if constexpr (EARLY_LD) { SLOAD(0, ((JJ) + 1) * KVBLK); SBAR(); } qkt<DQK>(PY0, PY1, K_lds + (SC) * SHM_K, qr, negm, r32, hi); \
    finishSM(PX0, PX1, pa); SBAR(); \
    if constexpr (!EARLY_LD) { SLOAD(0, ((JJ) + 1) * KVBLK); SBAR(); } \
    pv_d0(o, osum, V_lds + (SP) * SHM_V, pa, r32, hi); partialSM<false>(PY0, PY1, negm, ALY); \
    SWAIT(); SWRITE(SN, 0); \
    RESC(ALY); __syncthreads(); } while (0)
  SLOAD(0, 0); asm volatile("s_waitcnt vmcnt(0)" ::: "memory"); SWRITE(0, 0); __syncthreads();
  qkt<DQK>(pA0, pA1, K_lds, qr, negm, r32, hi); partialSM<true>(pA0, pA1, negm, alA);
  SLOAD(0, KVBLK); SWAIT(); SWRITE(1, 0); __syncthreads();
  for (int j = 1; j + 1 < NT; j += 6) {
    ATT_STEP(pA0, pA1, pB0, pB1, alB, 1, 0, 2, j);
    ATT_STEP(pB0, pB1, pA0, pA1, alA, 2, 1, 0, j + 1);
    ATT_STEP(pA0, pA1, pB0, pB1, alB, 0, 2, 1, j + 2);
    ATT_STEP(pB0, pB1, pA0, pA1, alA, 1, 0, 2, j + 3);
    ATT_STEP(pA0, pA1, pB0, pB1, alB, 2, 1, 0, j + 4);
    ATT_STEP(pB0, pB1, pA0, pA1, alA, 0, 2, 1, j + 5);
  }
  SBAR(); qkt<DQK>(pB0, pB1, K_lds + 1 * SHM_K, qr, negm, r32, hi);
  finishSM(pA0, pA1, pa); SBAR();
  pv_d0(o, osum, V_lds, pa, r32, hi); partialSM<false>(pB0, pB1, negm, alB);
  RESC(alB);
  finishSM(pB0, pB1, pa); SBAR();
  pv_d0(o, osum, V_lds + 1 * SHM_V, pa, r32, hi);
#undef ATT_STEP
  } else {
  constexpr int SE = 0, SO = SDEPTH - 1;
  SLOAD(SE, 0); asm volatile("s_waitcnt vmcnt(0)" ::: "memory"); SWRITE(0, SE); __syncthreads();
  qkt<DQK>(pA0, pA1, K_lds, qr, negm, r32, hi); partialSM<true>(pA0, pA1, negm, alA);
  SLOAD(SO, KVBLK); if constexpr (SDEPTH == 2) { if (2 < NT) SLOAD(SE, 2 * KVBLK); }
  SWAIT(); SWRITE(1, SO); __syncthreads();
  for (int j = 1; j + 1 < NT; j += 2) {
    SBAR(); qkt<DQK>(pB0, pB1, K_lds + SHM_K, qr, negm, r32, hi);
    finishSM(pA0, pA1, pa); SBAR();
    SLOAD(SO, (j + SDEPTH) * KVBLK); SBAR();
    pv_d0(o, osum, V_lds, pa, r32, hi); partialSM<false>(pB0, pB1, negm, alB);
    __syncthreads(); SWAIT(); SWRITE(0, SE);
    RESC(alB); __syncthreads();
    SBAR(); qkt<DQK>(pA0, pA1, K_lds, qr, negm, r32, hi);
    finishSM(pB0, pB1, pa); SBAR();
    if (SDEPTH == 1 || j + 3 < NT) SLOAD(SE, (j + 1 + SDEPTH) * KVBLK); SBAR();
    pv_d0(o, osum, V_lds + SHM_V, pa, r32, hi); partialSM<false>(pA0, pA1, negm, alA);
    __syncthreads(); SWAIT(); SWRITE(1, SO);
    RESC(alA); __syncthreads();
  }
  SBAR(); qkt<DQK>(pB0, pB1, K_lds + SHM_K, qr, negm, r32, hi);
  finishSM(pA0, pA1, pa); SBAR();
  pv_d0(o, osum, V_lds, pa, r32, hi); partialSM<false>(pB0, pB1, negm, alB);
  __syncthreads(); RESC(alB);
  finishSM(pB0, pB1, pa); SBAR();
  pv_d0(o, osum, V_lds + SHM_V, pa, r32, hi);
  }
  float rli[16];
#pragma unroll
  for (int r = 0; r < 16; ++r) rli[r] = 64.0f * __builtin_amdgcn_rcpf(osum[r]);
  unsigned char* Ow = Ob + (long)(wid * QBLK) * ldo;
  static_assert(C::LDS_BYTES <= OIMG_OFF, "the output image sits above the K / V^T slots");
  char* oimg = lds + OIMG_OFF + wid * (QBLK * DV);
#pragma unroll
  for (int r = 0; r < 16; ++r) { const int orow = crow(r, hi);
    const unsigned w4 = (unsigned)__builtin_amdgcn_cvt_pk_fp8_f32(o[2][r] * rli[r], o[3][r] * rli[r], __builtin_amdgcn_cvt_pk_fp8_f32(o[0][r] * rli[r], o[1][r] * rli[r], 0, false), true);
    oimg[orow * DV + r32] = (char)(w4 & 0xff); oimg[orow * DV + 32 + r32] = (char)((w4 >> 8) & 0xff); oimg[orow * DV + 64 + r32] = (char)((w4 >> 16) & 0xff); oimg[orow * DV + 96 + r32] = (char)(w4 >> 24); }
  asm volatile("s_waitcnt lgkmcnt(0)" ::: "memory");
#pragma unroll
  for (int i = 0; i < 4; ++i) { const int c_ = i * 64 + lane, row_ = c_ >> 3, ch_ = c_ & 7;
    const u32x4 v_ = *reinterpret_cast<const u32x4*>(oimg + row_ * DV + ch_ * 16); *reinterpret_cast<u32x4*>(Ow + (long)row_ * ldo + ch_ * 16) = v_; }
  __syncthreads();
#undef SLOAD
#undef SWRITE
#undef SWAIT
#undef RESC
#undef ATT_LD8
}

constexpr int MROW = 528, MEM_LDS_BYTES = 256 * MROW;
__device__ __forceinline__ void mem_attn_unit(const bf16_t* __restrict__ Qb, int ldq, const float* __restrict__ gq, float eps, const bf16_t* __restrict__ Kt, int ldk, const bf16_t* __restrict__ VT,
                                              unsigned char* __restrict__ Ob  , int ldo, char* lds, float* wsl, const int wv) {
  int wid = wv; asm volatile("" : "+s"(wid));
  const int lane = pg8::opq_lane(), tid = wid * 64 + lane, r32 = lane & 31, hi = lane >> 5;
  const bf16_t* qp = Qb + (long)(wid * QBLK + r32) * ldq + hi * 8;
  float ss = 0.f;
#pragma unroll
  for (int d0 = 0; d0 < 16; ++d0) { const bf16x8 q = *reinterpret_cast<const bf16x8*>(qp + d0 * 16);
#pragma unroll
    for (int e = 0; e < 8; ++e) { const float f = bf2f(q[e]); ss += f * f; } }
  { auto rr = __builtin_amdgcn_permlane32_swap(__float_as_uint(ss), __float_as_uint(ss), false, false); ss = __uint_as_float(rr[0]) + __uint_as_float(rr[1]); }
  const float rstd = 1.0f / sqrtf(ss * (1.0f / 256.0f) + eps);
  { const int srow = tid >> 5, sch = tid & 31;
#pragma unroll 4
    for (int i = 0; i < 16; ++i) *(bf16x8*)(lds + (srow + 16 * i) * MROW + sch * 16) = *reinterpret_cast<const bf16x8*>(Kt + (long)(srow + 16 * i) * ldk + sch * 8); }
  __syncthreads();
  f32x16 s[8];
#pragma unroll
  for (int kb = 0; kb < 8; ++kb) s[kb] = f32x16{};
  typedef const __attribute__((address_space(3))) bf16x8* lds_frag_t;
  unsigned rd = (unsigned)(uintptr_t)lds + r32 * MROW + hi * 16;
  unsigned rd4 = rd + 4 * 32 * MROW;
  asm volatile("" : "+v"(rd)); asm volatile("" : "+v"(rd4));
#pragma unroll
  for (int d0 = 0; d0 < 16; ++d0) {
    const bf16x8 qraw = *reinterpret_cast<const bf16x8*>(qp + d0 * 16);
    const f32x4 g0 = *(const f32x4*)(gq + d0 * 16 + hi * 8), g1 = *(const f32x4*)(gq + d0 * 16 + hi * 8 + 4);
    float x[8];
#pragma unroll
    for (int e = 0; e < 4; ++e) { x[e] = bf2f(qraw[e]) * rstd * g0[e]; x[4 + e] = bf2f(qraw[4 + e]) * rstd * g1[e]; }
    const u32x4 w = {cvtpk(x[0], x[1]), cvtpk(x[2], x[3]), cvtpk(x[4], x[5]), cvtpk(x[6], x[7])}; const bf16x8 qf = __builtin_bit_cast(bf16x8, w);
#pragma unroll
    for (int kb = 0; kb < 8; ++kb) { const bf16x8 kf = *(lds_frag_t)((kb < 4 ? rd : rd4) + (kb & 3) * 32 * MROW + d0 * 32); s[kb] = __builtin_amdgcn_mfma_f32_32x32x16_bf16(kf, qf, s[kb], 0, 0, 0); } }
  constexpr float C = 0.0625f * 1.4426950408889634f;
  float mx = s[0][0];
#pragma unroll
  for (int kb = 0; kb < 8; ++kb)
#pragma unroll
    for (int r = 0; r < 16; ++r) mx = fmaxf(mx, s[kb][r]);
  { auto rr = __builtin_amdgcn_permlane32_swap(__float_as_uint(mx), __float_as_uint(mx), false, false); mx = fmaxf(__uint_as_float(rr[0]), __uint_as_float(rr[1])); }
  const float mC = -mx * C; float ps = 0.f;
#pragma unroll
  for (int kb = 0; kb < 8; ++kb)
#pragma unroll
    for (int r = 0; r < 16; ++r) { s[kb][r] = __builtin_amdgcn_exp2f(fmaf(s[kb][r], C, mC)); ps += s[kb][r]; }
  { auto rr = __builtin_amdgcn_permlane32_swap(__float_as_uint(ps), __float_as_uint(ps), false, false); ps = __uint_as_float(rr[0]) + __uint_as_float(rr[1]); }
  bf16x8 pa[16];
#pragma unroll
  for (int kb = 0; kb < 8; ++kb) { ATT_PK4(s[kb], 0, pa[2 * kb]); ATT_PK4(s[kb], 8, pa[2 * kb + 1]); }
  __syncthreads();
  { const int srow = tid >> 5, sch = tid & 31;
#pragma unroll 4
    for (int i = 0; i < 16; ++i) *(bf16x8*)(lds + (srow + 16 * i) * MROW + sch * 16) = *reinterpret_cast<const bf16x8*>(VT + (long)(srow + 16 * i) * 256 + sch * 8); }
  __syncthreads();
  float* li_l = wsl + wid * 64;
  if (hi == 0) li_l[r32] = ps; asm volatile("s_waitcnt lgkmcnt(0)" ::: "memory");
  unsigned char* Ow = Ob + (long)(wid * QBLK) * ldo;
#pragma unroll
  for (int half = 0; half < 2; ++half) {
    f32x16 o[4];
#pragma unroll
    for (int c = 0; c < 4; ++c) o[c] = f32x16{};
#pragma unroll
    for (int ks = 0; ks < 16; ++ks)
#pragma unroll
      for (int c = 0; c < 4; ++c) { const bf16x8 vf = *(lds_frag_t)((half == 0 ? rd : rd4) + c * 32 * MROW + ks * 32); o[c] = __builtin_amdgcn_mfma_f32_32x32x16_bf16(pa[ks], vf, o[c], 0, 0, 0); }
#pragma unroll
    for (int r = 0; r < 16; ++r) { const int orow = crow(r, hi); const float rl = 64.0f * __builtin_amdgcn_rcpf(li_l[orow]);
#pragma unroll
      for (int c = 0; c < 4; ++c) Ow[(long)orow * ldo + (half * 4 + c) * 32 + r32] = (unsigned char)(__builtin_amdgcn_cvt_pk_fp8_f32(o[c][r] * rl, 0.f, 0, false) & 0xff); } }
  __syncthreads();
}
#undef SBAR
#undef ATT_PK4
}

#define GAS __attribute__((address_space(1)))
#define LAS __attribute__((address_space(3)))
typedef unsigned short bf16;
typedef unsigned v4u __attribute__((ext_vector_type(4)));
typedef float f32x4 __attribute__((ext_vector_type(4)));
typedef short bf16x8 __attribute__((ext_vector_type(8)));
typedef GAS unsigned gu32;
typedef GAS unsigned long long gu64;
#define RLX_AGENT __ATOMIC_RELAXED, __HIP_MEMORY_SCOPE_AGENT
#define LDS_WAIT() asm volatile("s_waitcnt lgkmcnt(0)" ::: "memory")
#define VM_WAIT() asm volatile("s_waitcnt vmcnt(0)" ::: "memory")
__device__ __forceinline__ unsigned long long rt() { return __builtin_amdgcn_s_memrealtime(); }
__device__ __forceinline__ unsigned f2bf(float f) { unsigned u = __builtin_bit_cast(unsigned, f); return (u + 0x7fffu + ((u >> 16) & 1u)) >> 16; }
__device__ __forceinline__ unsigned pk2(float lo, float hi) { return f2bf(lo) | (f2bf(hi) << 16); }

#define XB_TMO      128
#define XB_XCNT(j)  (256  + 64 * (j))
#define XB_XSUB(j)  (1280 + 64 * (j))
#define XB_XGEN(j)  (2304 + 64 * (j))
#define XB_TOP      3328
#define XB_TOPGEN   3392
#define XCD_BAR_WORDS 3456
#define XB_SPIN_CAP (1u << 18)

__device__ __forceinline__ unsigned xb_ld(unsigned* p)              { return __hip_atomic_load(p, __ATOMIC_RELAXED, __HIP_MEMORY_SCOPE_AGENT); }
__device__ __forceinline__ unsigned xb_add(unsigned* p, unsigned v) { return __hip_atomic_fetch_add(p, v, __ATOMIC_RELAXED, __HIP_MEMORY_SCOPE_AGENT); }
__device__ __forceinline__ unsigned xb_xcc_id() { return (unsigned)__builtin_amdgcn_s_getreg((3 << 11) | 20) & 0xFu; }
#define XB_SPIN(cond, bar) do { unsigned _sp = 0; while (cond) { __builtin_amdgcn_s_sleep(1); \
    if ((++_sp & 255u) == 0u) { if (xb_ld(&(bar)[XB_TMO])) break; if (_sp > XB_SPIN_CAP) { atomicAdd(&(bar)[XB_TMO], 1u); break; } } } } while (0)

struct XcdBarrier {
    unsigned* bar; unsigned x;
    volatile LAS unsigned* st;
};

__device__ __forceinline__ XcdBarrier xcd_barrier_post(unsigned* bar, volatile LAS unsigned* st) {
    XcdBarrier b; b.bar = bar; b.x = xb_xcc_id(); b.st = st;
    if (threadIdx.x == 0) (void)xb_add(&bar[XB_XCNT(b.x)], 1u);
    return b;
}
__device__ __forceinline__ void xcd_barrier_complete(unsigned* bar, unsigned x, unsigned& nloc, unsigned& nx) {
    const unsigned G = gridDim.x * gridDim.y * gridDim.z;
    unsigned sum, cnt, mine, sp = 0u;
    for (;;) {
        sum = 0u; cnt = 0u; mine = 0u;
#pragma unroll
        for (unsigned j = 0; j < 16; ++j) { const unsigned c = xb_ld(&bar[XB_XCNT(j)]); sum += c; cnt += (c > 0u) ? 1u : 0u; mine = (j == x) ? c : mine; }
        if (sum == G) break;
        __builtin_amdgcn_s_sleep(1);
        if ((++sp & 255u) == 0u) { if (xb_ld(&bar[XB_TMO])) break; if (sp > XB_SPIN_CAP) { atomicAdd(&bar[XB_TMO], 1u); break; } }
    }
    nloc = mine > 0u ? mine : 1u; nx = cnt > 0u ? cnt : 1u;
}

__device__ __forceinline__ void xcd_barrier(const XcdBarrier& b) {
    asm volatile("s_waitcnt vmcnt(0)" ::: "memory");
    __syncthreads();
    if (threadIdx.x == 0) {
        unsigned* bar = b.bar;
        __builtin_amdgcn_s_waitcnt(0);
        unsigned nloc = b.st[0], nx = b.st[1];
        if (nloc == 0u) { xcd_barrier_complete(bar, b.x, nloc, nx); b.st[0] = nloc; b.st[1] = nx; }
        const unsigned old = xb_add(&bar[XB_XSUB(b.x)], 1u);
        const unsigned gen = old / nloc;
        if (old + 1u == (gen + 1u) * nloc) {
            __builtin_amdgcn_fence(__ATOMIC_RELEASE, "agent");
            asm volatile("s_waitcnt vmcnt(0)" ::: "memory");
            const unsigned og = xb_add(&bar[XB_TOP], 1u);
            const unsigned tg = og / nx;
            if (og + 1u == (tg + 1u) * nx) xb_add(&bar[XB_TOPGEN], 1u);
            else XB_SPIN(xb_ld(&bar[XB_TOPGEN]) == tg, bar);
            __builtin_amdgcn_fence(__ATOMIC_ACQUIRE, "agent");
            xb_add(&bar[XB_XGEN(b.x)], 1u);
            asm volatile("s_waitcnt vmcnt(0)" ::: "memory");
        } else {
            XB_SPIN(xb_ld(&bar[XB_XGEN(b.x)]) == gen, bar);
            __builtin_amdgcn_fence(__ATOMIC_ACQUIRE, "agent");
            asm volatile("s_waitcnt vmcnt(0)" ::: "memory");
        }
    }
    __syncthreads();
}
constexpr int NWAVES = 8;
constexpr int BATCH = 2, SEQ = 8192, DM = 4096, DFF = 6144, DEPTH = 4, M = BATCH * SEQ;
constexpr int MEMT = 256, MEMR = BATCH * MEMT;
constexpr int NH = 24, HD = 128, TOKW = 3072, MEMW = 1024, MEMHD = 256;
constexpr int A_QL = 1024, A_KVL = 512, A_ROPE = 64, A_IN = 2624, A_INP = 2816, A_QBN = 4608, A_KVBN = 6144, A_KW = NH * 192;
constexpr int B_IN = 5632, B_KVH = 6, B_KW = B_KVH * HD;
constexpr float EPS = 1e-6f;

constexpr size_t MiB = 1u << 20;
constexpr size_t CTL_ZERO_BYTES = 1 * MiB;
constexpr size_t WS_CTL = 0;
constexpr size_t WS_ROPE = 1 * MiB;
constexpr size_t WS_COSA = WS_ROPE, WS_SINA = WS_ROPE + 1 * MiB, WS_COSB = WS_ROPE + 2 * MiB, WS_SINB = WS_ROPE + 4 * MiB;
constexpr size_t WS_PAR = 7 * MiB;
constexpr int PAR_MQ = 0, PAR_QN = 1024, PAR_QP = 1280, PAR_KN = 1408, PAR_KP = 1664, PAR_BQ = 1792, PAR_BK = 2048, PAR_N = 2304;
constexpr size_t WS_RSTD = 7 * MiB + 64 * 1024;
constexpr size_t WS_W = 8 * MiB;
constexpr size_t SZ_GU = (size_t)2 * DFF * DM * 2, SZ_DN = (size_t)DM * DFF * 2, SZ_WO = (size_t)DM * DM * 2;
constexpr size_t SZ_LAYER = 2 * SZ_GU + 2 * SZ_DN + SZ_WO;
constexpr size_t OFF_GU1 = 0, OFF_DN1 = SZ_GU, OFF_GU2 = SZ_GU + SZ_DN, OFF_DN2 = 2 * SZ_GU + SZ_DN, OFF_WO = 2 * SZ_GU + 2 * SZ_DN;
constexpr size_t WS_WMEM = WS_W + DEPTH * SZ_LAYER;
constexpr size_t SZ_AIN = (size_t)A_INP * DM * 2, SZ_AQB = (size_t)A_QBN * A_QL * 2, SZ_AKVB = (size_t)A_KVBN * A_KVL * 2, SZ_A = SZ_AIN + SZ_AQB + SZ_AKVB;
constexpr size_t WS_WA = WS_WMEM + 64 * MiB;
constexpr size_t SZ_BIN = (size_t)B_IN * DM * 2;
constexpr size_t WS_WB = WS_WA + 2 * SZ_A;
constexpr size_t WS_ACT = WS_WB + 2 * SZ_BIN;
constexpr size_t WS_XN = WS_ACT;
constexpr size_t WS_XH = WS_XN + (size_t)M * DM * 2;
constexpr size_t WS_H = WS_XH + (size_t)M * DM * 2;
constexpr size_t WS_O = WS_H + (size_t)M * DFF * 2;
constexpr size_t WS_QM = WS_O + (size_t)M * DM * 2;
constexpr size_t WS_T0 = WS_QM + (size_t)M * MEMW * 2;
constexpr size_t WS_CQ = WS_T0, WS_CKV = WS_CQ + (size_t)M * 1024 * 2, WS_CQN = WS_CKV + (size_t)M * 768 * 2, WS_CKVN = WS_CQN + (size_t)M * 1024 * 2;
constexpr size_t WS_QA = WS_CKVN + (size_t)M * 512 * 2, WS_KVR = WS_QA + (size_t)M * A_QBN * 2, WS_K192 = WS_KVR + (size_t)M * A_KVBN * 2, WS_AEND = WS_K192 + (size_t)M * A_KW * 2;
constexpr size_t WS_QB = WS_T0, WS_KBR = WS_QB + (size_t)M * TOKW * 2, WS_VB = WS_KBR + (size_t)M * B_KW * 2, WS_KB = WS_VB + (size_t)M * B_KW * 2;
constexpr size_t WS_MEMN = WS_AEND;
constexpr size_t WS_MEMKV = WS_MEMN + (size_t)MEMR * DM * 2;
constexpr size_t WS_MK = WS_MEMKV + (size_t)MEMR * 8192 * 2;
constexpr size_t WS_MVT = WS_MK + (size_t)DEPTH * MEMR * 1024 * 2;
constexpr size_t WS_PROBE = WS_MVT + (size_t)DEPTH * MEMR * 1024 * 2;
constexpr size_t WS_RSP = WS_PROBE;
constexpr size_t WS_RSPA = WS_RSP + (size_t)M * 16 * 4;
constexpr size_t WS_END = WS_RSPA + (size_t)M * 16 * 4;
constexpr size_t WS_VT8A = WS_K192 + (size_t)M * A_KW, WS_VT8B = WS_KB + (size_t)M * B_KW;
constexpr size_t WS_X8 = WS_O + (size_t)M * DM;
constexpr size_t OFF_AQM = 8 * MiB, OFF_BQM = 20 * MiB;
constexpr int CW_BAR = 4096;

constexpr int RING_OFF = 0, RING_BYTES = 131072;
constexpr int LDSCTL_OFF = att::MEM_LDS_BYTES, MISC_OFF = LDSCTL_OFF + 320, WSL_OFF = LDSCTL_OFF + 2048;
constexpr int EPI_RED_OFF = WSL_OFF + 2048, EPI_RS_OFF = EPI_RED_OFF + 4096;
constexpr int LDS_BYTES = 147456;
static_assert(2 * 66560 <= att::MEM_LDS_BYTES && att::Cfg<192>::LDS_BYTES <= RING_BYTES && att::MEM_LDS_BYTES >= RING_BYTES && EPI_RS_OFF + 1024 <= LDS_BYTES && EPI_RED_OFF + 8192 <= LDS_BYTES && WSL_OFF + 9216 <= LDS_BYTES, "LDS map");

typedef float f32x4 __attribute__((ext_vector_type(4)));
typedef short bf16x8 __attribute__((ext_vector_type(8)));

struct Args { const float* in[26]; float* out; unsigned char* ws; };

__device__ __forceinline__ unsigned char* opq_ptr(unsigned char* p) { GAS unsigned char* g = (GAS unsigned char*)p; asm volatile("" : "+s"(g)); return (unsigned char*)g; }
struct Frame { LAS unsigned char* lds; int tid, lane, wave, vcu, G, bx, gw, NGW; };

template <int O> __device__ __forceinline__ float xor_add(float v) {
    if constexpr (O == 32) { auto rr = __builtin_amdgcn_permlane32_swap(__float_as_uint(v), __float_as_uint(v), false, false); return __uint_as_float(rr[0]) + __uint_as_float(rr[1]); }
    else return v + __int_as_float(__builtin_amdgcn_ds_swizzle(__float_as_int(v), (O << 10) | 0x1f));
}
template <int LANES> __device__ __forceinline__ float group_sum(float v) {
    if constexpr (LANES > 1) v = xor_add<1>(v);
    if constexpr (LANES > 2) v = xor_add<2>(v);
    if constexpr (LANES > 4) v = xor_add<4>(v);
    if constexpr (LANES > 8) v = xor_add<8>(v);
    if constexpr (LANES > 16) v = xor_add<16>(v);
    if constexpr (LANES > 32) v = xor_add<32>(v);
    return v;
}
__device__ __forceinline__ float wave_sum(float v) { return group_sum<64>(v); }
__device__ __forceinline__ float bf2f(short s) { return __uint_as_float(((unsigned)(unsigned short)s) << 16); }

__device__ __forceinline__ int dst_row(int kind, int n0, int row_off) {
    switch (kind) {
        case 1: { const int up = n0 >= DFF, f = up ? n0 - DFF : n0; return 256 * (f >> 7) + (f & 127) + (up ? 128 : 0); }
        case 2: return n0 < 1024 ? n0 : (n0 < 1600 ? n0 + 1024 : (n0 < 2624 ? n0 - 576 : n0));
        case 3: { const int h = n0 / 192, d = n0 % 192; return d < 128 ? h * 128 + d : 3072 + h * 64 + (d - 128); }
        case 4: { const int h = n0 >> 8, d = n0 & 255; return d < 128 ? h * 128 + d : 3072 + h * 128 + (d - 128); }
        default: return n0 + row_off;
    }
}
struct TrItem { f32x4 a[8], b[8]; };
__device__ __forceinline__ void tr_load(TrItem& t, const float* W, int K, int N, const float* gain, int item, int lane) {
    const int nblk = N >> 6, kb = item / nblk, nb = item - kb * nblk, k0 = 64 * kb, n0 = 64 * nb, c4 = (lane & 15) * 4, rq = lane >> 4;
    const GAS f32x4* src = (const GAS f32x4*)(W + (size_t)(k0 + 2 * rq) * N + n0 + c4); const size_t rs = (size_t)(N >> 2);
#pragma unroll
    for (int i = 0; i < 8; ++i) { t.a[i] = src[(size_t)(8 * i) * rs]; t.b[i] = src[(size_t)(8 * i + 1) * rs]; }
    (void)K; (void)gain;
}
__device__ __forceinline__ void tr_store(const TrItem& t, int K, int N, bf16* WT, int kind, int row_off, const float* gain, LAS unsigned* scr, int item, int lane) {
    const int nblk = N >> 6, kb = item / nblk, nb = item - kb * nblk, k0 = 64 * kb, n0 = 64 * nb, c4 = (lane & 15) * 4, rq = lane >> 4;
    const int r0 = dst_row(kind, n0, row_off);
#pragma unroll
    for (int i = 0; i < 8; ++i) { const float ga = gain ? gain[k0 + 8 * i + 2 * rq] : 1.0f, gb = gain ? gain[k0 + 8 * i + 2 * rq + 1] : 1.0f;
#pragma unroll
        for (int c = 0; c < 4; ++c) scr[(c4 + c) * 33 + 4 * i + rq] = pg8::cvt_pk_bf16(t.a[i][c] * ga, t.b[i][c] * gb); }
    LDS_WAIT(); asm volatile("" ::: "memory");
    const int q = lane & 7;
#pragma unroll
    for (int j = 0; j < 8; ++j) { const int n = 8 * j + (lane >> 3); const LAS unsigned* sp = scr + n * 33 + 4 * q;
        v4u o; o.x = sp[0]; o.y = sp[1]; o.z = sp[2]; o.w = sp[3];
        *(GAS v4u*)(WT + (size_t)(r0 + n) * K + k0 + 8 * q) = o; }
    LDS_WAIT(); asm volatile("" ::: "memory");
}
__device__ __forceinline__ void convert_weight(const Frame& F, const float* W, int K, int N, bf16* WT, int kind, int row_off, const float* gain) {
    LAS unsigned* scr = (LAS unsigned*)(F.lds + RING_OFF + F.wave * 16384);
    const int nitems = (K >> 6) * (N >> 6); const int lane = F.lane;
    TrItem ta, tb; int it = F.gw;
    if (it < nitems) tr_load(ta, W, K, N, gain, it, lane);
    for (; it < nitems; it += 2 * F.NGW) {
        const int it1 = it + F.NGW, it2 = it + 2 * F.NGW;
        if (it1 < nitems) tr_load(tb, W, K, N, gain, it1, lane);
        tr_store(ta, K, N, WT, kind, row_off, gain, scr, it, lane);
        if (it1 < nitems) { if (it2 < nitems) tr_load(ta, W, K, N, gain, it2, lane);
                            tr_store(tb, K, N, WT, kind, row_off, gain, scr, it1, lane); }
    }
}
constexpr int TRW_ROW = 65, TRW_BUF = 256 * TRW_ROW * 4;
__device__ __forceinline__ void convert_weight_wg(const Frame& F, const float* W  , int K, int N  , int NS  , bf16* WT, int kind, int row_off, const float* gain, bool fp8, float wsc = 1.0f  ) {
    const int nblk = (N + 255) >> 8, ntiles = (K >> 7) * nblk, lane = F.lane, w = F.wave;
    f32x4 a[8], b[8]; int tile = F.vcu, par = 0;
    const size_t rs = (size_t)(NS >> 2);
#define TRW_LOAD(t_) do { const int kb_ = (t_) / nblk, nb_ = (t_) - kb_ * nblk; const GAS f32x4* src_ = (const GAS f32x4*)(W + (size_t)(128 * kb_ + 16 * w) * NS + 256 * nb_ + 4 * lane); \
        if (256 * nb_ + 4 * lane < N) { _Pragma("unroll") for (int i = 0; i < 8; ++i) { a[i] = src_[(size_t)(2 * i) * rs]; b[i] = src_[(size_t)(2 * i + 1) * rs]; } } \
        else { _Pragma("unroll") for (int i = 0; i < 8; ++i) { a[i] = (f32x4){0.f, 0.f, 0.f, 0.f}; b[i] = (f32x4){0.f, 0.f, 0.f, 0.f}; } } } while (0)
    if (tile < ntiles) TRW_LOAD(tile);
    for (; tile < ntiles; tile += F.G, par ^= 1) {
        const int kb = tile / nblk, nb = tile - kb * nblk, k0 = 128 * kb, n0 = 256 * nb;
        LAS unsigned* img = (LAS unsigned*)(F.lds + par * TRW_BUF);
        if (!fp8) {
#pragma unroll
        for (int i = 0; i < 8; ++i) { const float ga = gain ? gain[k0 + 16 * w + 2 * i] : 1.0f, gb = gain ? gain[k0 + 16 * w + 2 * i + 1] : 1.0f;
#pragma unroll
            for (int c = 0; c < 4; ++c) img[(c * 64 + lane) * TRW_ROW + 8 * w + i] = pg8::cvt_pk_bf16(a[i][c] * ga, b[i][c] * gb); }
        } else {
#pragma unroll
        for (int q = 0; q < 4; ++q) { const int kk = k0 + 16 * w + 4 * q; const float g0 = (gain ? gain[kk] : 1.0f) * wsc, g1 = (gain ? gain[kk + 1] : 1.0f) * wsc, g2 = (gain ? gain[kk + 2] : 1.0f) * wsc, g3 = (gain ? gain[kk + 3] : 1.0f) * wsc;
#pragma unroll
            for (int c = 0; c < 4; ++c) img[(c * 64 + lane) * TRW_ROW + 4 * w + q] = (unsigned)__builtin_amdgcn_cvt_pk_fp8_f32(a[2 * q + 1][c] * g2, b[2 * q + 1][c] * g3, __builtin_amdgcn_cvt_pk_fp8_f32(a[2 * q][c] * g0, b[2 * q][c] * g1, 0, false), true); }
        }
        if (tile + F.G < ntiles) TRW_LOAD(tile + F.G);
        asm volatile("s_waitcnt lgkmcnt(0)" ::: "memory"); __builtin_amdgcn_s_barrier(); asm volatile("" ::: "memory");
        if (!fp8) {
        const int q = lane & 15;
#pragma unroll
        for (int j = 0; j < 8; ++j) { const int r = 32 * w + 4 * j + (lane >> 4), n = 4 * (r & 63) + (r >> 6); const LAS unsigned* sp = img + r * TRW_ROW + 4 * q;
            v4u o; o.x = sp[0]; o.y = sp[1]; o.z = sp[2]; o.w = sp[3];
            const int dr = dst_row(kind, n0 + (n & ~63), row_off) + (n & 63);
            *(GAS v4u*)(WT + (size_t)dr * K + k0 + 8 * q) = o; }
        } else {
        const int q = lane & 7;
#pragma unroll
        for (int j = 0; j < 4; ++j) { const int r = 32 * w + 8 * j + (lane >> 3), n = 4 * (r & 63) + (r >> 6); const LAS unsigned* sp = img + r * TRW_ROW + 4 * q;
            v4u o; o.x = sp[0]; o.y = sp[1]; o.z = sp[2]; o.w = sp[3];
            const int dr = dst_row(kind, n0 + (n & ~63), row_off) + (n & 63);
            *(GAS v4u*)((unsigned char*)WT + (size_t)dr * K + k0 + 16 * q) = o; }
        }
    }
#undef TRW_LOAD
    asm volatile("s_waitcnt lgkmcnt(0)" ::: "memory"); __builtin_amdgcn_s_barrier(); asm volatile("" ::: "memory");
}
__device__ __forceinline__ void xnorm_rows(const Frame& F, const float* x, bf16* xn, int nrows) {
    const int lane = pg8::opq_lane();
    for (int m = F.gw; m < nrows; m += F.NGW) {
        const GAS f32x4* xr = (const GAS f32x4*)(x + (size_t)m * DM) + lane;
        f32x4 v[16]; float s = 0.f;
#pragma unroll
        for (int j = 0; j < 16; ++j) { v[j] = xr[64 * j]; s += (v[j].x * v[j].x + v[j].y * v[j].y) + (v[j].z * v[j].z + v[j].w * v[j].w); }
        const float rstd = 1.0f / sqrtf(wave_sum(s) * (1.0f / DM) + EPS);
        GAS unsigned long long* o8 = (GAS unsigned long long*)(xn + (size_t)m * DM) + lane;
#pragma unroll
        for (int j = 0; j < 16; ++j) o8[64 * j] = (unsigned long long)pk2(v[j].x * rstd, v[j].y * rstd) | ((unsigned long long)pk2(v[j].z * rstd, v[j].w * rstd) << 32);
    }
}
#ifndef RS_LO
#define RS_LO(w) pg8::f16_lo(w)
#define RS_HI(w) pg8::f16_hi(w)
#endif
__device__ __forceinline__ void row_stats(const Frame& F, const bf16* xb, float* rstd, unsigned char* x8  ) {
    const int lane = pg8::opq_lane();
    typedef unsigned v2u __attribute__((ext_vector_type(2)));
    for (int rb = F.gw; rb < M / 16; rb += F.NGW) {
        const GAS v4u* p = (const GAS v4u*)(xb + (size_t)rb * 128 * 512) + lane; float ss = 0.f;
        GAS unsigned char* q8 = (GAS unsigned char*)x8 + ((size_t)rb * 64 * 16 + (lane >> 2)) * 64 + 8 * (lane & 3);
#pragma unroll 1
        for (int c0 = 0; c0 < 128; c0 += 16) { v4u v[16];
#pragma unroll
            for (int c = 0; c < 16; ++c) v[c] = p[(c0 + c) * 64];
#pragma unroll
            for (int c = 0; c < 16; ++c) { float f[8];
#pragma unroll
                for (int e = 0; e < 4; ++e) { f[2 * e] = RS_LO(v[c][e]); f[2 * e + 1] = RS_HI(v[c][e]); ss += f[2 * e] * f[2 * e] + f[2 * e + 1] * f[2 * e + 1]; }
                if (x8) { v2u w8;
                    w8.x = (unsigned)__builtin_amdgcn_cvt_pk_fp8_f32(f[2], f[3], __builtin_amdgcn_cvt_pk_fp8_f32(f[0], f[1], 0, false), true);
                    w8.y = (unsigned)__builtin_amdgcn_cvt_pk_fp8_f32(f[6], f[7], __builtin_amdgcn_cvt_pk_fp8_f32(f[4], f[5], 0, false), true);
                    *(GAS v2u*)(q8 + (c >> 1) * 1024 + (c & 1) * 32) = w8; } }
            q8 += 8 * 1024; }
        ss = group_sum<4>(ss);
        if ((lane & 3) == 0) rstd[rb * 16 + (lane >> 2)] = 1.0f / sqrtf(ss * (1.0f / DM) + EPS);
    }
}
__device__ __forceinline__ void xcast_blocked(const Frame& F, const float* x, bf16* xh, bf16* xb, float* rstd, float* rsp) {
    const int lane = pg8::opq_lane();
    for (int rb = F.gw; rb < M / 16; rb += F.NGW) {
        const GAS f32x4* src = (const GAS f32x4*)(x + (size_t)(rb * 16 + (lane >> 2)) * DM + 8 * (lane & 3)); GAS v4u* dst = (GAS v4u*)(xh + (size_t)rb * 128 * 512) + lane; GAS v4u* dstb = (GAS v4u*)(xb + (size_t)rb * 128 * 512) + lane; float ss = 0.f;
#pragma unroll 2
        for (int c0 = 0; c0 < 128; c0 += 8) { f32x4 a[8], b[8];
#pragma unroll
            for (int c = 0; c < 8; ++c) { a[c] = src[(c0 + c) * 8]; b[c] = src[(c0 + c) * 8 + 1]; }
#pragma unroll
            for (int c = 0; c < 8; ++c) { v4u w; w.x = pg8::cvt_pk_f16(a[c].x, a[c].y); w.y = pg8::cvt_pk_f16(a[c].z, a[c].w); w.z = pg8::cvt_pk_f16(b[c].x, b[c].y); w.w = pg8::cvt_pk_f16(b[c].z, b[c].w); dst[(c0 + c) * 64] = w;
                v4u z; z.x = pk2(a[c].x, a[c].y); z.y = pk2(a[c].z, a[c].w); z.z = pk2(b[c].x, b[c].y); z.w = pk2(b[c].z, b[c].w); dstb[(c0 + c) * 64] = z;
#pragma unroll
                for (int e = 0; e < 4; ++e) { const float lo = pg8::f16_lo(w[e]), hi = pg8::f16_hi(w[e]); ss += lo * lo + hi * hi; } } }
        ss = group_sum<4>(ss);
        if ((lane & 3) == 0) rstd[rb * 16 + (lane >> 2)] = 1.0f / sqrtf(ss * (1.0f / DM) + EPS);
        *(GAS f32x4*)(rsp + (size_t)(rb * 16 + (lane >> 2)) * 16 + 4 * (lane & 3)) = (f32x4){(lane & 3) == 0 ? ss : 0.f, 0.f, 0.f, 0.f};
    }
}
template <int L, bool GAIN, bool ROPE, int REP, bool OUT8 = false, int U = 1  >
__device__ __forceinline__ void seg_norm(const Frame& F, const bf16* src, long src_ld, int src_ss, int spr, long nseg, bf16* dst, long dst_ld, int dst_ss, const float* gain, const float* cs, const float* sn) {
    constexpr int LPS = (L / 8 >= 64) ? 64 : L / 8, CPL = L / 8 / LPS, SPW = 64 / LPS;
    const int lane = pg8::opq_lane(), sl = lane % LPS, sg = lane / LPS;
    const long step = (long)F.NGW * SPW;
    for (long s0 = (long)F.gw * SPW; s0 < nseg; s0 += step * U) {
        bf16x8 raw[U][CPL];
#pragma unroll
        for (int u = 0; u < U; ++u) { const long seg = s0 + u * step + sg; if (seg < nseg) { const long row = seg / spr; const int si = (int)(seg % spr); const bf16* sp = src + row * src_ld + (long)si * src_ss;
#pragma unroll
            for (int c = 0; c < CPL; ++c) raw[u][c] = *(const bf16x8*)(sp + (c * LPS + sl) * 8); } }
#pragma unroll
        for (int u = 0; u < U; ++u) { const long seg = s0 + u * step + sg; if (seg >= nseg) continue;
        const long row = seg / spr; const int si = (int)(seg % spr);
        float ss = 0.f;
#pragma unroll
        for (int c = 0; c < CPL; ++c)
#pragma unroll
            for (int e = 0; e < 8; ++e) { const float f = bf2f(raw[u][c][e]); ss += f * f; }
        ss = group_sum<LPS>(ss);
        const float rstd = 1.0f / sqrtf(ss * (1.0f / L) + EPS);
        const int pos = (int)(row % SEQ);
#pragma unroll
        for (int c = 0; c < CPL; ++c) { const int e0 = (c * LPS + sl) * 8; float x[8];
#pragma unroll
            for (int e = 0; e < 8; ++e) x[e] = bf2f(raw[u][c][e]) * rstd;
            if (GAIN) { const f32x4 g0 = *(const f32x4*)(gain + e0), g1 = *(const f32x4*)(gain + e0 + 4);
#pragma unroll
                for (int e = 0; e < 4; ++e) { x[e] *= g0[e]; x[4 + e] *= g1[e]; } }
            if (ROPE) { const f32x4 cv = *(const f32x4*)(cs + (size_t)pos * (L / 2) + e0 / 2), sv = *(const f32x4*)(sn + (size_t)pos * (L / 2) + e0 / 2);
#pragma unroll
                for (int p = 0; p < 4; ++p) { const float a = x[2 * p], b = x[2 * p + 1]; x[2 * p] = a * cv[p] - b * sv[p]; x[2 * p + 1] = a * sv[p] + b * cv[p]; } }
            if constexpr (OUT8) {
                typedef unsigned v2u __attribute__((ext_vector_type(2))); v2u w8;
                w8.x = (unsigned)__builtin_amdgcn_cvt_pk_fp8_f32(x[2], x[3], __builtin_amdgcn_cvt_pk_fp8_f32(x[0], x[1], 0, false), true);
                w8.y = (unsigned)__builtin_amdgcn_cvt_pk_fp8_f32(x[6], x[7], __builtin_amdgcn_cvt_pk_fp8_f32(x[4], x[5], 0, false), true);
                unsigned char* dp = (unsigned char*)dst + row * dst_ld + (long)si * dst_ss + e0;
#pragma unroll
                for (int r = 0; r < REP; ++r) *(v2u*)(dp + (long)r * dst_ss) = w8;
            } else {
            v4u w; w.x = pk2(x[0], x[1]); w.y = pk2(x[2], x[3]); w.z = pk2(x[4], x[5]); w.w = pk2(x[6], x[7]);
            bf16* dp = dst + row * dst_ld + (long)si * dst_ss + e0;
#pragma unroll
            for (int r = 0; r < REP; ++r) *(v4u*)(dp + (long)r * dst_ss) = w; } } }
    }
}
__device__ __forceinline__ void sincos_d(float ang, float& c, float& s) {
    const double a = (double)ang, k = __builtin_rint(a * 0.63661977236758134308), r = __builtin_fma(-k, 1.57079632679489661923, a) - k * 6.123233995736766e-17, r2 = r * r;
    double sp = -7.6471637318198164759e-13; sp = sp * r2 + 1.6059043836821614599e-10; sp = sp * r2 - 2.5052108385441718775e-08; sp = sp * r2 + 2.7557319223985890653e-06; sp = sp * r2 - 1.9841269841269841270e-04;
    sp = sp * r2 + 8.3333333333333333333e-03; sp = sp * r2 - 1.6666666666666666667e-01; sp = sp * r2 * r + r;
    double cp = 4.7794773323873852974e-14; cp = cp * r2 - 1.1470745597729724714e-11; cp = cp * r2 + 2.0876756987868098979e-09; cp = cp * r2 - 2.7557319223985890653e-07; cp = cp * r2 + 2.4801587301587301587e-05;
    cp = cp * r2 - 1.3888888888888888889e-03; cp = cp * r2 + 4.1666666666666666667e-02; cp = cp * r2 - 0.5; cp = cp * r2 + 1.0;
    const int q = ((int)k) & 3;
    const double cc = (q == 0) ? cp : (q == 1) ? -sp : (q == 2) ? -cp : sp, sv = (q == 0) ? sp : (q == 1) ? cp : (q == 2) ? -sp : -cp;
    c = (float)cc; s = (float)sv;
}
__device__ __forceinline__ float inv_freq(int axis_dim, int j) {
    constexpr float FA[16] = {1.f, 0.562341332f, 0.316227764f, 0.177827939f, 0.100000001f, 0.0562341325f, 0.0316227749f, 0.0177827943f, 0.00999999978f, 0.00562341325f, 0.00316227763f, 0.00177827943f, 0.00100000005f, 0.000562341302f, 0.000316227757f, 0.00017782794f};
    constexpr float FB[32] = {1.f, 0.749894261f, 0.562341332f, 0.421696514f, 0.316227764f, 0.237137377f, 0.177827939f, 0.133352131f, 0.100000001f, 0.0749894157f, 0.0562341325f, 0.0421696529f, 0.0316227749f, 0.0237137377f, 0.0177827943f, 0.0133352149f,
                              0.00999999978f, 0.00749894185f, 0.00562341325f, 0.00421696482f, 0.00316227763f, 0.00237137359f, 0.00177827943f, 0.00133352145f, 0.00100000005f, 0.000749894243f, 0.000562341302f, 0.000421696517f, 0.000316227757f, 0.00023713737f, 0.00017782794f, 0.00013335215f};
    return axis_dim == 32 ? FA[j] : FB[j];
}

#ifndef QM_FP8
#define QM_FP8 true
#endif
#ifndef ATT_RING_A
#define ATT_RING_A true
#endif
#ifndef ATT_RING_B
#define ATT_RING_B true
#endif
#ifndef ATT_SD_A
#define ATT_SD_A 1
#endif
#ifndef ATT_SD_B
#define ATT_SD_B 1
#endif
__device__ __forceinline__ void vt_fp8(const Frame& F, const bf16* V, int ldv, int NHV, unsigned char* VT) {
    const int lane = pg8::opq_lane(), ncb = NHV * 2, nitems = (M / 64) * ncb;
    LAS unsigned char* img = F.lds + RING_OFF + F.wave * 16384; constexpr int IROW = 132;
    for (int it = F.gw; it < nitems; it += F.NGW) {
        const int kt = it / ncb, ct = it - kt * ncb, k0 = 64 * kt, c = 64 * ct + lane, b = k0 / SEQ;
        const bf16* src = V + (size_t)(k0 + (lane >> 3)) * ldv + 64 * ct + 8 * (lane & 7);
        v4u t[8];
#pragma unroll
        for (int i = 0; i < 8; ++i) t[i] = *(const GAS v4u*)(src + (size_t)(8 * i) * ldv);
#pragma unroll
        for (int i = 0; i < 8; ++i) { LAS unsigned* d = (LAS unsigned*)(img + ((lane >> 3) + 8 * i) * IROW + 16 * (lane & 7)); d[0] = t[i].x; d[1] = t[i].y; d[2] = t[i].z; d[3] = t[i].w; }
        LDS_WAIT(); asm volatile("" ::: "memory");
        float v[64];
#pragma unroll
        for (int i = 0; i < 64; ++i) v[i] = __uint_as_float((unsigned)*(const LAS unsigned short*)(img + i * IROW + 2 * lane) << 16);
        LDS_WAIT(); asm volatile("" ::: "memory");
        unsigned char* dst = VT + ((size_t)(b * NHV + (c >> 7)) * 128 + (c & 127)) * SEQ + (k0 - b * SEQ);
#pragma unroll
        for (int g = 0; g < 2; ++g) { v4u w0, w1;
#pragma unroll
            for (int d = 0; d < 4; ++d) { const int kb = 32 * g + 8 * d;
                w0[d] = (unsigned)__builtin_amdgcn_cvt_pk_fp8_f32(v[kb + 2], v[kb + 3], __builtin_amdgcn_cvt_pk_fp8_f32(v[kb], v[kb + 1], 0, false), true);
                w1[d] = (unsigned)__builtin_amdgcn_cvt_pk_fp8_f32(v[kb + 6], v[kb + 7], __builtin_amdgcn_cvt_pk_fp8_f32(v[kb + 4], v[kb + 5], 0, false), true); }
            *(v4u*)(dst + 32 * g) = w0; *(v4u*)(dst + 32 * g + 16) = w1; }
    }
}
struct QRaw { att::bf16x8 v[4]; };
__device__ __forceinline__ QRaw q_load(const bf16* p) { QRaw r;
#pragma unroll
    for (int i = 0; i < 4; ++i) r.v[i] = *(const att::bf16x8*)(p + 8 * i);
    return r; }
__device__ __forceinline__ float q_ss(const QRaw& r) { float s = 0.f;
#pragma unroll
    for (int i = 0; i < 4; ++i)
#pragma unroll
        for (int e = 0; e < 8; ++e) { const float f = bf2f(r.v[i][e]); s += f * f; }
    return s; }
template <bool ROPE> __device__ __forceinline__ att::v8i_t q_fp8(const QRaw& r, float rstd, const float* gain32, const float* cos16, const float* sin16) {
    att::v8i_t o;
#pragma unroll
    for (int i = 0; i < 4; ++i) { const f32x4 g0 = *(const f32x4*)(gain32 + 8 * i), g1 = *(const f32x4*)(gain32 + 8 * i + 4); float x[8];
#pragma unroll
        for (int e = 0; e < 4; ++e) { x[e] = bf2f(r.v[i][e]) * rstd * g0[e]; x[4 + e] = bf2f(r.v[i][4 + e]) * rstd * g1[e]; }
        if (ROPE) { const f32x4 cv = *(const f32x4*)(cos16 + 4 * i), sv = *(const f32x4*)(sin16 + 4 * i);
#pragma unroll
            for (int p = 0; p < 4; ++p) { const float a = x[2 * p], c = x[2 * p + 1]; x[2 * p] = a * cv[p] - c * sv[p]; x[2 * p + 1] = a * sv[p] + c * cv[p]; } }
        o[2 * i] = __builtin_amdgcn_cvt_pk_fp8_f32(x[2], x[3], __builtin_amdgcn_cvt_pk_fp8_f32(x[0], x[1], 0, false), true);
        o[2 * i + 1] = __builtin_amdgcn_cvt_pk_fp8_f32(x[6], x[7], __builtin_amdgcn_cvt_pk_fp8_f32(x[4], x[5], 0, false), true); }
    return o; }
__device__ __forceinline__ int opq_i(int v) { asm volatile("" : "+s"(v)); return v; }
__device__ __forceinline__ Frame make_frame(LAS unsigned char* lds, const int wv) {
    Frame F; F.lds = lds; F.lane = pg8::opq_lane(); F.wave = opq_i(wv); F.tid = F.wave * 64 + F.lane;
    F.G = opq_i((int)gridDim.x); F.bx = opq_i((int)blockIdx.x); F.vcu = (F.G % 8 == 0) ? (F.bx % 8) * (F.G / 8) + F.bx / 8 : F.bx;
    F.gw = F.vcu * NWAVES + F.wave; F.NGW = F.G * NWAVES; return F;
}
template <class Epi, bool ABLK = false, bool FP8 = false, bool BBLK = false> __device__ __forceinline__ void gemm_site(LAS unsigned char* ldsp, const int wv, const void* A, const void* Bt, int Mr, int N, int K, const Epi& E, const int sc_w = 0x7f7f7f7f, const int sc_a = 0x7f7f7f7f) {
    const Frame F = make_frame(ldsp, wv);
    pg8::Gemm g{(const pg8::bf16_t*)A, (const pg8::bf16_t*)Bt, Mr, N, K}; pg8::StaticOrder S; S.init(Mr, N, F.G, F.bx);
    pg8::gemm_phase<Epi, pg8::StaticOrder, true, true, ABLK, FP8, BBLK>(F.lds + RING_OFF, g, S, E, wv, sc_w, sc_a);
}
__device__ __forceinline__ void conv_job(const Frame& F, const Args& args, unsigned char* ws, const int job) {
            const float* W; const float* gain = nullptr; int K, N, NS, kind = 0, row_off = 0; size_t dst; bool fp8 = false;
            if (job < 24) { const int l = job / 6, t = job % 6; const size_t lo = WS_W + (size_t)l * SZ_LAYER;
                if (t == 0)      { W = args.in[3] + (size_t)l * DM * 2 * DFF; K = DM; N = 2 * DFF; dst = lo + OFF_GU1; kind = 1; gain = args.in[2] + l * DM; }
                else if (t == 1) { W = args.in[4] + (size_t)l * DFF * DM; K = DFF; N = DM; dst = lo + OFF_DN1; }
                else if (t == 2) { W = args.in[12] + (size_t)l * DM * 2 * DFF; K = DM; N = 2 * DFF; dst = lo + OFF_GU2; kind = 1; gain = args.in[11] + l * DM; }
                else if (t == 3) { W = args.in[13] + (size_t)l * DFF * DM; K = DFF; N = DM; dst = lo + OFF_DN2; }
                else if (t == 4) { W = args.in[6] + (size_t)l * DM * DM; K = DM; N = DM; dst = lo + OFF_WO; fp8 = true; }
                else             { W = args.in[8] + (size_t)l * DM * 2048; K = DM; N = 2048; dst = WS_WMEM; row_off = l * 2048; gain = args.in[7] + l * DM; }
                NS = N;
            } else { const int j = (job - 24) / 6, t = (job - 24) % 6; const size_t ao = WS_WA + (size_t)j * SZ_A;
                if (t == 0)      { W = args.in[14] + (size_t)j * DM * A_IN; K = DM; N = 1600; NS = A_IN; dst = ao; gain = args.in[5] + (2 * j) * DM; fp8 = true; }
                else if (t == 1) { W = args.in[14] + (size_t)j * DM * A_IN + 1600; K = DM; N = 1024; NS = A_IN; dst = ao + OFF_AQM; gain = args.in[5] + (2 * j) * DM; fp8 = QM_FP8; }
                else if (t == 2) { W = args.in[17] + (size_t)j * A_QL * A_QBN; K = A_QL; N = A_QBN; NS = N; dst = ao + SZ_AIN; kind = 3; gain = args.in[15] + j * A_QL; fp8 = true; }
                else if (t == 3) { W = args.in[18] + (size_t)j * A_KVL * A_KVBN; K = A_KVL; N = A_KVBN; NS = N; dst = ao + SZ_AIN + SZ_AQB; kind = 4; gain = args.in[16] + j * A_KVL; fp8 = true; }
                else if (t == 4) { W = args.in[23] + (size_t)j * DM * B_IN; K = DM; N = 4608; NS = B_IN; dst = WS_WB + (size_t)j * SZ_BIN; gain = args.in[5] + (2 * j + 1) * DM; fp8 = true; }
                else             { W = args.in[23] + (size_t)j * DM * B_IN + 4608; K = DM; N = 1024; NS = B_IN; dst = WS_WB + (size_t)j * SZ_BIN + OFF_BQM; gain = args.in[5] + (2 * j + 1) * DM; fp8 = QM_FP8; }
            }
            const float wsc = (job < 24) ? 64.0f : ((((job - 24) % 6) == 2) ? 32.0f : ((((job - 24) % 6) == 3) ? 16.0f : 64.0f));
            convert_weight_wg(F, W, K, N, NS, (bf16*)(ws + dst), kind, row_off, gain, fp8, wsc);
}
__device__ __forceinline__ void conv_slot(LAS unsigned char* ldsp, const int wv, const Args& args, unsigned char* ws, const int l, const int k) {
    if (k > 6) return;
    const Frame F = make_frame(ldsp, wv);
    const int ln = l + 1, jb = 24 + (ln >> 1) * 6;
    if (k < 3) { conv_job(F, args, ws, l * 6 + (k == 0 ? 2 : k == 1 ? 3 : 4)); }
    else if (ln >= DEPTH) return;
    else if (k < 5) { conv_job(F, args, ws, ln * 6 + (k == 3 ? 0 : 1)); }
    else if ((ln & 1) == 0) { conv_job(F, args, ws, jb + (k == 5 ? 0 : 2)); conv_job(F, args, ws, jb + (k == 5 ? 1 : 3)); }
    else { conv_job(F, args, ws, jb + (k == 5 ? 4 : 5)); }
}
__global__ void __launch_bounds__(NWAVES * 64, 2) fwd_kernel(Args args) {
    extern __shared__ __attribute__((aligned(16))) unsigned char lds[];
    LAS unsigned char* const ldsp = (LAS unsigned char*)lds;
    unsigned char* const ws = args.ws;
    const int wv = __builtin_amdgcn_readfirstlane((int)threadIdx.x >> 6);
    { const int tid = threadIdx.x; for (int u = tid; u < (LDS_BYTES - LDSCTL_OFF) / 4; u += NWAVES * 64) ((LAS unsigned*)(ldsp + LDSCTL_OFF))[u] = 0u; }
    __syncthreads();
    XcdBarrier bar = xcd_barrier_post((unsigned*)(ws + WS_CTL) + CW_BAR, (volatile LAS unsigned*)(ldsp + MISC_OFF) + 8);
#define GRID_BAR() xcd_barrier(bar)
#define WSP (opq_ptr(ws))
#define OUTP ((float*)opq_ptr((unsigned char*)args.out))

#ifdef PROBE_PRO
    for (int rep_ = 0; rep_ < 2; ++rep_)
#endif
    {
        const Frame F = make_frame(ldsp, wv);
#ifdef PROBE_CONV
        for (int rep2_ = 0; rep2_ < 2; ++rep2_)
#endif
        for (int job = 0; job < 36; ++job) {
            if (!((job < 24 && ((job < 2 && F.G <= 64) || job % 6 == 5)) || (job >= 24 && job < 28))) continue;
            conv_job(F, args, ws, job);
        }
        { float* par = (float*)(ws + WS_PAR);
          for (int i = F.gw * 64 + F.lane; i < PAR_N; i += F.NGW * 64) {
              float v;
              if (i < PAR_QN) v = args.in[9][i]; else if (i < PAR_QP) v = args.in[19][i - PAR_QN]; else if (i < PAR_KN) v = args.in[20][i - PAR_QP]; else if (i < PAR_KP) v = args.in[21][i - PAR_KN];
              else if (i < PAR_BQ) v = args.in[22][i - PAR_KP]; else if (i < PAR_BK) v = args.in[24][i - PAR_BQ]; else v = args.in[25][i - PAR_BK];
              par[i] = v; } }
        { float* cA = (float*)(ws + WS_COSA); float* sA = (float*)(ws + WS_SINA); float* cB = (float*)(ws + WS_COSB); float* sB = (float*)(ws + WS_SINB);
          for (int i = F.gw * 64 + F.lane; i < SEQ * 32; i += F.NGW * 64) { const int t = i >> 5, p = i & 31; const float pos = (float)(p < 16 ? (t >> 6) : (t & 63)); float c, s; sincos_d(pos * inv_freq(32, p & 15), c, s); cA[i] = c; sA[i] = s; }
          for (int i = F.gw * 64 + F.lane; i < SEQ * 64; i += F.NGW * 64) { const int t = i >> 6, p = i & 63; const float pos = (float)(p < 32 ? (t >> 6) : (t & 63)); float c, s; sincos_d(pos * inv_freq(64, p & 31), c, s); cB[i] = c; sB[i] = s; } }
        xnorm_rows(F, args.in[1], (bf16*)(ws + WS_MEMN), MEMR);
        xcast_blocked(F, args.in[0], (bf16*)(ws + WS_XH), (bf16*)(ws + WS_XN), (float*)(ws + WS_RSTD), (float*)(ws + WS_RSP));
    }
    GRID_BAR();
    { const Frame F = make_frame(ldsp, wv);
      if (F.G > 64 && F.bx >= 64) { Frame Fc = F; Fc.vcu = F.bx - 64; Fc.G = F.G - 64; conv_job(Fc, args, ws, 0); conv_job(Fc, args, ws, 1); } }
    { unsigned char* const w = WSP; typedef pg8::EpiBf16One<WS_MEMKV, 8192> EpiT; const EpiT E{w, nullptr, nullptr};
      gemm_site<EpiT>(ldsp, wv, w + WS_MEMN, w + WS_WMEM, MEMR, 8192, DM, E); }
    GRID_BAR();
    {
        const Frame F = make_frame(ldsp, wv); unsigned char* const w = WSP;
        for (int l = 0; l < DEPTH; ++l)
            seg_norm<256, true, false, 1>(F, (const bf16*)(w + WS_MEMKV) + l * 2048, 8192, 256, 4, (long)MEMR * 4, (bf16*)(w + WS_MK) + (size_t)l * MEMR * 1024, 1024, 256, args.in[10] + l * MEMHD, nullptr, nullptr);
        const bf16* mkv = (const bf16*)(w + WS_MEMKV); bf16* vt = (bf16*)(w + WS_MVT);
        for (int i = F.gw * 64 + F.lane; i < DEPTH * BATCH * 4 * 256 * 32; i += F.NGW * 64) {
            const int col = i & 255, kc = (i >> 8) & 31, mh = (i >> 13) & 3, b = (i >> 15) & 1, l = i >> 16;
            const bf16* sp = mkv + (size_t)(b * 256 + kc * 8) * 8192 + l * 2048 + 1024 + mh * 256 + col;
            v4u o; o.x = (unsigned)sp[0] | ((unsigned)sp[8192] << 16); o.y = (unsigned)sp[2 * 8192] | ((unsigned)sp[3 * 8192] << 16); o.z = (unsigned)sp[4 * 8192] | ((unsigned)sp[5 * 8192] << 16); o.w = (unsigned)sp[6 * 8192] | ((unsigned)sp[7 * 8192] << 16);
            *(v4u*)(vt + ((size_t)((l * 2 + b) * 4 + mh) * 256 + col) * 256 + kc * 8) = o; }
    }

    for (int l = 0; l < DEPTH; ++l) {
        const size_t wl_off = WS_W + (size_t)l * SZ_LAYER;
#define isA ((opq_i(l) & 1) == 0)
#define j (opq_i(l) >> 1)
        for (int f = 0; f < 2; ++f) {
#ifdef PROBE_GU
            for (int rep_ = 0; rep_ < (f == 0 ? 2 : 1); ++rep_)
#endif
            { unsigned char* const w = WSP; const pg8::EpiSwiGLU E{(pg8::bf16_t*)(w + WS_H), DFF, (const float*)(w + WS_RSP), (LAS float*)(ldsp + EPI_RS_OFF)};
              gemm_site<pg8::EpiSwiGLU, true>(ldsp, wv, w + WS_XN, w + wl_off + (f ? OFF_GU2 : OFF_GU1), M, 2 * DFF, DM, E);
            GRID_BAR(); }
            if (opq_i(l) == DEPTH - 1 && opq_i(f) == 1) {
                unsigned char* const w = WSP; const pg8::EpiResidOut E{(const pg8::bf16_t*)(w + WS_XH), OUTP, DM, 0.5f};
                gemm_site<pg8::EpiResidOut, true>(ldsp, wv, w + WS_H, w + wl_off + OFF_DN2, M, DM, DFF, E);
                continue;
            }
            { unsigned char* const w = WSP; const pg8::EpiResidB E{(pg8::bf16_t*)(w + WS_XH), (pg8::bf16_t*)(w + WS_XN), 0.5f, (float*)(w + WS_RSP), (LAS float*)(ldsp + EPI_RED_OFF), opq_i(f) == 0 ? w + WS_X8 : nullptr};
              gemm_site<pg8::EpiResidB, true>(ldsp, wv, w + WS_H, w + wl_off + (f ? OFF_DN2 : OFF_DN1), M, DM, DFF, E); }
            GRID_BAR();
            if (opq_i(f) != 0) continue;
#ifdef PROBE_WIN
            for (int rep_ = 0; rep_ < 2; ++rep_)
#endif
            {
                unsigned char* const w = WSP; const float* const rs = (const float*)(w + WS_RSP); LAS float* const rl = (LAS float*)(ldsp + EPI_RS_OFF);
                typedef pg8::EpiBf16Seg<true, (1 << 30), (1 << 30), (1 << 30), WS_QM, 0, 0, 0, 1024, 0, 0, 0> EpiQM;
                typedef pg8::EpiBf16Seg<true, 4, (1 << 30), (1 << 30), WS_CQ, WS_CKV, 0, 0, 1024, 768, 0, 0> EpiA; typedef pg8::EpiBf16Seg<true, 12, 15, (1 << 30), WS_QB, WS_KBR, WS_VB, 0, 3072, 768, 768, 0> EpiB;
                { const EpiQM E{w, rs, rl}; if constexpr (QM_FP8) gemm_site<EpiQM, true, true>(ldsp, wv, w + WS_X8, isA ? w + WS_WA + (size_t)j * SZ_A + OFF_AQM : w + WS_WB + (size_t)j * SZ_BIN + OFF_BQM, M, 1024, DM / 2, E, 0x79797979);
                  else gemm_site<EpiQM, true>(ldsp, wv, w + WS_XN, isA ? w + WS_WA + (size_t)j * SZ_A + OFF_AQM : w + WS_WB + (size_t)j * SZ_BIN + OFF_BQM, M, 1024, DM, E); }
                if (isA) { typedef pg8::EpiA8<WS_CQN, WS_CKVN, WS_CKV, 768, 512, WS_RSP, WS_RSPA, EPI_RED_OFF, EPI_RS_OFF> EpiA8; const EpiA8 E{w, ldsp};
                           gemm_site<EpiA8, true, true>(ldsp, wv, w + WS_X8, w + WS_WA + (size_t)j * SZ_A, M, 1792, DM / 2, E, 0x79797979); }
                else { unsigned char* const wb = w + WS_WB + (size_t)j * SZ_BIN;
                    typedef pg8::EpiKNR8<128, WS_QB, TOKW, WS_COSB, WS_SINB, SEQ, WS_RSP, WSL_OFF, WSL_OFF + 8192> EpiBQ; typedef pg8::EpiKNR8<128, WS_KB, B_KW, WS_COSB, WS_SINB, SEQ, WS_RSP, WSL_OFF, WSL_OFF + 8192> EpiBK; typedef pg8::EpiVT8<B_KVH * 128, SEQ, WS_VT8B, true, WS_RSP, EPI_RS_OFF> EpiBV;
                    { const EpiBQ E{w, (const float*)(w + WS_PAR) + PAR_BQ + j * 128, ldsp, att::Cfg<128>::SCALE * 1.4426950408889634f};
                      gemm_site<EpiBQ, true, true>(ldsp, wv, w + WS_X8, wb, M, 3072, DM / 2, E, 0x79797979); }
                    { const EpiBK E{w, (const float*)(w + WS_PAR) + PAR_BK + j * 128, ldsp, 1.0f};
                      gemm_site<EpiBK, true, true>(ldsp, wv, w + WS_X8, wb + (size_t)3072 * DM, M, B_KW, DM / 2, E, 0x79797979); }
                    { const EpiBV E{w, ldsp};
                      gemm_site<EpiBV, false, true, true>(ldsp, wv, wb + (size_t)3840 * DM, w + WS_X8, B_KW, M, DM / 2, E, 0x7f7f7f7f, 0x79797979); } }
            GRID_BAR(); }
            if (isA) {
#ifdef PROBE_ELT
                for (int rep_ = 0; rep_ < 2; ++rep_)
#endif
                {
                    const Frame F = make_frame(ldsp, wv); unsigned char* const w = WSP;
                    seg_norm<64, true, true, 24, true>(F, (const bf16*)(w + WS_CKV) + 512, 768, 0, 1, M, (bf16*)(w + WS_K192 + 128), A_KW, 192, (const float*)(w + WS_PAR) + PAR_KP + j * 64, (const float*)(w + WS_COSA), (const float*)(w + WS_SINA)); }
#ifdef PROBE_QKVB
                for (int rep_ = 0; rep_ < 2; ++rep_) {
#endif
                { unsigned char* const w = WSP; typedef pg8::EpiQA8<WS_QA, A_QBN, WS_COSA, WS_SINA, SEQ, WS_RSPA, WSL_OFF, WSL_OFF + 8192> EpiT;
                  const EpiT E{w, (const float*)(w + WS_PAR) + PAR_QN + j * 128, (const float*)(w + WS_PAR) + PAR_QP + j * 64, ldsp, att::Cfg<192>::SCALE * 1.4426950408889634f};
                  gemm_site<EpiT, false, true>(ldsp, wv, w + WS_CQN, w + WS_WA + (size_t)j * SZ_A + SZ_AIN, M, A_QBN, A_QL / 2, E, 0x7a7a7a7a); }
                { unsigned char* const w = WSP; typedef pg8::EpiKN8<192, true, 4, 2, 512> EpiT; const EpiT E{w + WS_K192, A_KW, (const float*)(w + WS_PAR) + PAR_KN + j * 128, (LAS float*)(ldsp + WSL_OFF), (const float*)(w + WS_RSPA), (LAS float*)(ldsp + WSL_OFF + 8192)};
                  gemm_site<EpiT, false, true>(ldsp, wv, w + WS_CKVN, w + WS_WA + (size_t)j * SZ_A + SZ_AIN + SZ_AQB, M, 3072, A_KVL / 2, E, 0x7b7b7b7b); }
                { unsigned char* const w = WSP; typedef pg8::EpiVT8<NH * 128, SEQ, WS_VT8A, true, WS_RSPA, EPI_RS_OFF, 4, 2, 512> EpiT; const EpiT E{w, ldsp};
                  gemm_site<EpiT, false, true>(ldsp, wv, w + WS_WA + (size_t)j * SZ_A + SZ_AIN + SZ_AQB + (size_t)3072 * A_KVL, w + WS_CKVN, NH * 128, M, A_KVL / 2, E, 0x7f7f7f7f, 0x7b7b7b7b); }
                GRID_BAR();
#ifdef PROBE_QKVB
                }
#endif
            }
            int ks = 0; const int kpos = opq_i((int)blockIdx.x) % 7;
            if (isA) {
                const Frame F0 = make_frame(ldsp, wv);
                for (int u = F0.vcu; u < BATCH * NH * (SEQ / 256); u += F0.G) {
                    const Frame F = make_frame(ldsp, wv); const int r32 = F.lane & 31, hi = F.lane >> 5;
                    unsigned char* const w = WSP;
                    const int bh = u >> 5, qb = u & 31, b = bh / NH, h = bh % NH;
                    const long row = (long)b * SEQ + qb * 256 + F.wave * 32 + r32;
                    const unsigned char* qrow = (const unsigned char*)(w + WS_QA) + row * A_QBN + h * 192 + 32 * hi;
                    att::v8i_t qr[3];
#pragma unroll
                    for (int s = 0; s < 3; ++s) { const v4u a = *(const GAS v4u*)(qrow + 64 * s), c = *(const GAS v4u*)(qrow + 64 * s + 16);
                        qr[s] = (att::v8i_t){(int)a.x, (int)a.y, (int)a.z, (int)a.w, (int)c.x, (int)c.y, (int)c.z, (int)c.w}; }
                    att::attn_unit<192, ATT_SD_A, ATT_RING_A>(qr, (const unsigned char*)(w + WS_K192) + (size_t)b * SEQ * A_KW + h * 192, A_KW, (const unsigned char*)(w + WS_VT8A) + (size_t)(b * NH + h) * 128 * SEQ, SEQ,
                                                  (unsigned char*)(w + WS_O) + ((size_t)b * SEQ + qb * 256) * DM + h * 128, DM, SEQ, (char*)lds + RING_OFF, wv);
                    if (ks == kpos) { for (int k2 = 0; k2 < 7; ++k2) conv_slot(ldsp, wv, args, WSP, opq_i(l), k2); } ++ks;
                }
            } else {
                const Frame F0 = make_frame(ldsp, wv);
                for (int u = F0.vcu; u < BATCH * NH * (SEQ / 256); u += F0.G) {
                    const Frame F = make_frame(ldsp, wv); const int r32 = F.lane & 31, hi = F.lane >> 5;
                    unsigned char* const w = WSP;
                    const int bh = u >> 5, qb = u & 31, b = bh / NH, h = bh % NH;
                    const long row = (long)b * SEQ + qb * 256 + F.wave * 32 + r32;
                    const unsigned char* qrow = (const unsigned char*)(w + WS_QB) + row * TOKW + h * 128 + 32 * hi;
                    att::v8i_t qr[2];
#pragma unroll
                    for (int s = 0; s < 2; ++s) { const v4u a = *(const GAS v4u*)(qrow + 64 * s), c = *(const GAS v4u*)(qrow + 64 * s + 16);
                        qr[s] = (att::v8i_t){(int)a.x, (int)a.y, (int)a.z, (int)a.w, (int)c.x, (int)c.y, (int)c.z, (int)c.w}; }
                    const int kvh = h >> 2;
                    att::attn_unit<128, ATT_SD_B, ATT_RING_B>(qr, (const unsigned char*)(w + WS_KB) + (size_t)b * SEQ * B_KW + kvh * 128, B_KW, (const unsigned char*)(w + WS_VT8B) + (size_t)(b * B_KVH + kvh) * 128 * SEQ, SEQ,
                                                  (unsigned char*)(w + WS_O) + ((size_t)b * SEQ + qb * 256) * DM + h * 128, DM, SEQ, (char*)lds + RING_OFF, wv);
                    if (ks == kpos) { for (int k2 = 0; k2 < 7; ++k2) conv_slot(ldsp, wv, args, WSP, opq_i(l), k2); } ++ks;
                }
            }
            __syncthreads();
#ifdef PROBE_MEM
            for (int rep_ = 0; rep_ < 2; ++rep_)
#endif
            {
                const Frame F0 = make_frame(ldsp, wv);
                for (int u = F0.vcu; u < BATCH * 4 * (SEQ / 256); u += F0.G) {
                    unsigned char* const w = WSP;
                    const int bm = u >> 5, qb = u & 31, b = bm >> 2, mh = bm & 3;
                    att::mem_attn_unit((const att::bf16_t*)(w + WS_QM) + ((size_t)b * SEQ + qb * 256) * MEMW + mh * 256, MEMW, (const float*)(w + WS_PAR) + PAR_MQ + l * MEMHD, EPS,
                                       (const att::bf16_t*)(w + WS_MK) + ((size_t)l * MEMR + b * 256) * 1024 + mh * 256, 1024, (const att::bf16_t*)(w + WS_MVT) + (size_t)((l * 2 + b) * 4 + mh) * 65536,
                                       (unsigned char*)(w + WS_O) + ((size_t)b * SEQ + qb * 256) * DM + TOKW + mh * 256, DM, (char*)lds + RING_OFF, (float*)((char*)lds + WSL_OFF), wv);
                    if (ks == kpos) { for (int k2 = 0; k2 < 7; ++k2) conv_slot(ldsp, wv, args, WSP, opq_i(l), k2); } ++ks;
                }
                if (ks <= kpos) { for (int k2 = 0; k2 < 7; ++k2) conv_slot(ldsp, wv, args, WSP, opq_i(l), k2); }
            }
            GRID_BAR();
            { unsigned char* const w = WSP; const pg8::EpiResidB E{(pg8::bf16_t*)(w + WS_XH), (pg8::bf16_t*)(w + WS_XN), 1.0f, (float*)(w + WS_RSP), (LAS float*)(ldsp + EPI_RED_OFF), nullptr};
              gemm_site<pg8::EpiResidB, false, true>(ldsp, wv, w + WS_O, w + wl_off + OFF_WO, M, DM, DM / 2, E, 0x79797979, 0x79797979); }
            GRID_BAR();
        }
    }
#undef isA
#undef j
#undef GRID_BAR
#undef WSP
#undef OUTP
}

extern "C" void kernel_launch(void* const* d_in, const int* in_sizes, int n_in, void* d_out, int out_size, void* d_ws, size_t ws_size, hipStream_t stream) {
    static int grid = 0;
    if (grid == 0) {
        if (n_in != 26 || in_sizes[0] != M * DM || out_size != M * DM || ws_size < WS_END) { fprintf(stderr, "kernel_launch: unexpected shapes (n_in %d, in0 %d, out %d, ws %zu, need %zu); nothing launched\n", n_in, n_in > 0 ? in_sizes[0] : -1, out_size, ws_size, (size_t)WS_END); grid = -1; return; }
        int dev = 0, cus = 0, per_cu = 0;
        if (hipGetDevice(&dev) != hipSuccess || hipDeviceGetAttribute(&cus, hipDeviceAttributeMultiprocessorCount, dev) != hipSuccess) { grid = -1; return; }
        if (hipFuncSetAttribute((const void*)fwd_kernel, hipFuncAttributeMaxDynamicSharedMemorySize, LDS_BYTES) != hipSuccess) { fprintf(stderr, "kernel_launch: hipFuncSetAttribute failed\n"); grid = -1; return; }
        if (hipOccupancyMaxActiveBlocksPerMultiprocessor(&per_cu, (const void*)fwd_kernel, NWAVES * 64, LDS_BYTES) != hipSuccess || per_cu < 1) fprintf(stderr, "kernel_launch: occupancy query says %d\n", per_cu);
        (void)hipGetLastError();
        grid = cus;
    }
    if (grid < 0) return;
    if (hipMemsetAsync((char*)d_ws + WS_CTL, 0, CTL_ZERO_BYTES, stream) != hipSuccess) return;
    Args a{};
    for (int i = 0; i < 26; ++i) a.in[i] = (const float*)d_in[i];
    a.out = (float*)d_out; a.ws = (unsigned char*)d_ws;
    hipLaunchKernelGGL(fwd_kernel, dim3(grid), dim3(NWAVES * 64), LDS_BYTES, stream, a);
    const hipError_t le = hipPeekAtLastError();
    if (le != hipSuccess) fprintf(stderr, "kernel_launch: launch failed: %s\n", hipGetErrorName(le));
}
```

```cpp
#include <hip/hip_runtime.h>
#include <hip/hip_bf16.h>
#include <cstdio>
#include <cstdint>
namespace pg8 {
#define PG8_LAS __attribute__((address_space(3)))
typedef unsigned short bf16_t;
typedef short bf16x8 __attribute__((ext_vector_type(8)));
typedef float f32x4 __attribute__((ext_vector_type(4)));
typedef unsigned u32x4 __attribute__((ext_vector_type(4)));
typedef __bf16 bf16x2_t __attribute__((ext_vector_type(2)));
constexpr int BM = 256, BK = 64, HALF = 128, HTB = HALF * BK * 2  , STAGE_BYTES = 8 * HTB, NXCD = 8, WGM = 8;

__host__ __device__ __forceinline__ int lds_byte(int r, int c) { const int st = (r >> 4) * 2 + (c >> 5), rr = r & 15, cc = c & 31, ob = rr * 64 + cc * 2; return st * 1024 + (ob ^ (((ob >> 9) & 1) << 5)); }
__host__ __device__ __forceinline__ void stage_rc(int b, int& R, int& C) { const int st = b / 1024, sb = b % 1024, swz = sb ^ (((sb >> 9) & 1) << 5); R = (st >> 1) * 16 + swz / 64; C = (st & 1) * 32 + (swz % 64) / 2; }
__host__ __device__ __forceinline__ int perm32(int rho) { const int n = rho >> 4, i = rho & 15; return 8 * (i >> 2) + 4 * n + (i & 3); }

__device__ __forceinline__ int opq_lane() { int l; asm volatile("v_mbcnt_lo_u32_b32 %0, -1, 0\n\tv_mbcnt_hi_u32_b32 %0, -1, %0" : "=v"(l)); return l; }
typedef int v8i_t __attribute__((ext_vector_type(8)));
typedef int i32x4_t __attribute__((ext_vector_type(4)));
struct Unit { int pm, pn; };
struct Gemm { const bf16_t* A; const bf16_t* Bt; int M, N, K; };

struct StaticOrder {
    int nM, nN, nwg, G, c;
    __host__ __device__ void init(int M, int N, int G_, int c_) { nM = M / BM; nN = N / BM; nwg = nM * nN; G = G_; c = c_; }
    __host__ __device__ bool next(int i, Unit& u) const {
        const long L = (long)i * G + c; if (L >= nwg) return false;
        int wgid = (int)L; { const int q = nwg / NXCD, r = nwg % NXCD, xcd = wgid % NXCD, off = wgid / NXCD; wgid = (xcd < r ? xcd * (q + 1) : r * (q + 1) + (xcd - r) * q) + off; }
        const int nig = WGM * nN, gid = wgid / nig, fm = gid * WGM, gsz = (nM - fm) < WGM ? (nM - fm) : WGM;
        u.pm = fm + ((wgid % nig) % gsz); u.pn = (wgid % nig) / gsz; return true;
    }
    __device__ __forceinline__ void a_ready(const Unit&) const {}
    __device__ __forceinline__ void done(const Unit&) const {}
};

__device__ __forceinline__ unsigned cvt_pk_bf16(float lo, float hi) { unsigned r; asm volatile("v_cvt_pk_bf16_f32 %0, %1, %2" : "=v"(r) : "v"(lo), "v"(hi)); return r; }
typedef float f32x2 __attribute__((ext_vector_type(2)));
__device__ __forceinline__ void acc_zero(f32x4 (&acc)[2][2][4][2]) {
#pragma unroll
    for (int a = 0; a < 2; ++a)
#pragma unroll
        for (int b = 0; b < 2; ++b)
#pragma unroll
            for (int m = 0; m < 4; ++m)
#pragma unroll
                for (int n = 0; n < 2; ++n) acc[a][b][m][n] = (f32x4){0.f, 0.f, 0.f, 0.f};
}
__device__ __forceinline__ float epi_xor1(float v) { return v + __int_as_float(__builtin_amdgcn_ds_swizzle(__float_as_int(v), (1 << 10) | 0x1f)); }
__device__ __forceinline__ float epi_xor16(float v) { return v + __int_as_float(__builtin_amdgcn_ds_swizzle(__float_as_int(v), (16 << 10) | 0x1f)); }
__device__ __forceinline__ float epi_xor32(float v) { auto rr = __builtin_amdgcn_permlane32_swap(__float_as_uint(v), __float_as_uint(v), false, false); return __uint_as_float(rr[0]) + __uint_as_float(rr[1]); }
template <int P0, int NP, int CNT> __device__ __forceinline__ void rstd_init(const float* rsp, int row0, int wr, int wc, PG8_LAS float* rs_lds) {
    const int idx = (wr * 4 + wc) * 64 + opq_lane(), row = idx >> 1, half = idx & 1;
    __builtin_amdgcn_s_barrier();
    const float* p = rsp + ((size_t)(row0 + row) * 16 + P0 + half * (NP / 2)); float s;
    if constexpr (NP == 16) { const f32x4 a = *(const f32x4*)p, b = *(const f32x4*)(p + 4); s = ((a[0] + a[1]) + (a[2] + a[3])) + ((b[0] + b[1]) + (b[2] + b[3])); }
    else if constexpr (NP == 4) { s = p[0] + p[1]; }
    else { static_assert(NP == 2, "partials"); s = p[0]; }
    s = epi_xor1(s);
    rs_lds[row] = 1.0f / sqrtf(s * (1.0f / CNT) + 1e-6f);
}
struct EpiSwiGLU {
    static constexpr bool PERM = true, AFTER_DRAIN = false, LAUNDER = false;
    bf16_t* H; int ldh; const float* rsp; PG8_LAS float* rs_lds;
    __device__ __forceinline__ void init(f32x4 (&acc)[2][2][4][2], const Unit& u, int wr, int wc, int, int, int prev  ) const {
        acc_zero(acc);
        if (prev == u.pm) return;
        const int idx = (wr * 4 + wc) * 64 + opq_lane(), row = idx >> 1, half = idx & 1;
        __builtin_amdgcn_s_barrier();
        const f32x4* p = (const f32x4*)(rsp + ((size_t)(u.pm * BM + row) * 16 + half * 8));
        const f32x4 a = p[0], b = p[1];
        const float s = epi_xor1(((a[0] + a[1]) + (a[2] + a[3])) + ((b[0] + b[1]) + (b[2] + b[3])));
        rs_lds[row] = 1.0f / sqrtf(s * (1.0f / 4096.0f) + 1e-6f);
    }
    __device__ __forceinline__ void operator()(const f32x4 (&acc)[2][2][4][2], const Unit& u, int wr, int wc, int fr, int fq) const {
        float rs[2][4];
#pragma unroll
        for (int ai = 0; ai < 2; ++ai)
#pragma unroll
            for (int m = 0; m < 4; ++m) rs[ai][m] = rs_lds[ai * HALF + wr * 64 + m * 16 + fr];
#pragma unroll
        for (int ai = 0; ai < 2; ++ai)
#pragma unroll
            for (int m = 0; m < 4; ++m) { bf16_t* rowp = H + ((size_t)((u.pm * 16 + ai * 8 + wr * 4 + m) * (ldh >> 5) + (u.pn * 4 + wc)) * 16 + fr) * 32 + 8 * fq;
                const float r = rs[ai][m]; float h[8];
#pragma unroll
                for (int n = 0; n < 2; ++n)
#pragma unroll
                    for (int j = 0; j < 4; ++j) { const float g = acc[ai][0][m][n][j] * r, up = acc[ai][1][m][n][j] * r;
                        const float e = __builtin_amdgcn_exp2f(g * (-1.4426950408889634f)); h[n * 4 + j] = g * __builtin_amdgcn_rcpf(1.0f + e) * up; }
                u32x4 w; w.x = cvt_pk_bf16(h[0], h[1]); w.y = cvt_pk_bf16(h[2], h[3]); w.z = cvt_pk_bf16(h[4], h[5]); w.w = cvt_pk_bf16(h[6], h[7]);
                *(u32x4*)rowp = w; }
    }
};
__device__ __forceinline__ float bf_lo(unsigned w) { return __uint_as_float(w << 16); }
__device__ __forceinline__ float bf_hi(unsigned w) { return __uint_as_float(w & 0xffff0000u); }
struct EpiResidB {
    static constexpr bool PERM = true, AFTER_DRAIN = false, LAUNDER = false;
    bf16_t* xb; float alpha; float* rsp; PG8_LAS float* red; unsigned char* x8;
    __device__ __forceinline__ void init(f32x4 (&acc)[2][2][4][2], const Unit&, int, int, int, int, int) const { acc_zero(acc); }
    __device__ __forceinline__ void operator()(const f32x4 (&acc)[2][2][4][2], const Unit& u, int wr, int wc, int fr, int fq) const {
        bf16_t* p0 = xb + ((size_t)((u.pm * 16 + wr * 4) * 128 + (u.pn * 8 + wc)) * 16 + fr) * 32 + 8 * fq;
        float ss[2][4];
        u32x4 bs[2][4][2];
#pragma unroll
        for (int ai = 0; ai < 2; ++ai)
#pragma unroll
            for (int m = 0; m < 4; ++m)
#pragma unroll
                for (int bj = 0; bj < 2; ++bj) bs[ai][m][bj] = *(const u32x4*)(p0 + (size_t)((ai * 8 + m) * 128 + bj * 4) * 512);
#pragma unroll
        for (int ai = 0; ai < 2; ++ai)
#pragma unroll
            for (int m = 0; m < 4; ++m)
#pragma unroll
                for (int bj = 0; bj < 2; ++bj) { const u32x4 b = bs[ai][m][bj]; const f32x4 a0 = acc[ai][bj][m][0] * alpha, a1 = acc[ai][bj][m][1] * alpha;
                    u32x4 w; w.x = cvt_pk_bf16(bf_lo(b.x) + a0[0], bf_hi(b.x) + a0[1]); w.y = cvt_pk_bf16(bf_lo(b.y) + a0[2], bf_hi(b.y) + a0[3]);
                    w.z = cvt_pk_bf16(bf_lo(b.z) + a1[0], bf_hi(b.z) + a1[1]); w.w = cvt_pk_bf16(bf_lo(b.w) + a1[2], bf_hi(b.w) + a1[3]);
                    *(u32x4*)(p0 + (size_t)((ai * 8 + m) * 128 + bj * 4) * 512) = w;
                    float q = (bj == 0) ? 0.f : ss[ai][m]; float f[8];
#pragma unroll
                    for (int e = 0; e < 4; ++e) { f[2 * e] = bf_lo(w[e]); f[2 * e + 1] = bf_hi(w[e]); q += f[2 * e] * f[2 * e] + f[2 * e + 1] * f[2 * e + 1]; }
                    ss[ai][m] = q;
                    if (x8) { typedef unsigned v2u_t __attribute__((ext_vector_type(2))); v2u_t w8;
                        w8.x = (unsigned)__builtin_amdgcn_cvt_pk_fp8_f32(f[2], f[3], __builtin_amdgcn_cvt_pk_fp8_f32(f[0], f[1], 0, false), true);
                        w8.y = (unsigned)__builtin_amdgcn_cvt_pk_fp8_f32(f[6], f[7], __builtin_amdgcn_cvt_pk_fp8_f32(f[4], f[5], 0, false), true);
                        *(v2u_t*)(x8 + ((size_t)((u.pm * 16 + ai * 8 + wr * 4 + m) * 64 + u.pn * 4 + bj * 2 + (wc >> 1)) * 16 + fr) * 64 + (wc & 1) * 32 + 8 * fq) = w8; } }
#pragma unroll
        for (int ai = 0; ai < 2; ++ai) { float v = 0.f;
#pragma unroll
            for (int m = 0; m < 4; ++m) { const float t = epi_xor32(epi_xor16(ss[ai][m])); v = (fq == m) ? t : v; }
            red[wc * 256 + ai * HALF + wr * 64 + fq * 16 + fr] = v; }
        asm volatile("s_waitcnt lgkmcnt(0)" ::: "memory"); __builtin_amdgcn_s_barrier();
        if (wr * 4 + wc < 4) { const int row = (wr * 4 + wc) * 64 + fq * 16 + fr;
            rsp[(size_t)(u.pm * BM + row) * 16 + u.pn] = (red[row] + red[256 + row]) + (red[512 + row] + red[768 + row]); }
    }
};
struct EpiResidOut {
    static constexpr bool PERM = true, AFTER_DRAIN = false, LAUNDER = false;
    const bf16_t* xb; float* out; int ldc; float alpha;
    __device__ __forceinline__ void init(f32x4 (&acc)[2][2][4][2], const Unit&, int, int, int, int, int) const { acc_zero(acc); }
    __device__ __forceinline__ void operator()(const f32x4 (&acc)[2][2][4][2], const Unit& u, int wr, int wc, int fr, int fq) const {
        const bf16_t* p0 = xb + ((size_t)((u.pm * 16 + wr * 4) * 128 + (u.pn * 8 + wc)) * 16 + fr) * 32 + 8 * fq;
        float* o0 = out + (size_t)(u.pm * BM + wr * 64 + fr) * ldc + u.pn * BM + wc * 32 + 8 * fq;
#pragma unroll
        for (int ai = 0; ai < 2; ++ai)
#pragma unroll
            for (int m = 0; m < 4; ++m) {
#pragma unroll
                for (int bj = 0; bj < 2; ++bj) { const u32x4 b = *(const u32x4*)(p0 + (size_t)((ai * 8 + m) * 128 + bj * 4) * 512); const f32x4 a0 = acc[ai][bj][m][0] * alpha, a1 = acc[ai][bj][m][1] * alpha;
                    float* o = o0 + (size_t)(ai * HALF + m * 16) * ldc + bj * HALF;
                    *(f32x4*)o = (f32x4){bf_lo(b.x) + a0[0], bf_hi(b.x) + a0[1], bf_lo(b.y) + a0[2], bf_hi(b.y) + a0[3]};
                    *(f32x4*)(o + 4) = (f32x4){bf_lo(b.z) + a1[0], bf_hi(b.z) + a1[1], bf_lo(b.w) + a1[2], bf_hi(b.w) + a1[3]}; }
                if (m & 1) asm volatile("" ::: "memory"); }
    }
};
template <bool NORM, int T1, int T2, int T3, size_t O0, size_t O1, size_t O2, size_t O3, int L0, int L1, int L2, int L3, int P0 = 0, int NP = 16, int CNT = 4096> struct EpiBf16Seg {
    static constexpr bool PERM = true, AFTER_DRAIN = false, LAUNDER = (NP != 16);
    unsigned char* ws; const float* rsp; PG8_LAS float* rs_lds;
    __device__ __forceinline__ void init(f32x4 (&acc)[2][2][4][2], const Unit& u, int wr, int wc, int, int, int prev  ) const {
        acc_zero(acc);
        if constexpr (NORM) { if (prev != u.pm) rstd_init<P0, NP, CNT>(rsp, u.pm * BM, wr, wc, rs_lds); }
    }
    __device__ __forceinline__ void operator()(const f32x4 (&acc)[2][2][4][2], const Unit& u, int wr, int wc, int fr, int fq) const {
        const int pn = u.pn;
        const size_t off = pn >= T3 ? O3 : (pn >= T2 ? O2 : (pn >= T1 ? O1 : O0));
        const int ts = pn >= T3 ? T3 : (pn >= T2 ? T2 : (pn >= T1 ? T1 : 0)), ldc = pn >= T3 ? L3 : (pn >= T2 ? L2 : (pn >= T1 ? L1 : L0));
        bf16_t* base = (bf16_t*)(ws + off);
        const int row0 = u.pm * BM + wr * 64 + fr, col0 = (pn - ts) * BM + wc * 32 + 8 * fq;
        float rs[2][4];
#pragma unroll
        for (int ai = 0; ai < 2; ++ai)
#pragma unroll
            for (int m = 0; m < 4; ++m) rs[ai][m] = NORM ? rs_lds[ai * HALF + wr * 64 + m * 16 + fr] : 1.0f;
#pragma unroll
        for (int ai = 0; ai < 2; ++ai)
#pragma unroll
            for (int m = 0; m < 4; ++m) { bf16_t* rowp = base + (size_t)(row0 + ai * HALF + m * 16) * ldc + col0;
#pragma unroll
                for (int bj = 0; bj < 2; ++bj) { const f32x4 v0 = acc[ai][bj][m][0] * rs[ai][m], v1 = acc[ai][bj][m][1] * rs[ai][m];
                    u32x4 w; w.x = cvt_pk_bf16(v0[0], v0[1]); w.y = cvt_pk_bf16(v0[2], v0[3]); w.z = cvt_pk_bf16(v1[0], v1[1]); w.w = cvt_pk_bf16(v1[2], v1[3]);
                    *(u32x4*)(rowp + bj * HALF) = w; } }
    }
};
template <size_t O0, int L0> using EpiBf16One = EpiBf16Seg<false, (1 << 30), (1 << 30), (1 << 30), O0, 0, 0, 0, L0, 0, 0, 0>;
template <int NROWS, int SEQL, size_t OFF_VT, bool NORMC = false, size_t OFF_RSP = 0, int LDS_RS = 0, int P0 = 0, int NP = 16, int CNT = 4096> struct EpiVT8 {
    static constexpr bool PERM = true, AFTER_DRAIN = false, LAUNDER = true;
    unsigned char* ws; PG8_LAS unsigned char* lds;
    __device__ __forceinline__ void init(f32x4 (&acc)[2][2][4][2], const Unit& u, int wr, int wc, int, int, int prev  ) const {
        acc_zero(acc);
        if constexpr (NORMC) rstd_init<P0, NP, CNT>((const float*)(ws + OFF_RSP), u.pn * BM, wr, wc, (PG8_LAS float*)(lds + LDS_RS));
    }
    __device__ __forceinline__ void operator()(const f32x4 (&acc)[2][2][4][2], const Unit& u, int wr, int wc, int fr, int fq) const {
        const int key0 = u.pn * BM, b = key0 / SEQL, t0 = key0 - b * SEQL;
        unsigned char* const vt = ws + OFF_VT; PG8_LAS float* rs_lds = (PG8_LAS float*)(lds + LDS_RS);
        unsigned char* d0 = vt + ((size_t)b * NROWS + u.pm * BM + wr * 64 + fr) * SEQL + t0 + wc * 32 + 4 * fq;
        f32x4 cr[2][2];
#pragma unroll
        for (int bj = 0; bj < 2; ++bj)
#pragma unroll
            for (int n = 0; n < 2; ++n) cr[bj][n] = NORMC ? *(const PG8_LAS f32x4*)(rs_lds + bj * HALF + wc * 32 + 8 * fq + 4 * n) : (f32x4){1.f, 1.f, 1.f, 1.f};
#pragma unroll
        for (int ai = 0; ai < 2; ++ai)
#pragma unroll
            for (int m = 0; m < 4; ++m)
#pragma unroll
                for (int bj = 0; bj < 2; ++bj) { unsigned char* p = d0 + (size_t)(ai * HALF + m * 16) * SEQL + bj * HALF; const f32x4 v0 = acc[ai][bj][m][0] * cr[bj][0], v1 = acc[ai][bj][m][1] * cr[bj][1];
                    *(unsigned*)p = (unsigned)__builtin_amdgcn_cvt_pk_fp8_f32(v0[2], v0[3], __builtin_amdgcn_cvt_pk_fp8_f32(v0[0], v0[1], 0, false), true);
                    *(unsigned*)(p + 16) = (unsigned)__builtin_amdgcn_cvt_pk_fp8_f32(v1[2], v1[3], __builtin_amdgcn_cvt_pk_fp8_f32(v1[0], v1[1], 0, false), true); }
    }
};
template <int HSTRIDE, bool ROWN = false, int P0 = 0, int NP = 16, int CNT = 4096> struct EpiKN8 {
    static constexpr bool PERM = true, AFTER_DRAIN = false, LAUNDER = true;
    unsigned char* k8; int ldk; const float* gain; PG8_LAS float* red; const float* rsp; PG8_LAS float* rs_lds;
    __device__ __forceinline__ void init(f32x4 (&acc)[2][2][4][2], const Unit& u, int wr, int wc, int, int, int prev  ) const { acc_zero(acc); if constexpr (ROWN) { if (prev != u.pm) rstd_init<P0, NP, CNT>(rsp, u.pm * BM, wr, wc, rs_lds); } }
    __device__ __forceinline__ void operator()(const f32x4 (&acc)[2][2][4][2], const Unit& u, int wr, int wc, int fr, int fq) const {
        float rsx[2][4];
#pragma unroll
        for (int ai = 0; ai < 2; ++ai)
#pragma unroll
            for (int m = 0; m < 4; ++m) rsx[ai][m] = ROWN ? rs_lds[ai * HALF + wr * 64 + m * 16 + fr] : 1.0f;
#pragma unroll
        for (int ai = 0; ai < 2; ++ai)
#pragma unroll
            for (int bj = 0; bj < 2; ++bj) { float v = 0.f;
#pragma unroll
                for (int m = 0; m < 4; ++m) { const f32x4 a = acc[ai][bj][m][0], b = acc[ai][bj][m][1];
                    const float t = epi_xor32(epi_xor16(((a[0] * a[0] + a[1] * a[1]) + (a[2] * a[2] + a[3] * a[3]) + ((b[0] * b[0] + b[1] * b[1]) + (b[2] * b[2] + b[3] * b[3]))) * (rsx[ai][m] * rsx[ai][m]))); v = (fq == m) ? t : v; }
                red[((bj * 256 + ai * HALF + wr * 64 + fq * 16 + fr) << 2) + wc] = v; }
        asm volatile("s_waitcnt lgkmcnt(0)" ::: "memory"); __builtin_amdgcn_s_barrier();
        const f32x4 g0 = *(const f32x4*)(gain + wc * 32 + 8 * fq), g1 = *(const f32x4*)(gain + wc * 32 + 8 * fq + 4);
        unsigned char* d0 = k8 + (size_t)(u.pm * BM + wr * 64 + fr) * ldk + (u.pn * 2) * HSTRIDE + wc * 32 + 8 * fq;
        typedef unsigned v2u_t __attribute__((ext_vector_type(2)));
#pragma unroll
        for (int ai = 0; ai < 2; ++ai)
#pragma unroll
            for (int m = 0; m < 4; ++m)
#pragma unroll
                for (int bj = 0; bj < 2; ++bj) { const f32x4 s4 = *(const PG8_LAS f32x4*)(red + ((bj * 256 + ai * HALF + wr * 64 + m * 16 + fr) << 2));
                    const float rs = rsx[ai][m] * __builtin_amdgcn_rsqf(((s4[0] + s4[1]) + (s4[2] + s4[3])) * (1.0f / 128.0f) + 1e-6f);
                    const f32x4 a = acc[ai][bj][m][0] * rs * g0, b = acc[ai][bj][m][1] * rs * g1; v2u_t w8;
                    w8.x = (unsigned)__builtin_amdgcn_cvt_pk_fp8_f32(a[2], a[3], __builtin_amdgcn_cvt_pk_fp8_f32(a[0], a[1], 0, false), true);
                    w8.y = (unsigned)__builtin_amdgcn_cvt_pk_fp8_f32(b[2], b[3], __builtin_amdgcn_cvt_pk_fp8_f32(b[0], b[1], 0, false), true);
                    *(v2u_t*)(d0 + (size_t)(ai * HALF + m * 16) * ldk + bj * HSTRIDE) = w8; }
    }
};
template <int HSTRIDE, size_t OFF_K8, int ldk, size_t OFF_CS, size_t OFF_SN, int seq, size_t OFF_RSP, int LDS_RED, int LDS_RS> struct EpiKNR8 {
    static constexpr bool PERM = true, AFTER_DRAIN = false, LAUNDER = true;
    unsigned char* ws; const float* gain; PG8_LAS unsigned char* lds; float osc;
    __device__ __forceinline__ void init(f32x4 (&acc)[2][2][4][2], const Unit& u, int wr, int wc, int, int, int prev  ) const {
        acc_zero(acc);
        if (prev == u.pm) return;
        const int idx = (wr * 4 + wc) * 64 + opq_lane(), row = idx >> 1, half = idx & 1;
        __builtin_amdgcn_s_barrier();
        const float* rsp = (const float*)(ws + OFF_RSP); PG8_LAS float* rs_lds = (PG8_LAS float*)(lds + LDS_RS);
        const f32x4* p = (const f32x4*)(rsp + ((size_t)(u.pm * BM + row) * 16 + half * 8));
        const f32x4 a = p[0], b = p[1];
        const float s = epi_xor1(((a[0] + a[1]) + (a[2] + a[3])) + ((b[0] + b[1]) + (b[2] + b[3])));
        rs_lds[row] = 1.0f / sqrtf(s * (1.0f / 4096.0f) + 1e-6f);
    }
    __device__ __forceinline__ void operator()(const f32x4 (&acc)[2][2][4][2], const Unit& u, int wr, int wc, int fr, int fq) const {
        unsigned char* const k8 = ws + OFF_K8; const float* const cs = (const float*)(ws + OFF_CS); const float* const sn = (const float*)(ws + OFF_SN);
        PG8_LAS float* red = (PG8_LAS float*)(lds + LDS_RED); PG8_LAS float* rs_lds = (PG8_LAS float*)(lds + LDS_RS);
        float rsx[2][4];
#pragma unroll
        for (int ai = 0; ai < 2; ++ai)
#pragma unroll
            for (int m = 0; m < 4; ++m) rsx[ai][m] = rs_lds[ai * HALF + wr * 64 + m * 16 + fr];
#pragma unroll
        for (int ai = 0; ai < 2; ++ai)
#pragma unroll
            for (int bj = 0; bj < 2; ++bj) { float v = 0.f;
#pragma unroll
                for (int m = 0; m < 4; ++m) { const f32x4 a = acc[ai][bj][m][0], b = acc[ai][bj][m][1];
                    const float t = epi_xor32(epi_xor16(((a[0] * a[0] + a[1] * a[1]) + (a[2] * a[2] + a[3] * a[3]) + ((b[0] * b[0] + b[1] * b[1]) + (b[2] * b[2] + b[3] * b[3]))) * (rsx[ai][m] * rsx[ai][m]))); v = (fq == m) ? t : v; }
                red[((bj * 256 + ai * HALF + wr * 64 + fq * 16 + fr) << 2) + wc] = v; }
        asm volatile("s_waitcnt lgkmcnt(0)" ::: "memory"); __builtin_amdgcn_s_barrier();
        const f32x4 g0 = *(const f32x4*)(gain + wc * 32 + 8 * fq), g1 = *(const f32x4*)(gain + wc * 32 + 8 * fq + 4);
        const int row0 = u.pm * BM + wr * 64 + fr;
        unsigned char* d0 = k8 + (size_t)row0 * ldk + (u.pn * 2) * HSTRIDE + wc * 32 + 8 * fq;
        typedef unsigned v2u_t __attribute__((ext_vector_type(2)));
#pragma unroll
        for (int ai = 0; ai < 2; ++ai)
#pragma unroll
            for (int m = 0; m < 4; ++m) { const int pos = (row0 + ai * HALF + m * 16) % seq;
                const f32x4 cv = *(const f32x4*)(cs + (size_t)pos * 64 + wc * 16 + 4 * fq), sv = *(const f32x4*)(sn + (size_t)pos * 64 + wc * 16 + 4 * fq);
#pragma unroll
                for (int bj = 0; bj < 2; ++bj) { const f32x4 s4 = *(const PG8_LAS f32x4*)(red + ((bj * 256 + ai * HALF + wr * 64 + m * 16 + fr) << 2));
                    const float rs = rsx[ai][m] * osc * __builtin_amdgcn_rsqf(((s4[0] + s4[1]) + (s4[2] + s4[3])) * (1.0f / 128.0f) + 1e-6f);
                    const f32x4 a = acc[ai][bj][m][0] * rs * g0, b = acc[ai][bj][m][1] * rs * g1;
                    const float x0 = a[0] * cv[0] - a[1] * sv[0], x1 = a[0] * sv[0] + a[1] * cv[0], x2 = a[2] * cv[1] - a[3] * sv[1], x3 = a[2] * sv[1] + a[3] * cv[1];
                    const float x4 = b[0] * cv[2] - b[1] * sv[2], x5 = b[0] * sv[2] + b[1] * cv[2], x6 = b[2] * cv[3] - b[3] * sv[3], x7 = b[2] * sv[3] + b[3] * cv[3];
                    v2u_t w8;
                    w8.x = (unsigned)__builtin_amdgcn_cvt_pk_fp8_f32(x2, x3, __builtin_amdgcn_cvt_pk_fp8_f32(x0, x1, 0, false), true);
                    w8.y = (unsigned)__builtin_amdgcn_cvt_pk_fp8_f32(x6, x7, __builtin_amdgcn_cvt_pk_fp8_f32(x4, x5, 0, false), true);
                    *(v2u_t*)(d0 + (size_t)(ai * HALF + m * 16) * ldk + bj * HSTRIDE) = w8; } }
    }
};
template <size_t OFF_CQ8, size_t OFF_CKV8, size_t OFF_KPE, int LDKPE, int KPE0, size_t OFF_RSPX, size_t OFF_RSPA, int LDS_RED, int LDS_RS> struct EpiA8 {
    static constexpr bool PERM = true, AFTER_DRAIN = false, LAUNDER = true;
    unsigned char* ws; PG8_LAS unsigned char* lds;
    __device__ __forceinline__ void init(f32x4 (&acc)[2][2][4][2], const Unit& u, int wr, int wc, int, int, int prev  ) const { acc_zero(acc); if (prev != u.pm) rstd_init<0, 16, 4096>((const float*)(ws + OFF_RSPX), u.pm * BM, wr, wc, (PG8_LAS float*)(lds + LDS_RS)); }
    __device__ __forceinline__ void operator()(const f32x4 (&acc)[2][2][4][2], const Unit& u, int wr, int wc, int fr, int fq) const {
        PG8_LAS float* rs_lds = (PG8_LAS float*)(lds + LDS_RS); PG8_LAS float* red = (PG8_LAS float*)(lds + LDS_RED);
        const int pn = u.pn, row0 = u.pm * BM + wr * 64 + fr;
        float rs[2][4];
#pragma unroll
        for (int ai = 0; ai < 2; ++ai)
#pragma unroll
            for (int m = 0; m < 4; ++m) rs[ai][m] = rs_lds[ai * HALF + wr * 64 + m * 16 + fr];
        if (pn >= 6) {
            bf16_t* base = (bf16_t*)(ws + OFF_KPE) + KPE0 + wc * 32 + 8 * fq;
#pragma unroll
            for (int ai = 0; ai < 2; ++ai)
#pragma unroll
                for (int m = 0; m < 4; ++m) { bf16_t* rowp = base + (size_t)(row0 + ai * HALF + m * 16) * LDKPE;
#pragma unroll
                    for (int bj = 0; bj < 2; ++bj) { const f32x4 v0 = acc[ai][bj][m][0] * rs[ai][m], v1 = acc[ai][bj][m][1] * rs[ai][m];
                        u32x4 w; w.x = cvt_pk_bf16(v0[0], v0[1]); w.y = cvt_pk_bf16(v0[2], v0[3]); w.z = cvt_pk_bf16(v1[0], v1[1]); w.w = cvt_pk_bf16(v1[2], v1[3]);
                        *(u32x4*)(rowp + bj * HALF) = w; } }
            return; }
        unsigned char* d0 = (pn < 4 ? ws + OFF_CQ8 + (size_t)row0 * 1024 + pn * BM : ws + OFF_CKV8 + (size_t)row0 * 512 + (pn - 4) * BM) + wc * 32 + 8 * fq;
        const int ldo = pn < 4 ? 1024 : 512;
        typedef unsigned v2u_t __attribute__((ext_vector_type(2)));
        float ss[2][4];
#pragma unroll
        for (int ai = 0; ai < 2; ++ai)
#pragma unroll
            for (int m = 0; m < 4; ++m) { float q = 0.f;
#pragma unroll
                for (int bj = 0; bj < 2; ++bj) { const f32x4 a = acc[ai][bj][m][0] * rs[ai][m], b = acc[ai][bj][m][1] * rs[ai][m]; v2u_t w8;
                    q += ((a[0] * a[0] + a[1] * a[1]) + (a[2] * a[2] + a[3] * a[3])) + ((b[0] * b[0] + b[1] * b[1]) + (b[2] * b[2] + b[3] * b[3]));
                    w8.x = (unsigned)__builtin_amdgcn_cvt_pk_fp8_f32(a[2], a[3], __builtin_amdgcn_cvt_pk_fp8_f32(a[0], a[1], 0, false), true);
                    w8.y = (unsigned)__builtin_amdgcn_cvt_pk_fp8_f32(b[2], b[3], __builtin_amdgcn_cvt_pk_fp8_f32(b[0], b[1], 0, false), true);
                    *(v2u_t*)(d0 + (size_t)(ai * HALF + m * 16) * ldo + bj * HALF) = w8; }
                ss[ai][m] = q; }
#pragma unroll
        for (int ai = 0; ai < 2; ++ai) { float v = 0.f;
#pragma unroll
            for (int m = 0; m < 4; ++m) { const float t = epi_xor32(epi_xor16(ss[ai][m])); v = (fq == m) ? t : v; }
            red[wc * 256 + ai * HALF + wr * 64 + fq * 16 + fr] = v; }
        asm volatile("s_waitcnt lgkmcnt(0)" ::: "memory"); __builtin_amdgcn_s_barrier();
        if (wr * 4 + wc < 4) { const int row = (wr * 4 + wc) * 64 + fq * 16 + fr;
            ((float*)(ws + OFF_RSPA))[(size_t)(u.pm * BM + row) * 16 + pn] = (red[row] + red[256 + row]) + (red[512 + row] + red[768 + row]); }
    }
};
template <size_t OFF_Q8, int LDQ, size_t OFF_CS, size_t OFF_SN, int seq, size_t OFF_RSPA, int LDS_RED, int LDS_RS> struct EpiQA8 {
    static constexpr bool PERM = true, AFTER_DRAIN = false, LAUNDER = true;
    unsigned char* ws; const float* gn; const float* gp; PG8_LAS unsigned char* lds; float osc;
    __device__ __forceinline__ void init(f32x4 (&acc)[2][2][4][2], const Unit& u, int wr, int wc, int, int, int prev  ) const { acc_zero(acc); if (prev != u.pm) rstd_init<0, 4, 1024>((const float*)(ws + OFF_RSPA), u.pm * BM, wr, wc, (PG8_LAS float*)(lds + LDS_RS)); }
    __device__ __forceinline__ void operator()(const f32x4 (&acc)[2][2][4][2], const Unit& u, int wr, int wc, int fr, int fq) const {
        PG8_LAS float* red = (PG8_LAS float*)(lds + LDS_RED); PG8_LAS float* rs_lds = (PG8_LAS float*)(lds + LDS_RS);
        const bool pe = u.pn >= 12;
        float rsx[2][4];
#pragma unroll
        for (int ai = 0; ai < 2; ++ai)
#pragma unroll
            for (int m = 0; m < 4; ++m) rsx[ai][m] = rs_lds[ai * HALF + wr * 64 + m * 16 + fr];
#pragma unroll
        for (int ai = 0; ai < 2; ++ai)
#pragma unroll
            for (int bj = 0; bj < 2; ++bj) { float v = 0.f;
#pragma unroll
                for (int m = 0; m < 4; ++m) { const f32x4 a = acc[ai][bj][m][0], b = acc[ai][bj][m][1];
                    const float t = epi_xor32(epi_xor16(((a[0] * a[0] + a[1] * a[1]) + (a[2] * a[2] + a[3] * a[3]) + ((b[0] * b[0] + b[1] * b[1]) + (b[2] * b[2] + b[3] * b[3]))) * (rsx[ai][m] * rsx[ai][m]))); v = (fq == m) ? t : v; }
                red[((bj * 256 + ai * HALF + wr * 64 + fq * 16 + fr) << 2) + wc] = v; }
        asm volatile("s_waitcnt lgkmcnt(0)" ::: "memory"); __builtin_amdgcn_s_barrier();
        const int row0 = u.pm * BM + wr * 64 + fr;
        const int d0i = pe ? (wc & 1) * 32 + 8 * fq : wc * 32 + 8 * fq;
        const float* gv = pe ? gp + d0i : gn + d0i;
        const f32x4 g0 = *(const f32x4*)gv, g1 = *(const f32x4*)(gv + 4);
        unsigned char* d0 = ws + OFF_Q8 + (size_t)row0 * LDQ + (pe ? (4 * (u.pn - 12) + (wc >> 1)) * 192 + 128 : (2 * u.pn) * 192) + d0i;
        const int hstep = pe ? 2 * 192 : 192;
        const float inv_n = pe ? (1.0f / 64.0f) : (1.0f / 128.0f);
        typedef unsigned v2u_t __attribute__((ext_vector_type(2)));
#pragma unroll
        for (int ai = 0; ai < 2; ++ai)
#pragma unroll
            for (int m = 0; m < 4; ++m) { f32x4 cv = {1.f, 1.f, 1.f, 1.f}, sv = {0.f, 0.f, 0.f, 0.f};
                if (pe) { const int pos = (row0 + ai * HALF + m * 16) % seq; cv = *(const f32x4*)((const float*)(ws + OFF_CS) + (size_t)pos * 32 + (d0i >> 1)); sv = *(const f32x4*)((const float*)(ws + OFF_SN) + (size_t)pos * 32 + (d0i >> 1)); }
#pragma unroll
                for (int bj = 0; bj < 2; ++bj) { const f32x4 s4 = *(const PG8_LAS f32x4*)(red + ((bj * 256 + ai * HALF + wr * 64 + m * 16 + fr) << 2));
                    const float ssum = pe ? ((wc & 2) ? s4[2] + s4[3] : s4[0] + s4[1]) : (s4[0] + s4[1]) + (s4[2] + s4[3]);
                    const float rs = rsx[ai][m] * osc * __builtin_amdgcn_rsqf(ssum * inv_n + 1e-6f);
                    const f32x4 a = acc[ai][bj][m][0] * rs * g0, b = acc[ai][bj][m][1] * rs * g1;
                    const float x0 = a[0] * cv[0] - a[1] * sv[0], x1 = a[0] * sv[0] + a[1] * cv[0], x2 = a[2] * cv[1] - a[3] * sv[1], x3 = a[2] * sv[1] + a[3] * cv[1];
                    const float x4 = b[0] * cv[2] - b[1] * sv[2], x5 = b[0] * sv[2] + b[1] * cv[2], x6 = b[2] * cv[3] - b[3] * sv[3], x7 = b[2] * sv[3] + b[3] * cv[3];
                    v2u_t w8;
                    w8.x = (unsigned)__builtin_amdgcn_cvt_pk_fp8_f32(x2, x3, __builtin_amdgcn_cvt_pk_fp8_f32(x0, x1, 0, false), true);
                    w8.y = (unsigned)__builtin_amdgcn_cvt_pk_fp8_f32(x6, x7, __builtin_amdgcn_cvt_pk_fp8_f32(x4, x5, 0, false), true);
                    *(v2u_t*)(d0 + (size_t)(ai * HALF + m * 16) * LDQ + bj * hstep) = w8; } }
    }
};

template <class Epi, class Sched, bool ALIGN_EPI = false, bool SP2 = false, bool ABLK = false, bool FP8 = false, bool BBLK = false  >
__device__ __forceinline__ void gemm_phase(PG8_LAS unsigned char* lds, const Gemm g, const Sched& S, const Epi& E, const int wv  , const int sc_w = 0x7f7f7f7f  , const int sc_a = 0x7f7f7f7f  ) {
    int wid = wv; asm volatile("" : "+s"(wid));
    const int lane = opq_lane(), tid = wid * 64 + lane, wr = wid >> 2, wc = wid & 3, fr = lane & 15, fq = lane >> 4;
    const int K = g.K, nt = K / BK;
    unsigned voffA[2], voffB[2];
#pragma unroll
    for (int i = 0; i < 2; ++i) { int R, C; stage_rc(tid * 16 + i * 8192, R, C); const int Rb = Epi::PERM ? ((R & ~31) + perm32(R & 31)) : R;
        voffA[i] = ABLK ? (unsigned)((((R >> 4) * (K >> 5) + (C >> 5)) * 16 + (R & 15)) * 32 + (C & 31)) * 2u : (unsigned)(R * K + C) * 2u; voffB[i] = BBLK ? (unsigned)((((Rb >> 4) * (K >> 5) + (C >> 5)) * 16 + (Rb & 15)) * 32 + (C & 31)) * 2u : (unsigned)(Rb * K + C) * 2u; }
    const size_t kstep = BBLK ? (size_t)2048 : (size_t)(BK * 2);
    const size_t hstep = BBLK ? (size_t)8 * (K >> 5) * 1024 : (size_t)HALF * K * 2;
    const size_t tstep = 2 * hstep;
    const size_t kstepA = ABLK ? (size_t)2048 : (size_t)(BK * 2), hstepA = ABLK ? (size_t)8 * (K >> 5) * 1024 : (size_t)HALF * K * 2, tstepA = 2 * hstepA;
    const unsigned ldsw = (unsigned)wid * 1024u;
    const int aoff = lds_byte(wr * 64 + fr, fq * 8), boff = lds_byte(wc * 32 + fr, fq * 8);
#define PG8_SA(b, h) (((b) * 2 + (h)) * HTB)
#define PG8_SB(b, h) ((4 + (b) * 2 + (h)) * HTB)
#define PG8_STAGE(bufoff, gbase, voff) do { _Pragma("unroll") for (int _i = 0; _i < 2; ++_i) { unsigned vo_ = (voff)[_i]; if constexpr (BBLK || Epi::LAUNDER) asm volatile("" : "+v"(vo_));   \
        __builtin_amdgcn_global_load_lds((const unsigned*)((const char*)(gbase) + vo_), (PG8_LAS unsigned*)(lds + (bufoff) + ldsw + _i * 8192), 16, 0, 0); } } while (0)
#define PG8_LD16A(off) (*(const PG8_LAS i32x4_t*)(abase8 + (off)))
#define PG8_LD16B(off) (*(const PG8_LAS i32x4_t*)(bbase8 + (off)))
#define PG8_LDA(dst, b, h) do { _Pragma("unroll") for (int m = 0; m < 4; ++m) { if constexpr (FP8) dst##8[m] = __builtin_shufflevector(PG8_LD16A(PG8_SA(b, h) + m * 2048), PG8_LD16A(PG8_SA(b, h) + m * 2048 + 1024), 0, 1, 2, 3, 4, 5, 6, 7); \
        else { _Pragma("unroll") for (int k = 0; k < 2; ++k) dst[m][k] = *(const PG8_LAS bf16x8*)(lds + PG8_SA(b, h) + aoff + m * 2048 + k * 1024); } } } while (0)
#define PG8_LDB(dst, b, h) do { _Pragma("unroll") for (int n = 0; n < 2; ++n) { if constexpr (FP8) dst##8[n] = __builtin_shufflevector(PG8_LD16B(PG8_SB(b, h) - 4 * HTB + n * 2048), PG8_LD16B(PG8_SB(b, h) - 4 * HTB + n * 2048 + 1024), 0, 1, 2, 3, 4, 5, 6, 7); \
        else { _Pragma("unroll") for (int k = 0; k < 2; ++k) dst[n][k] = *(const PG8_LAS bf16x8*)(lds + PG8_SB(b, h) + boff + n * 2048 + k * 1024); } } } while (0)
#define PG8_MMA(ai, bj, At, Bt) do { if constexpr (FP8) PG8_SCHED;   __builtin_amdgcn_s_setprio(1); _Pragma("unroll") for (int m = 0; m < 4; ++m) _Pragma("unroll") for (int n = 0; n < 2; ++n) { \
        if constexpr (FP8) acc[ai][bj][m][n] = __builtin_amdgcn_mfma_scale_f32_16x16x128_f8f6f4(Bt##8[n], At##8[m], acc[ai][bj][m][n], 0, 0, 0, sc_w, 0, sc_a); \
        else { _Pragma("unroll") for (int k = 0; k < 2; ++k) acc[ai][bj][m][n] = __builtin_amdgcn_mfma_f32_16x16x32_bf16(Bt[n][k], At[m][k], acc[ai][bj][m][n], 0, 0, 0); } } \
        __builtin_amdgcn_s_setprio(0); if constexpr (FP8) { _Pragma("unroll") for (int m = 0; m < 4; ++m) _Pragma("unroll") for (int n = 0; n < 2; ++n) asm volatile("" : "+v"(acc[ai][bj][m][n]));   PG8_SCHED; } } while (0)
#define PG8_WAIT_V(n) asm volatile("s_waitcnt vmcnt(" #n ")" ::: "memory")
#define PG8_WAIT_L(n) asm volatile("s_waitcnt lgkmcnt(" #n ")" ::: "memory")
#define PG8_BAR __builtin_amdgcn_s_barrier()
#define PG8_SCHED __builtin_amdgcn_sched_barrier(0)
    Unit cur, nxt; int ui = 0;
    if (!S.next(0, cur)) return;
    f32x4 acc[2][2][4][2];
    E.init(acc, cur, wr, wc, fr, fq, -1);
    bf16x8 At[4][2], B0[2][2], B1[2][2];
    v8i_t At8[4], B08[2], B18[2];
    PG8_LAS unsigned char* abase8 = lds + aoff; PG8_LAS unsigned char* bbase8 = lds + 4 * HTB + boff;
    if constexpr (FP8) { asm volatile("" : "+v"(abase8)); asm volatile("" : "+v"(bbase8)); }
    const char* cA = (const char*)g.A + (size_t)cur.pm * tstepA; const char* cB = (const char*)g.Bt + (size_t)cur.pn * tstep;
    S.a_ready(cur);
    if constexpr (SP2) {
        PG8_STAGE(PG8_SB(0, 0), cB, voffB); PG8_STAGE(PG8_SB(0, 1), cB + hstep, voffB); PG8_STAGE(PG8_SA(0, 0), cA, voffA); PG8_STAGE(PG8_SA(0, 1), cA + hstepA, voffA);
        if (wr == 1) PG8_BAR;
        PG8_WAIT_V(2); PG8_BAR;
        PG8_STAGE(PG8_SB(1, 0), cB + kstep, voffB); PG8_STAGE(PG8_SA(1, 0), cA + kstepA, voffA); PG8_STAGE(PG8_SB(1, 1), cB + hstep + kstep, voffB);
        PG8_WAIT_V(6); PG8_BAR;
    } else {
        PG8_STAGE(PG8_SB(0, 0), cB, voffB); PG8_STAGE(PG8_SA(0, 0), cA, voffA); PG8_STAGE(PG8_SB(0, 1), cB + hstep, voffB); PG8_STAGE(PG8_SA(0, 1), cA + hstepA, voffA);
        if (wr == 1) PG8_BAR;
        PG8_WAIT_V(4); PG8_BAR;
        PG8_STAGE(PG8_SB(1, 0), cB + kstep, voffB); PG8_STAGE(PG8_SA(1, 0), cA + kstepA, voffA); PG8_STAGE(PG8_SB(1, 1), cB + hstep + kstep, voffB);
        PG8_WAIT_V(6); PG8_BAR;
    }
    for (;;) {
        const bool has_next = S.next(ui + 1, nxt);
        const char* nA = has_next ? (const char*)g.A + (size_t)nxt.pm * tstepA : cA; const char* nB = has_next ? (const char*)g.Bt + (size_t)nxt.pn * tstep : cB;
        for (int t = 0; t < nt; t += 2) {
            const bool last = (t == nt - 2);
            const char* a1 = cA + (size_t)(t + 1) * kstepA;
            const char* a2 = last ? nA : cA + (size_t)(t + 2) * kstepA; const char* b2 = last ? nB : cB + (size_t)(t + 2) * kstep;
            const char* a3 = a2 + kstepA; const char* b3 = b2 + kstep;
            if (last && has_next) S.a_ready(nxt);
            if constexpr (SP2) {
            PG8_LDB(B0, 0, 0); PG8_LDB(B1, 0, 1); PG8_SCHED; PG8_LDA(At, 0, 0); PG8_STAGE(PG8_SA(1, 1), a1 + hstepA, voffA);
            PG8_WAIT_V(8); PG8_WAIT_L(0); PG8_BAR; PG8_MMA(0, 0, At, B0); PG8_MMA(0, 1, At, B1); PG8_BAR; PG8_SCHED;
            PG8_LDA(At, 0, 1); PG8_STAGE(PG8_SB(0, 0), b2, voffB); PG8_STAGE(PG8_SB(0, 1), b2 + hstep, voffB); PG8_STAGE(PG8_SA(0, 0), a2, voffA);
            PG8_WAIT_V(8); PG8_WAIT_L(0); PG8_BAR; PG8_MMA(1, 0, At, B0); PG8_MMA(1, 1, At, B1); PG8_BAR; PG8_SCHED;
            PG8_LDB(B0, 1, 0); PG8_LDB(B1, 1, 1); PG8_SCHED; PG8_LDA(At, 1, 0); PG8_STAGE(PG8_SA(0, 1), a2 + hstepA, voffA);
            PG8_WAIT_V(8); PG8_WAIT_L(0); PG8_BAR; PG8_MMA(0, 0, At, B0); PG8_MMA(0, 1, At, B1); PG8_BAR; PG8_SCHED;
            PG8_LDA(At, 1, 1); PG8_STAGE(PG8_SB(1, 0), b3, voffB); PG8_STAGE(PG8_SB(1, 1), b3 + hstep, voffB); PG8_STAGE(PG8_SA(1, 0), a3, voffA);
            PG8_WAIT_V(8); PG8_WAIT_L(0); PG8_BAR; PG8_MMA(1, 0, At, B0); PG8_MMA(1, 1, At, B1); PG8_BAR; PG8_SCHED;
            } else {
            PG8_LDB(B0, 0, 0); PG8_SCHED; PG8_LDA(At, 0, 0); PG8_STAGE(PG8_SA(1, 1), a1 + hstepA, voffA);
            PG8_WAIT_L(8); PG8_BAR; PG8_WAIT_L(0); PG8_MMA(0, 0, At, B0); PG8_BAR; PG8_SCHED;
            PG8_LDB(B1, 0, 1); PG8_STAGE(PG8_SB(0, 0), b2, voffB);
            PG8_BAR; PG8_WAIT_L(0); PG8_MMA(0, 1, At, B1); PG8_BAR;
            PG8_LDA(At, 0, 1); PG8_STAGE(PG8_SA(0, 0), a2, voffA);
            PG8_BAR; PG8_WAIT_L(0); PG8_MMA(1, 0, At, B0); PG8_BAR; PG8_SCHED;
            PG8_STAGE(PG8_SB(0, 1), b2 + hstep, voffB);
            PG8_WAIT_V(6); PG8_BAR; PG8_MMA(1, 1, At, B1); PG8_BAR;
            PG8_LDB(B0, 1, 0); PG8_SCHED; PG8_LDA(At, 1, 0); PG8_STAGE(PG8_SA(0, 1), a2 + hstepA, voffA);
            PG8_WAIT_L(8); PG8_BAR; PG8_WAIT_L(0); PG8_MMA(0, 0, At, B0); PG8_BAR; PG8_SCHED;
            PG8_LDB(B1, 1, 1); PG8_STAGE(PG8_SB(1, 0), b3, voffB);
            PG8_BAR; PG8_WAIT_L(0); PG8_MMA(0, 1, At, B1); PG8_BAR;
            PG8_LDA(At, 1, 1); PG8_STAGE(PG8_SA(1, 0), a3, voffA);
            PG8_BAR; PG8_WAIT_L(0); PG8_MMA(1, 0, At, B0); PG8_BAR; PG8_SCHED;
            PG8_STAGE(PG8_SB(1, 1), b3 + hstep, voffB);
            PG8_WAIT_V(6); PG8_BAR; PG8_MMA(1, 1, At, B1); PG8_BAR;
            }
        }
        if constexpr (ALIGN_EPI) { if (wr == 0) PG8_BAR; }
        if constexpr (!Epi::AFTER_DRAIN) { const int l2_ = opq_lane();   E(acc, cur, wr, wc, l2_ & 15, l2_ >> 4); S.done(cur); }
        if (!has_next) break;
        E.init(acc, nxt, wr, wc, fr, fq, cur.pm);
        cur = nxt; cA = nA; cB = nB; ++ui;
        if constexpr (ALIGN_EPI) { if (wr == 1) PG8_BAR; }
    }
    PG8_WAIT_V(0);
    if constexpr (!ALIGN_EPI) { if (wr == 0) PG8_BAR; }
    PG8_BAR;
    if constexpr (Epi::AFTER_DRAIN) { E.fused(acc, cur, wr, wc, fr, fq, lds, wid, lane); S.done(cur); }
#undef PG8_SA
#undef PG8_SB
#undef PG8_STAGE
#undef PG8_LDA
#undef PG8_LD16A
#undef PG8_LD16B
#undef PG8_LDB
#undef PG8_MMA
#undef PG8_WAIT_V
#undef PG8_WAIT_L
#undef PG8_BAR
#undef PG8_SCHED
}
}
#ifndef ATT_EARLY_A
#define ATT_EARLY_A true
#endif
#ifndef ATT_EARLY_B
#define ATT_EARLY_B true
#endif
namespace att {
using bf16x8 = __attribute__((ext_vector_type(8))) short;
using s16x4  = __attribute__((ext_vector_type(4))) short;
using f32x16 = __attribute__((ext_vector_type(16))) float;
using f32x4  = __attribute__((ext_vector_type(4))) float;
using u32x4  = __attribute__((ext_vector_type(4))) unsigned;
typedef unsigned short bf16_t;
constexpr int NW = 8, QBLK = 32, KVBLK = 64, DV = 128, OIMG_OFF = 98304;
constexpr float THR = 6.f;
constexpr int VROW = KVBLK + 16, SHM_V = DV * VROW;
typedef int v8i_t __attribute__((ext_vector_type(8)));
template <int DQK> struct Cfg { static constexpr int KROW = DQK + 16  , SHM_K = KVBLK * KROW, NS = DQK / 64, NKC = (DQK / 16 + 7) / 8, LDS_BYTES = 3 * SHM_V + 3 * SHM_K + NW * 64 * 4;
    static constexpr float SCALE = DQK == 128 ? 0.088388347648318440f : 0.072168783648703220f; };
#define SBAR() __builtin_amdgcn_sched_barrier(0)
__device__ __forceinline__ int crow(int r, int hi) { return (r & 3) + 8 * (r >> 2) + 4 * hi; }
__device__ __forceinline__ unsigned cvtpk(float lo, float hi) { unsigned r; asm volatile("v_cvt_pk_bf16_f32 %0, %1, %2" : "=v"(r) : "v"(lo), "v"(hi)); return r; }
__device__ __forceinline__ float bf2f(short s) { return __uint_as_float(((unsigned)(unsigned short)s) << 16); }
template <int DQK> __device__ __forceinline__ int kswz(int row, int colB) { return row * Cfg<DQK>::KROW + colB; }

constexpr float THRL = THR * 1.4426950408889634f;
template <bool FIRST> __device__ __forceinline__ void partialSM(f32x16& p0, f32x16& p1, f32x16& negm, float& alpha) {
  float pmax = p0[0];
#pragma unroll
  for (int r = 1; r < 16; ++r) pmax = fmaxf(pmax, p0[r]);
#pragma unroll
  for (int r = 0; r < 16; ++r) pmax = fmaxf(pmax, p1[r]);
  { auto rr = __builtin_amdgcn_permlane32_swap(__float_as_uint(pmax), __float_as_uint(pmax), false, false);
    pmax = fmaxf(__uint_as_float(rr[0]), __uint_as_float(rr[1])); }
  if (!FIRST && __builtin_expect(__all(pmax <= THRL), 1)) { alpha = 1.f; }
  else { const float delta = FIRST ? pmax : fmaxf(pmax, 0.f); const float nm = negm[0] - delta; alpha = __builtin_amdgcn_exp2f(-delta);
#pragma unroll
    for (int r = 0; r < 16; ++r) { p0[r] -= delta; p1[r] -= delta; }
#pragma unroll
    for (int r = 0; r < 16; ++r) negm[r] = nm; }
#pragma unroll
  for (int r = 0; r < 16; ++r) p0[r] = __builtin_amdgcn_exp2f(p0[r]);
}
#define ATT_PK4(P, BASE, OUT) do { unsigned a0 = cvtpk(P[BASE + 0], P[BASE + 1]), a1 = cvtpk(P[BASE + 2], P[BASE + 3]);   \
    unsigned b0 = cvtpk(P[BASE + 4], P[BASE + 5]), b1 = cvtpk(P[BASE + 6], P[BASE + 7]);                              \
    auto r0 = __builtin_amdgcn_permlane32_swap(a0, b0, false, false); auto r1 = __builtin_amdgcn_permlane32_swap(a1, b1, false, false); \
    u32x4 w = {r0[0], r1[0], r0[1], r1[1]}; OUT = __builtin_bit_cast(bf16x8, w); } while (0)
__device__ __forceinline__ unsigned pk4_fp8(float a, float b, float c, float d) { return (unsigned)__builtin_amdgcn_cvt_pk_fp8_f32(c, d, __builtin_amdgcn_cvt_pk_fp8_f32(a, b, 0, false), true); }
__device__ __forceinline__ void finishSM(f32x16& p0, f32x16& p1, v8i_t& pa) {
#pragma unroll
  for (int r = 0; r < 16; ++r) p1[r] = __builtin_amdgcn_exp2f(p1[r]);
#pragma unroll
  for (int i = 0; i < 4; ++i) { const unsigned d0 = pk4_fp8(p0[4 * i], p0[4 * i + 1], p0[4 * i + 2], p0[4 * i + 3]), d1 = pk4_fp8(p1[4 * i], p1[4 * i + 1], p1[4 * i + 2], p1[4 * i + 3]);
    auto rr = __builtin_amdgcn_permlane32_swap(d0, d1, false, false); pa[i] = (int)rr[0]; pa[4 + i] = (int)rr[1]; }
}
template <int DQK> __device__ __forceinline__ void qkt(f32x16& p0, f32x16& p1, const char* Ks, const v8i_t (&qf)[DQK / 64], const f32x16& negm, int r32, int hi) {
  p0 = negm; p1 = negm;
#pragma unroll
  for (int s = 0; s < DQK / 64; ++s) { const char* k0 = Ks + kswz<DQK>(r32, 64 * s + 32 * hi); const char* k1 = Ks + kswz<DQK>(32 + r32, 64 * s + 32 * hi);
    const u32x4 a0 = *reinterpret_cast<const u32x4*>(k0), a1 = *reinterpret_cast<const u32x4*>(k0 + 16), b0 = *reinterpret_cast<const u32x4*>(k1), b1 = *reinterpret_cast<const u32x4*>(k1 + 16);
    const v8i_t ka = {(int)a0.x, (int)a0.y, (int)a0.z, (int)a0.w, (int)a1.x, (int)a1.y, (int)a1.z, (int)a1.w}, kb = {(int)b0.x, (int)b0.y, (int)b0.z, (int)b0.w, (int)b1.x, (int)b1.y, (int)b1.z, (int)b1.w};
    p0 = __builtin_amdgcn_mfma_scale_f32_32x32x64_f8f6f4(ka, qf[s], p0, 0, 0, 0, 0x7f7f7f7f, 0, 0x7f7f7f7f);
    p1 = __builtin_amdgcn_mfma_scale_f32_32x32x64_f8f6f4(kb, qf[s], p1, 0, 0, 0, 0x7f7f7f7f, 0, 0x7f7f7f7f); }
}
__device__ __forceinline__ void pv_d0(f32x16* o, f32x16& osum, const char* Vs, const v8i_t& pa, int r32, int hi) {
  { const v8i_t ones = {0x38383838, 0x38383838, 0x38383838, 0x38383838, 0x38383838, 0x38383838, 0x38383838, 0x38383838};
    osum = __builtin_amdgcn_mfma_scale_f32_32x32x64_f8f6f4(pa, ones, osum, 0, 0, 0, 0x7f7f7f7f, 0, 0x7f7f7f7f); }
#pragma unroll
  for (int cb = 0; cb < 4; ++cb) { const char* vp = Vs + (cb * 32 + r32) * VROW + 32 * hi;
    const u32x4 a0 = *reinterpret_cast<const u32x4*>(vp), a1 = *reinterpret_cast<const u32x4*>(vp + 16);
    const v8i_t vf = {(int)a0.x, (int)a0.y, (int)a0.z, (int)a0.w, (int)a1.x, (int)a1.y, (int)a1.z, (int)a1.w};
    o[cb] = __builtin_amdgcn_mfma_scale_f32_32x32x64_f8f6f4(pa, vf, o[cb], 0, 0, 0, 0x7f7f7f7f, 0, 0x7f7f7f7f); }
}
template <int DQK, int SDEPTH, bool RING>
__device__ __forceinline__ void attn_unit(const v8i_t (&qr)[DQK / 64], const unsigned char* __restrict__ Kh, int ldk  , const unsigned char* __restrict__ Vh  , int ldv  ,
                                          unsigned char* __restrict__ Ob  , int ldo, int seq, char* lds, const int wv) {
  using C = Cfg<DQK>; constexpr int SHM_K = C::SHM_K, NKC = C::NKC, CPR = DQK / 16;
  int wid = wv; asm volatile("" : "+s"(wid));
  const int lane = pg8::opq_lane(), tid = wid * 64 + lane, r32 = lane & 31, hi = lane >> 5;
  constexpr int NSLOT = RING ? 3 : 2; constexpr bool EARLY_LD = (DQK == 128) ? ATT_EARLY_B : ATT_EARLY_A;
  char* V_lds = lds; char* K_lds = lds + NSLOT * SHM_V;
  float* ws = (float*)(lds + NSLOT * SHM_V + NSLOT * SHM_K) + wid * 64; float* li_l = ws; float* al_l = ws + 32;
  f32x16 o[4] = {}; f32x16 osum = {}, negm = {};
  const int srow = tid >> 3, sch = tid & 7;
  const unsigned koff = (unsigned)(srow * ldk + sch * 16), voff = (unsigned)((tid >> 2) * ldv + (tid & 3) * 16);
  const int kdst = kswz<DQK>(srow, sch * 16), vdst = (tid >> 2) * VROW + (tid & 3) * 16;
  struct { bf16x8 vs[1], ks[NKC]; } sr_[SDEPTH];
#define ATT_LD8(p) (*reinterpret_cast<const bf16x8*>(p))
#define SLOAD(i, k0) do { const char* vg_ = (const char*)Vh + (k0); const char* kg_ = (const char*)Kh + (size_t)(k0) * ldk; \
    sr_[i].vs[0] = ATT_LD8(vg_ + voff); \
    _Pragma("unroll") for (int q_ = 0; q_ < NKC; ++q_) if (sch + 8 * q_ < CPR) sr_[i].ks[q_] = ATT_LD8(kg_ + koff + q_ * 128); } while (0)
#define SWRITE(b, i) do { *(bf16x8*)(V_lds + (b) * SHM_V + vdst) = sr_[i].vs[0]; \
    _Pragma("unroll") for (int q_ = 0; q_ < NKC; ++q_) if (sch + 8 * q_ < CPR) *(bf16x8*)(K_lds + (b) * SHM_K + kdst + q_ * 128) = sr_[i].ks[q_]; } while (0)
#define SWAIT() do { if constexpr (SDEPTH == 1) asm volatile("s_waitcnt vmcnt(0)" ::: "memory"); else if constexpr (NKC == 1) asm volatile("s_waitcnt vmcnt(2)" ::: "memory"); else asm volatile("s_waitcnt vmcnt(3)" ::: "memory"); } while (0)
#define RESC(a) do { if (__any((a) < 1.f)) { if (hi == 0) al_l[r32] = (a); asm volatile("s_waitcnt lgkmcnt(0)" ::: "memory"); \
    _Pragma("unroll") for (int r = 0; r < 16; ++r) { const float f_ = al_l[crow(r, hi)]; osum[r] *= f_; _Pragma("unroll") for (int d = 0; d < 4; ++d) o[d][r] *= f_; } } } while (0)
  f32x16 pA0, pA1, pB0, pB1; float alA, alB; v8i_t pa; const int NT = seq / KVBLK;
  if constexpr (RING) {
  static_assert(SDEPTH == 1, "the three-slot ring stages one tile ahead");
#define ATT_STEP(PX0, PX1, PY0, PY1, ALY, SC, SP, SN, JJ) do { \
    SBAR(); if constexpr (EARLY_LD) { SLOAD(0, ((JJ) + 1) * KVBLK); SBAR(); } qkt<DQK>(PY0, PY1, K_lds + (SC) * SHM_K, qr, negm, r32, hi); \
    finishSM(PX0, PX1, pa); SBAR(); \
    if constexpr (!EARLY_LD) { SLOAD(0, ((JJ) + 1) * KVBLK); SBAR(); } \
    pv_d0(o, osum, V_lds + (SP) * SHM_V, pa, r32, hi); partialSM<false>(PY0, PY1, negm, ALY); \
    SWAIT(); SWRITE(SN, 0); \
    RESC(ALY); __syncthreads(); } while (0)
  SLOAD(0, 0); asm volatile("s_waitcnt vmcnt(0)" ::: "memory"); SWRITE(0, 0); __syncthreads();
  qkt<DQK>(pA0, pA1, K_lds, qr, negm, r32, hi); partialSM<true>(pA0, pA1, negm, alA);
  SLOAD(0, KVBLK); SWAIT(); SWRITE(1, 0); __syncthreads();
  for (int j = 1; j + 1 < NT; j += 6) {
    ATT_STEP(pA0, pA1, pB0, pB1, alB, 1, 0, 2, j);
    ATT_STEP(pB0, pB1, pA0, pA1, alA, 2, 1, 0, j + 1);
    ATT_STEP(pA0, pA1, pB0, pB1, alB, 0, 2, 1, j + 2);
    ATT_STEP(pB0, pB1, pA0, pA1, alA, 1, 0, 2, j + 3);
    ATT_STEP(pA0, pA1, pB0, pB1, alB, 2, 1, 0, j + 4);
    ATT_STEP(pB0, pB1, pA0, pA1, alA, 0, 2, 1, j + 5);
  }
  SBAR(); qkt<DQK>(pB0, pB1, K_lds + 1 * SHM_K, qr, negm, r32, hi);
  finishSM(pA0, pA1, pa); SBAR();
  pv_d0(o, osum, V_lds, pa, r32, hi); partialSM<false>(pB0, pB1, negm, alB);
  RESC(alB);
  finishSM(pB0, pB1, pa); SBAR();
  pv_d0(o, osum, V_lds + 1 * SHM_V, pa, r32, hi);
#undef ATT_STEP
  } else {
  constexpr int SE = 0, SO = SDEPTH - 1;
  SLOAD(SE, 0); asm volatile("s_waitcnt vmcnt(0)" ::: "memory"); SWRITE(0, SE); __syncthreads();
  qkt<DQK>(pA0, pA1, K_lds, qr, negm, r32, hi); partialSM<true>(pA0, pA1, negm, alA);
  SLOAD(SO, KVBLK); if constexpr (SDEPTH == 2) { if (2 < NT) SLOAD(SE, 2 * KVBLK); }
  SWAIT(); SWRITE(1, SO); __syncthreads();
  for (int j = 1; j + 1 < NT; j += 2) {
    SBAR(); qkt<DQK>(pB0, pB1, K_lds + SHM_K, qr, negm, r32, hi);
    finishSM(pA0, pA1, pa); SBAR();
    SLOAD(SO, (j + SDEPTH) * KVBLK); SBAR();
    pv_d0(o, osum, V_lds, pa, r32, hi); partialSM<false>(pB0, pB1, negm, alB);
    __syncthreads(); SWAIT(); SWRITE(0, SE);
    RESC(alB); __syncthreads();
    SBAR(); qkt<DQK>(pA0, pA1, K_lds, qr, negm, r32, hi);
    finishSM(pB0, pB1, pa); SBAR();
    if (SDEPTH == 1 || j + 3 < NT) SLOAD(SE, (j + 1 + SDEPTH) * KVBLK); SBAR();
    pv_d0(o, osum, V_lds + SHM_V, pa, r32, hi); partialSM<false>(pA0, pA1, negm, alA);
    __syncthreads(); SWAIT(); SWRITE(1, SO);
    RESC(alA); __syncthreads();
  }
  SBAR(); qkt<DQK>(pB0, pB1, K_lds + SHM_K, qr, negm, r32, hi);
  finishSM(pA0, pA1, pa); SBAR();
  pv_d0(o, osum, V_lds, pa, r32, hi); partialSM<false>(pB0, pB1, negm, alB);
  __syncthreads(); RESC(alB);
  finishSM(pB0, pB1, pa); SBAR();
  pv_d0(o, osum, V_lds + SHM_V, pa, r32, hi);
  }
  float rli[16];
#pragma unroll
  for (int r = 0; r < 16; ++r) rli[r] = 64.0f * __builtin_amdgcn_rcpf(osum[r]);
  unsigned char* Ow = Ob + (long)(wid * QBLK) * ldo;
  static_assert(C::LDS_BYTES <= OIMG_OFF, "the output image sits above the K / V^T slots");
  char* oimg = lds + OIMG_OFF + wid * (QBLK * DV);
#pragma unroll
  for (int r = 0; r < 16; ++r) { const int orow = crow(r, hi);
    const unsigned w4 = (unsigned)__builtin_amdgcn_cvt_pk_fp8_f32(o[2][r] * rli[r], o[3][r] * rli[r], __builtin_amdgcn_cvt_pk_fp8_f32(o[0][r] * rli[r], o[1][r] * rli[r], 0, false), true);
    oimg[orow * DV + r32] = (char)(w4 & 0xff); oimg[orow * DV + 32 + r32] = (char)((w4 >> 8) & 0xff); oimg[orow * DV + 64 + r32] = (char)((w4 >> 16) & 0xff); oimg[orow * DV + 96 + r32] = (char)(w4 >> 24); }
  asm volatile("s_waitcnt lgkmcnt(0)" ::: "memory");
#pragma unroll
  for (int i = 0; i < 4; ++i) { const int c_ = i * 64 + lane, row_ = c_ >> 3, ch_ = c_ & 7;
    const u32x4 v_ = *reinterpret_cast<const u32x4*>(oimg + row_ * DV + ch_ * 16); *reinterpret_cast<u32x4*>(Ow + (long)row_ * ldo + ch_ * 16) = v_; }
  __syncthreads();
#undef SLOAD
#undef SWRITE
#undef SWAIT
#undef RESC
#undef ATT_LD8
}

constexpr int MROW = 528, MEM_LDS_BYTES = 256 * MROW;
__device__ __forceinline__ void mem_attn_unit(const bf16_t* __restrict__ Qb, int ldq, const float* __restrict__ gq, float eps, const bf16_t* __restrict__ Kt, int ldk, const bf16_t* __restrict__ VT,
                                              unsigned char* __restrict__ Ob  , int ldo, char* lds, float* wsl, const int wv) {
  int wid = wv; asm volatile("" : "+s"(wid));
  const int lane = pg8::opq_lane(), tid = wid * 64 + lane, r32 = lane & 31, hi = lane >> 5;
  const bf16_t* qp = Qb + (long)(wid * QBLK + r32) * ldq + hi * 8;
  float ss = 0.f;
#pragma unroll
  for (int d0 = 0; d0 < 16; ++d0) { const bf16x8 q = *reinterpret_cast<const bf16x8*>(qp + d0 * 16);
#pragma unroll
    for (int e = 0; e < 8; ++e) { const float f = bf2f(q[e]); ss += f * f; } }
  { auto rr = __builtin_amdgcn_permlane32_swap(__float_as_uint(ss), __float_as_uint(ss), false, false); ss = __uint_as_float(rr[0]) + __uint_as_float(rr[1]); }
  const float rstd = 1.0f / sqrtf(ss * (1.0f / 256.0f) + eps);
  { const int srow = tid >> 5, sch = tid & 31;
#pragma unroll 4
    for (int i = 0; i < 16; ++i) *(bf16x8*)(lds + (srow + 16 * i) * MROW + sch * 16) = *reinterpret_cast<const bf16x8*>(Kt + (long)(srow + 16 * i) * ldk + sch * 8); }
  __syncthreads();
  f32x16 s[8];
#pragma unroll
  for (int kb = 0; kb < 8; ++kb) s[kb] = f32x16{};
  typedef const __attribute__((address_space(3))) bf16x8* lds_frag_t;
  unsigned rd = (unsigned)(uintptr_t)lds + r32 * MROW + hi * 16;
  unsigned rd4 = rd + 4 * 32 * MROW;
  asm volatile("" : "+v"(rd)); asm volatile("" : "+v"(rd4));
#pragma unroll
  for (int d0 = 0; d0 < 16; ++d0) {
    const bf16x8 qraw = *reinterpret_cast<const bf16x8*>(qp + d0 * 16);
    const f32x4 g0 = *(const f32x4*)(gq + d0 * 16 + hi * 8), g1 = *(const f32x4*)(gq + d0 * 16 + hi * 8 + 4);
    float x[8];
#pragma unroll
    for (int e = 0; e < 4; ++e) { x[e] = bf2f(qraw[e]) * rstd * g0[e]; x[4 + e] = bf2f(qraw[4 + e]) * rstd * g1[e]; }
    const u32x4 w = {cvtpk(x[0], x[1]), cvtpk(x[2], x[3]), cvtpk(x[4], x[5]), cvtpk(x[6], x[7])}; const bf16x8 qf = __builtin_bit_cast(bf16x8, w);
#pragma unroll
    for (int kb = 0; kb < 8; ++kb) { const bf16x8 kf = *(lds_frag_t)((kb < 4 ? rd : rd4) + (kb & 3) * 32 * MROW + d0 * 32); s[kb] = __builtin_amdgcn_mfma_f32_32x32x16_bf16(kf, qf, s[kb], 0, 0, 0); } }
  constexpr float C = 0.0625f * 1.4426950408889634f;
  float mx = s[0][0];
#pragma unroll
  for (int kb = 0; kb < 8; ++kb)
#pragma unroll
    for (int r = 0; r < 16; ++r) mx = fmaxf(mx, s[kb][r]);
  { auto rr = __builtin_amdgcn_permlane32_swap(__float_as_uint(mx), __float_as_uint(mx), false, false); mx = fmaxf(__uint_as_float(rr[0]), __uint_as_float(rr[1])); }
  const float mC = -mx * C; float ps = 0.f;
#pragma unroll
  for (int kb = 0; kb < 8; ++kb)
#pragma unroll
    for (int r = 0; r < 16; ++r) { s[kb][r] = __builtin_amdgcn_exp2f(fmaf(s[kb][r], C, mC)); ps += s[kb][r]; }
  { auto rr = __builtin_amdgcn_permlane32_swap(__float_as_uint(ps), __float_as_uint(ps), false, false); ps = __uint_as_float(rr[0]) + __uint_as_float(rr[1]); }
  bf16x8 pa[16];
#pragma unroll
  for (int kb = 0; kb < 8; ++kb) { ATT_PK4(s[kb], 0, pa[2 * kb]); ATT_PK4(s[kb], 8, pa[2 * kb + 1]); }
  __syncthreads();
  { const int srow = tid >> 5, sch = tid & 31;
#pragma unroll 4
    for (int i = 0; i < 16; ++i) *(bf16x8*)(lds + (srow + 16 * i) * MROW + sch * 16) = *reinterpret_cast<const bf16x8*>(VT + (long)(srow + 16 * i) * 256 + sch * 8); }
  __syncthreads();
  float* li_l = wsl + wid * 64;
  if (hi == 0) li_l[r32] = ps; asm volatile("s_waitcnt lgkmcnt(0)" ::: "memory");
  unsigned char* Ow = Ob + (long)(wid * QBLK) * ldo;
#pragma unroll
  for (int half = 0; half < 2; ++half) {
    f32x16 o[4];
#pragma unroll
    for (int c = 0; c < 4; ++c) o[c] = f32x16{};
#pragma unroll
    for (int ks = 0; ks < 16; ++ks)
#pragma unroll
      for (int c = 0; c < 4; ++c) { const bf16x8 vf = *(lds_frag_t)((half == 0 ? rd : rd4) + c * 32 * MROW + ks * 32); o[c] = __builtin_amdgcn_mfma_f32_32x32x16_bf16(pa[ks], vf, o[c], 0, 0, 0); }
#pragma unroll
    for (int r = 0; r < 16; ++r) { const int orow = crow(r, hi); const float rl = 64.0f * __builtin_amdgcn_rcpf(li_l[orow]);
#pragma unroll
      for (int c = 0; c < 4; ++c) Ow[(long)orow * ldo + (half * 4 + c) * 32 + r32] = (unsigned char)(__builtin_amdgcn_cvt_pk_fp8_f32(o[c][r] * rl, 0.f, 0, false) & 0xff); } }
  __syncthreads();
}
#undef SBAR
#undef ATT_PK4
}

#define GAS __attribute__((address_space(1)))
#define LAS __attribute__((address_space(3)))
typedef unsigned short bf16;
typedef unsigned v4u __attribute__((ext_vector_type(4)));
typedef float f32x4 __attribute__((ext_vector_type(4)));
typedef short bf16x8 __attribute__((ext_vector_type(8)));
typedef GAS unsigned gu32;
typedef GAS unsigned long long gu64;
#define RLX_AGENT __ATOMIC_RELAXED, __HIP_MEMORY_SCOPE_AGENT
#define LDS_WAIT() asm volatile("s_waitcnt lgkmcnt(0)" ::: "memory")
#define VM_WAIT() asm volatile("s_waitcnt vmcnt(0)" ::: "memory")
__device__ __forceinline__ unsigned long long rt() { return __builtin_amdgcn_s_memrealtime(); }
__device__ __forceinline__ unsigned f2bf(float f) { unsigned u = __builtin_bit_cast(unsigned, f); return (u + 0x7fffu + ((u >> 16) & 1u)) >> 16; }
__device__ __forceinline__ unsigned pk2(float lo, float hi) { return f2bf(lo) | (f2bf(hi) << 16); }

#define XB_TMO      128
#define XB_XCNT(j)  (256  + 64 * (j))
#define XB_XSUB(j)  (1280 + 64 * (j))
#define XB_XGEN(j)  (2304 + 64 * (j))
#define XB_TOP      3328
#define XB_TOPGEN   3392
#define XCD_BAR_WORDS 3456
#define XB_SPIN_CAP (1u << 18)

__device__ __forceinline__ unsigned xb_ld(unsigned* p)              { return __hip_atomic_load(p, __ATOMIC_RELAXED, __HIP_MEMORY_SCOPE_AGENT); }
__device__ __forceinline__ unsigned xb_add(unsigned* p, unsigned v) { return __hip_atomic_fetch_add(p, v, __ATOMIC_RELAXED, __HIP_MEMORY_SCOPE_AGENT); }
__device__ __forceinline__ unsigned xb_xcc_id() { return (unsigned)__builtin_amdgcn_s_getreg((3 << 11) | 20) & 0xFu; }
#define XB_SPIN(cond, bar) do { unsigned _sp = 0; while (cond) { __builtin_amdgcn_s_sleep(1); \
    if ((++_sp & 255u) == 0u) { if (xb_ld(&(bar)[XB_TMO])) break; if (_sp > XB_SPIN_CAP) { atomicAdd(&(bar)[XB_TMO], 1u); break; } } } } while (0)

struct XcdBarrier {
    unsigned* bar; unsigned x;
    volatile LAS unsigned* st;
};

__device__ __forceinline__ XcdBarrier xcd_barrier_post(unsigned* bar, volatile LAS unsigned* st) {
    XcdBarrier b; b.bar = bar; b.x = xb_xcc_id(); b.st = st;
    if (threadIdx.x == 0) (void)xb_add(&bar[XB_XCNT(b.x)], 1u);
    return b;
}
__device__ __forceinline__ void xcd_barrier_complete(unsigned* bar, unsigned x, unsigned& nloc, unsigned& nx) {
    const unsigned G = gridDim.x * gridDim.y * gridDim.z;
    unsigned sum, cnt, mine, sp = 0u;
    for (;;) {
        sum = 0u; cnt = 0u; mine = 0u;
#pragma unroll
        for (unsigned j = 0; j < 16; ++j) { const unsigned c = xb_ld(&bar[XB_XCNT(j)]); sum += c; cnt += (c > 0u) ? 1u : 0u; mine = (j == x) ? c : mine; }
        if (sum == G) break;
        __builtin_amdgcn_s_sleep(1);
        if ((++sp & 255u) == 0u) { if (xb_ld(&bar[XB_TMO])) break; if (sp > XB_SPIN_CAP) { atomicAdd(&bar[XB_TMO], 1u); break; } }
    }
    nloc = mine > 0u ? mine : 1u; nx = cnt > 0u ? cnt : 1u;
}

__device__ __forceinline__ void xcd_barrier(const XcdBarrier& b) {
    asm volatile("s_waitcnt vmcnt(0)" ::: "memory");
    __syncthreads();
    if (threadIdx.x == 0) {
        unsigned* bar = b.bar;
        __builtin_amdgcn_s_waitcnt(0);
        unsigned nloc = b.st[0], nx = b.st[1];
        if (nloc == 0u) { xcd_barrier_complete(bar, b.x, nloc, nx); b.st[0] = nloc; b.st[1] = nx; }
        const unsigned old = xb_add(&bar[XB_XSUB(b.x)], 1u);
        const unsigned gen = old / nloc;
        if (old + 1u == (gen + 1u) * nloc) {
            __builtin_amdgcn_fence(__ATOMIC_RELEASE, "agent");
            asm volatile("s_waitcnt vmcnt(0)" ::: "memory");
            const unsigned og = xb_add(&bar[XB_TOP], 1u);
            const unsigned tg = og / nx;
            if (og + 1u == (tg + 1u) * nx) xb_add(&bar[XB_TOPGEN], 1u);
            else XB_SPIN(xb_ld(&bar[XB_TOPGEN]) == tg, bar);
            __builtin_amdgcn_fence(__ATOMIC_ACQUIRE, "agent");
            xb_add(&bar[XB_XGEN(b.x)], 1u);
            asm volatile("s_waitcnt vmcnt(0)" ::: "memory");
        } else {
            XB_SPIN(xb_ld(&bar[XB_XGEN(b.x)]) == gen, bar);
            __builtin_amdgcn_fence(__ATOMIC_ACQUIRE, "agent");
            asm volatile("s_waitcnt vmcnt(0)" ::: "memory");
        }
    }
    __syncthreads();
}
constexpr int NWAVES = 8;
constexpr int BATCH = 2, SEQ = 8192, DM = 4096, DFF = 6144, DEPTH = 4, M = BATCH * SEQ;
constexpr int MEMT = 256, MEMR = BATCH * MEMT;
constexpr int NH = 24, HD = 128, TOKW = 3072, MEMW = 1024, MEMHD = 256;
constexpr int A_QL = 1024, A_KVL = 512, A_ROPE = 64, A_IN = 2624, A_INP = 2816, A_QBN = 4608, A_KVBN = 6144, A_KW = NH * 192;
constexpr int B_IN = 5632, B_KVH = 6, B_KW = B_KVH * HD;
constexpr float EPS = 1e-6f;

constexpr size_t MiB = 1u << 20;
constexpr size_t CTL_ZERO_BYTES = 1 * MiB;
constexpr size_t WS_CTL = 0;
constexpr size_t WS_ROPE = 1 * MiB;
constexpr size_t WS_COSA = WS_ROPE, WS_SINA = WS_ROPE + 1 * MiB, WS_COSB = WS_ROPE + 2 * MiB, WS_SINB = WS_ROPE + 4 * MiB;
constexpr size_t WS_PAR = 7 * MiB;
constexpr int PAR_MQ = 0, PAR_QN = 1024, PAR_QP = 1280, PAR_KN = 1408, PAR_KP = 1664, PAR_BQ = 1792, PAR_BK = 2048, PAR_N = 2304;
constexpr size_t WS_RSTD = 7 * MiB + 64 * 1024;
constexpr size_t WS_W = 8 * MiB;
constexpr size_t SZ_GU = (size_t)2 * DFF * DM * 2, SZ_DN = (size_t)DM * DFF * 2, SZ_WO = (size_t)DM * DM * 2;
constexpr size_t SZ_LAYER = 2 * SZ_GU + 2 * SZ_DN + SZ_WO;
constexpr size_t OFF_GU1 = 0, OFF_DN1 = SZ_GU, OFF_GU2 = SZ_GU + SZ_DN, OFF_DN2 = 2 * SZ_GU + SZ_DN, OFF_WO = 2 * SZ_GU + 2 * SZ_DN;
constexpr size_t WS_WMEM = WS_W + DEPTH * SZ_LAYER;
constexpr size_t SZ_AIN = (size_t)A_INP * DM * 2, SZ_AQB = (size_t)A_QBN * A_QL * 2, SZ_AKVB = (size_t)A_KVBN * A_KVL * 2, SZ_A = SZ_AIN + SZ_AQB + SZ_AKVB;
constexpr size_t WS_WA = WS_WMEM + 64 * MiB;
constexpr size_t SZ_BIN = (size_t)B_IN * DM * 2;
constexpr size_t WS_WB = WS_WA + 2 * SZ_A;
constexpr size_t WS_ACT = WS_WB + 2 * SZ_BIN;
constexpr size_t WS_XN = WS_ACT;
constexpr size_t WS_H = WS_XN + (size_t)M * DM * 2;
constexpr size_t WS_O = WS_H + (size_t)M * DFF * 2;
constexpr size_t WS_QM = WS_O + (size_t)M * DM * 2;
constexpr size_t WS_T0 = WS_QM + (size_t)M * MEMW * 2;
constexpr size_t WS_CQ = WS_T0, WS_CKV = WS_CQ + (size_t)M * 1024 * 2, WS_CQN = WS_CKV + (size_t)M * 768 * 2, WS_CKVN = WS_CQN + (size_t)M * 1024 * 2;
constexpr size_t WS_QA = WS_CKVN + (size_t)M * 512 * 2, WS_KVR = WS_QA + (size_t)M * A_QBN * 2, WS_K192 = WS_KVR + (size_t)M * A_KVBN * 2, WS_AEND = WS_K192 + (size_t)M * A_KW * 2;
constexpr size_t WS_QB = WS_T0, WS_KBR = WS_QB + (size_t)M * TOKW * 2, WS_VB = WS_KBR + (size_t)M * B_KW * 2, WS_KB = WS_VB + (size_t)M * B_KW * 2;
constexpr size_t WS_MEMN = WS_AEND;
constexpr size_t WS_MEMKV = WS_MEMN + (size_t)MEMR * DM * 2;
constexpr size_t WS_MK = WS_MEMKV + (size_t)MEMR * 8192 * 2;
constexpr size_t WS_MVT = WS_MK + (size_t)DEPTH * MEMR * 1024 * 2;
constexpr size_t WS_PROBE = WS_MVT + (size_t)DEPTH * MEMR * 1024 * 2;
constexpr size_t WS_RSP = WS_PROBE;
constexpr size_t WS_RSPA = WS_RSP + (size_t)M * 16 * 4;
constexpr size_t WS_END = WS_RSPA + (size_t)M * 16 * 4;
constexpr size_t WS_VT8A = WS_K192 + (size_t)M * A_KW, WS_VT8B = WS_KB + (size_t)M * B_KW;
constexpr size_t WS_X8 = WS_O + (size_t)M * DM;
constexpr size_t OFF_AQM = 8 * MiB, OFF_BQM = 20 * MiB;
constexpr int CW_BAR = 4096;

constexpr int RING_OFF = 0, RING_BYTES = 131072;
constexpr int LDSCTL_OFF = att::MEM_LDS_BYTES, MISC_OFF = LDSCTL_OFF + 320, WSL_OFF = LDSCTL_OFF + 2048;
constexpr int EPI_RED_OFF = WSL_OFF + 2048, EPI_RS_OFF = EPI_RED_OFF + 4096;
constexpr int LDS_BYTES = 147456;
static_assert(2 * 66560 <= att::MEM_LDS_BYTES && att::Cfg<192>::LDS_BYTES <= RING_BYTES && att::MEM_LDS_BYTES >= RING_BYTES && EPI_RS_OFF + 1024 <= LDS_BYTES && EPI_RED_OFF + 8192 <= LDS_BYTES && WSL_OFF + 9216 <= LDS_BYTES, "LDS map");

typedef float f32x4 __attribute__((ext_vector_type(4)));
typedef short bf16x8 __attribute__((ext_vector_type(8)));

struct Args { const float* in[26]; float* out; unsigned char* ws; };

__device__ __forceinline__ unsigned char* opq_ptr(unsigned char* p) { GAS unsigned char* g = (GAS unsigned char*)p; asm volatile("" : "+s"(g)); return (unsigned char*)g; }
struct Frame { LAS unsigned char* lds; int tid, lane, wave, vcu, G, bx, gw, NGW; };

template <int O> __device__ __forceinline__ float xor_add(float v) {
    if constexpr (O == 32) { auto rr = __builtin_amdgcn_permlane32_swap(__float_as_uint(v), __float_as_uint(v), false, false); return __uint_as_float(rr[0]) + __uint_as_float(rr[1]); }
    else return v + __int_as_float(__builtin_amdgcn_ds_swizzle(__float_as_int(v), (O << 10) | 0x1f));
}
template <int LANES> __device__ __forceinline__ float group_sum(float v) {
    if constexpr (LANES > 1) v = xor_add<1>(v);
    if constexpr (LANES > 2) v = xor_add<2>(v);
    if constexpr (LANES > 4) v = xor_add<4>(v);
    if constexpr (LANES > 8) v = xor_add<8>(v);
    if constexpr (LANES > 16) v = xor_add<16>(v);
    if constexpr (LANES > 32) v = xor_add<32>(v);
    return v;
}
__device__ __forceinline__ float wave_sum(float v) { return group_sum<64>(v); }
__device__ __forceinline__ float bf2f(short s) { return __uint_as_float(((unsigned)(unsigned short)s) << 16); }

__device__ __forceinline__ int dst_row(int kind, int n0, int row_off) {
    switch (kind) {
        case 1: { const int up = n0 >= DFF, f = up ? n0 - DFF : n0; return 256 * (f >> 7) + (f & 127) + (up ? 128 : 0); }
        case 2: return n0 < 1024 ? n0 : (n0 < 1600 ? n0 + 1024 : (n0 < 2624 ? n0 - 576 : n0));
        case 3: { const int h = n0 / 192, d = n0 % 192; return d < 128 ? h * 128 + d : 3072 + h * 64 + (d - 128); }
        case 4: { const int h = n0 >> 8, d = n0 & 255; return d < 128 ? h * 128 + d : 3072 + h * 128 + (d - 128); }
        default: return n0 + row_off;
    }
}
struct TrItem { f32x4 a[8], b[8]; };
__device__ __forceinline__ void tr_load(TrItem& t, const float* W, int K, int N, const float* gain, int item, int lane) {
    const int nblk = N >> 6, kb = item / nblk, nb = item - kb * nblk, k0 = 64 * kb, n0 = 64 * nb, c4 = (lane & 15) * 4, rq = lane >> 4;
    const GAS f32x4* src = (const GAS f32x4*)(W + (size_t)(k0 + 2 * rq) * N + n0 + c4); const size_t rs = (size_t)(N >> 2);
#pragma unroll
    for (int i = 0; i < 8; ++i) { t.a[i] = src[(size_t)(8 * i) * rs]; t.b[i] = src[(size_t)(8 * i + 1) * rs]; }
    (void)K; (void)gain;
}
__device__ __forceinline__ void tr_store(const TrItem& t, int K, int N, bf16* WT, int kind, int row_off, const float* gain, LAS unsigned* scr, int item, int lane) {
    const int nblk = N >> 6, kb = item / nblk, nb = item - kb * nblk, k0 = 64 * kb, n0 = 64 * nb, c4 = (lane & 15) * 4, rq = lane >> 4;
    const int r0 = dst_row(kind, n0, row_off);
#pragma unroll
    for (int i = 0; i < 8; ++i) { const float ga = gain ? gain[k0 + 8 * i + 2 * rq] : 1.0f, gb = gain ? gain[k0 + 8 * i + 2 * rq + 1] : 1.0f;
#pragma unroll
        for (int c = 0; c < 4; ++c) scr[(c4 + c) * 33 + 4 * i + rq] = pg8::cvt_pk_bf16(t.a[i][c] * ga, t.b[i][c] * gb); }
    LDS_WAIT(); asm volatile("" ::: "memory");
    const int q = lane & 7;
#pragma unroll
    for (int j = 0; j < 8; ++j) { const int n = 8 * j + (lane >> 3); const LAS unsigned* sp = scr + n * 33 + 4 * q;
        v4u o; o.x = sp[0]; o.y = sp[1]; o.z = sp[2]; o.w = sp[3];
        *(GAS v4u*)(WT + (size_t)(r0 + n) * K + k0 + 8 * q) = o; }
    LDS_WAIT(); asm volatile("" ::: "memory");
}
__device__ __forceinline__ void convert_weight(const Frame& F, const float* W, int K, int N, bf16* WT, int kind, int row_off, const float* gain) {
    LAS unsigned* scr = (LAS unsigned*)(F.lds + RING_OFF + F.wave * 16384);
    const int nitems = (K >> 6) * (N >> 6); const int lane = F.lane;
    TrItem ta, tb; int it = F.gw;
    if (it < nitems) tr_load(ta, W, K, N, gain, it, lane);
    for (; it < nitems; it += 2 * F.NGW) {
        const int it1 = it + F.NGW, it2 = it + 2 * F.NGW;
        if (it1 < nitems) tr_load(tb, W, K, N, gain, it1, lane);
        tr_store(ta, K, N, WT, kind, row_off, gain, scr, it, lane);
        if (it1 < nitems) { if (it2 < nitems) tr_load(ta, W, K, N, gain, it2, lane);
                            tr_store(tb, K, N, WT, kind, row_off, gain, scr, it1, lane); }
    }
}
constexpr int TRW_ROW = 65, TRW_BUF = 256 * TRW_ROW * 4;
__device__ __forceinline__ void convert_weight_wg(const Frame& F, const float* W  , int K, int N  , int NS  , bf16* WT, int kind, int row_off, const float* gain, bool fp8, float wsc = 1.0f  ) {
    const int nblk = (N + 255) >> 8, ntiles = (K >> 7) * nblk, lane = F.lane, w = F.wave;
    f32x4 a[8], b[8]; int tile = F.vcu, par = 0;
    const size_t rs = (size_t)(NS >> 2);
#define TRW_LOAD(t_) do { const int kb_ = (t_) / nblk, nb_ = (t_) - kb_ * nblk; const GAS f32x4* src_ = (const GAS f32x4*)(W + (size_t)(128 * kb_ + 16 * w) * NS + 256 * nb_ + 4 * lane); \
        if (256 * nb_ + 4 * lane < N) { _Pragma("unroll") for (int i = 0; i < 8; ++i) { a[i] = __builtin_nontemporal_load(src_ + (size_t)(2 * i) * rs); b[i] = __builtin_nontemporal_load(src_ + (size_t)(2 * i + 1) * rs); } }     \
        else { _Pragma("unroll") for (int i = 0; i < 8; ++i) { a[i] = (f32x4){0.f, 0.f, 0.f, 0.f}; b[i] = (f32x4){0.f, 0.f, 0.f, 0.f}; } } } while (0)
    if (tile < ntiles) TRW_LOAD(tile);
    for (; tile < ntiles; tile += F.G, par ^= 1) {
        const int kb = tile / nblk, nb = tile - kb * nblk, k0 = 128 * kb, n0 = 256 * nb;
        LAS unsigned* img = (LAS unsigned*)(F.lds + par * TRW_BUF);
        if (!fp8) {
#pragma unroll
        for (int i = 0; i < 8; ++i) { const float ga = gain ? gain[k0 + 16 * w + 2 * i] : 1.0f, gb = gain ? gain[k0 + 16 * w + 2 * i + 1] : 1.0f;
#pragma unroll
            for (int c = 0; c < 4; ++c) img[(c * 64 + lane) * TRW_ROW + 8 * w + i] = pg8::cvt_pk_bf16(a[i][c] * ga, b[i][c] * gb); }
        } else {
#pragma unroll
        for (int q = 0; q < 4; ++q) { const int kk = k0 + 16 * w + 4 * q; const float g0 = (gain ? gain[kk] : 1.0f) * wsc, g1 = (gain ? gain[kk + 1] : 1.0f) * wsc, g2 = (gain ? gain[kk + 2] : 1.0f) * wsc, g3 = (gain ? gain[kk + 3] : 1.0f) * wsc;
#pragma unroll
            for (int c = 0; c < 4; ++c) img[(c * 64 + lane) * TRW_ROW + 4 * w + q] = (unsigned)__builtin_amdgcn_cvt_pk_fp8_f32(a[2 * q + 1][c] * g2, b[2 * q + 1][c] * g3, __builtin_amdgcn_cvt_pk_fp8_f32(a[2 * q][c] * g0, b[2 * q][c] * g1, 0, false), true); }
        }
        if (tile + F.G < ntiles) TRW_LOAD(tile + F.G);
        asm volatile("s_waitcnt lgkmcnt(0)" ::: "memory"); __builtin_amdgcn_s_barrier(); asm volatile("" ::: "memory");
        if (!fp8) {
        const int q = lane & 15;
#pragma unroll
        for (int j = 0; j < 8; ++j) { const int r = 32 * w + 4 * j + (lane >> 4), n = 4 * (r & 63) + (r >> 6); const LAS unsigned* sp = img + r * TRW_ROW + 4 * q;
            v4u o; o.x = sp[0]; o.y = sp[1]; o.z = sp[2]; o.w = sp[3];
            const int dr = dst_row(kind, n0 + (n & ~63), row_off) + (n & 63);
            __builtin_nontemporal_store(o, (GAS v4u*)(WT + (size_t)dr * K + k0 + 8 * q)); }
        } else {
        const int q = lane & 7;
#pragma unroll
        for (int j = 0; j < 4; ++j) { const int r = 32 * w + 8 * j + (lane >> 3), n = 4 * (r & 63) + (r >> 6); const LAS unsigned* sp = img + r * TRW_ROW + 4 * q;
            v4u o; o.x = sp[0]; o.y = sp[1]; o.z = sp[2]; o.w = sp[3];
            const int dr = dst_row(kind, n0 + (n & ~63), row_off) + (n & 63);
            __builtin_nontemporal_store(o, (GAS v4u*)((unsigned char*)WT + (size_t)dr * K + k0 + 16 * q)); }
        }
    }
#undef TRW_LOAD
    asm volatile("s_waitcnt lgkmcnt(0)" ::: "memory"); __builtin_amdgcn_s_barrier(); asm volatile("" ::: "memory");
}
__device__ __forceinline__ void xnorm_rows(const Frame& F, const float* x, bf16* xn, int nrows) {
    const int lane = pg8::opq_lane();
    for (int m = F.gw; m < nrows; m += F.NGW) {
        const GAS f32x4* xr = (const GAS f32x4*)(x + (size_t)m * DM) + lane;
        f32x4 v[16]; float s = 0.f;
#pragma unroll
        for (int j = 0; j < 16; ++j) { v[j] = xr[64 * j]; s += (v[j].x * v[j].x + v[j].y * v[j].y) + (v[j].z * v[j].z + v[j].w * v[j].w); }
        const float rstd = 1.0f / sqrtf(wave_sum(s) * (1.0f / DM) + EPS);
        GAS unsigned long long* o8 = (GAS unsigned long long*)(xn + (size_t)m * DM) + lane;
#pragma unroll
        for (int j = 0; j < 16; ++j) o8[64 * j] = (unsigned long long)pk2(v[j].x * rstd, v[j].y * rstd) | ((unsigned long long)pk2(v[j].z * rstd, v[j].w * rstd) << 32);
    }
}
#ifndef RS_LO
#define RS_LO(w) __uint_as_float((w) << 16)
#define RS_HI(w) __uint_as_float((w) & 0xffff0000u)
#endif
__device__ __forceinline__ void row_stats(const Frame& F, const bf16* xb, float* rstd, unsigned char* x8  ) {
    const int lane = pg8::opq_lane();
    typedef unsigned v2u __attribute__((ext_vector_type(2)));
    for (int rb = F.gw; rb < M / 16; rb += F.NGW) {
        const GAS v4u* p = (const GAS v4u*)(xb + (size_t)rb * 128 * 512) + lane; float ss = 0.f;
        GAS unsigned char* q8 = (GAS unsigned char*)x8 + ((size_t)rb * 64 * 16 + (lane >> 2)) * 64 + 8 * (lane & 3);
#pragma unroll 1
        for (int c0 = 0; c0 < 128; c0 += 16) { v4u v[16];
#pragma unroll
            for (int c = 0; c < 16; ++c) v[c] = p[(c0 + c) * 64];
#pragma unroll
            for (int c = 0; c < 16; ++c) { float f[8];
#pragma unroll
                for (int e = 0; e < 4; ++e) { f[2 * e] = RS_LO(v[c][e]); f[2 * e + 1] = RS_HI(v[c][e]); ss += f[2 * e] * f[2 * e] + f[2 * e + 1] * f[2 * e + 1]; }
                if (x8) { v2u w8;
                    w8.x = (unsigned)__builtin_amdgcn_cvt_pk_fp8_f32(f[2], f[3], __builtin_amdgcn_cvt_pk_fp8_f32(f[0], f[1], 0, false), true);
                    w8.y = (unsigned)__builtin_amdgcn_cvt_pk_fp8_f32(f[6], f[7], __builtin_amdgcn_cvt_pk_fp8_f32(f[4], f[5], 0, false), true);
                    *(GAS v2u*)(q8 + (c >> 1) * 1024 + (c & 1) * 32) = w8; } }
            q8 += 8 * 1024; }
        ss = group_sum<4>(ss);
        if ((lane & 3) == 0) rstd[rb * 16 + (lane >> 2)] = 1.0f / sqrtf(ss * (1.0f / DM) + EPS);
    }
}
__device__ __forceinline__ void xcast_blocked(const Frame& F, const float* x, bf16* xb, float* rstd, float* rsp) {
    const int lane = pg8::opq_lane();
    for (int rb = F.gw; rb < M / 16; rb += F.NGW) {
        const GAS f32x4* src = (const GAS f32x4*)(x + (size_t)(rb * 16 + (lane >> 2)) * DM + 8 * (lane & 3)); GAS v4u* dst = (GAS v4u*)(xb + (size_t)rb * 128 * 512) + lane; float ss = 0.f;
#pragma unroll 2
        for (int c0 = 0; c0 < 128; c0 += 8) { f32x4 a[8], b[8];
#pragma unroll
            for (int c = 0; c < 8; ++c) { a[c] = src[(c0 + c) * 8]; b[c] = src[(c0 + c) * 8 + 1]; }
#pragma unroll
            for (int c = 0; c < 8; ++c) { v4u w; w.x = pk2(a[c].x, a[c].y); w.y = pk2(a[c].z, a[c].w); w.z = pk2(b[c].x, b[c].y); w.w = pk2(b[c].z, b[c].w); dst[(c0 + c) * 64] = w;
#pragma unroll
                for (int e = 0; e < 4; ++e) { const float lo = __uint_as_float(w[e] << 16), hi = __uint_as_float(w[e] & 0xffff0000u); ss += lo * lo + hi * hi; } } }
        ss = group_sum<4>(ss);
        if ((lane & 3) == 0) rstd[rb * 16 + (lane >> 2)] = 1.0f / sqrtf(ss * (1.0f / DM) + EPS);
        *(GAS f32x4*)(rsp + (size_t)(rb * 16 + (lane >> 2)) * 16 + 4 * (lane & 3)) = (f32x4){(lane & 3) == 0 ? ss : 0.f, 0.f, 0.f, 0.f};
    }
}
template <int L, bool GAIN, bool ROPE, int REP, bool OUT8 = false, int U = 1  >
__device__ __forceinline__ void seg_norm(const Frame& F, const bf16* src, long src_ld, int src_ss, int spr, long nseg, bf16* dst, long dst_ld, int dst_ss, const float* gain, const float* cs, const float* sn) {
    constexpr int LPS = (L / 8 >= 64) ? 64 : L / 8, CPL = L / 8 / LPS, SPW = 64 / LPS;
    const int lane = pg8::opq_lane(), sl = lane % LPS, sg = lane / LPS;
    const long step = (long)F.NGW * SPW;
    for (long s0 = (long)F.gw * SPW; s0 < nseg; s0 += step * U) {
        bf16x8 raw[U][CPL];
#pragma unroll
        for (int u = 0; u < U; ++u) { const long seg = s0 + u * step + sg; if (seg < nseg) { const long row = seg / spr; const int si = (int)(seg % spr); const bf16* sp = src + row * src_ld + (long)si * src_ss;
#pragma unroll
            for (int c = 0; c < CPL; ++c) raw[u][c] = *(const bf16x8*)(sp + (c * LPS + sl) * 8); } }
#pragma unroll
        for (int u = 0; u < U; ++u) { const long seg = s0 + u * step + sg; if (seg >= nseg) continue;
        const long row = seg / spr; const int si = (int)(seg % spr);
        float ss = 0.f;
#pragma unroll
        for (int c = 0; c < CPL; ++c)
#pragma unroll
            for (int e = 0; e < 8; ++e) { const float f = bf2f(raw[u][c][e]); ss += f * f; }
        ss = group_sum<LPS>(ss);
        const float rstd = 1.0f / sqrtf(ss * (1.0f / L) + EPS);
        const int pos = (int)(row % SEQ);
#pragma unroll
        for (int c = 0; c < CPL; ++c) { const int e0 = (c * LPS + sl) * 8; float x[8];
#pragma unroll
            for (int e = 0; e < 8; ++e) x[e] = bf2f(raw[u][c][e]) * rstd;
            if (GAIN) { const f32x4 g0 = *(const f32x4*)(gain + e0), g1 = *(const f32x4*)(gain + e0 + 4);
#pragma unroll
                for (int e = 0; e < 4; ++e) { x[e] *= g0[e]; x[4 + e] *= g1[e]; } }
            if (ROPE) { const f32x4 cv = *(const f32x4*)(cs + (size_t)pos * (L / 2) + e0 / 2), sv = *(const f32x4*)(sn + (size_t)pos * (L / 2) + e0 / 2);
#pragma unroll
                for (int p = 0; p < 4; ++p) { const float a = x[2 * p], b = x[2 * p + 1]; x[2 * p] = a * cv[p] - b * sv[p]; x[2 * p + 1] = a * sv[p] + b * cv[p]; } }
            if constexpr (OUT8) {
                typedef unsigned v2u __attribute__((ext_vector_type(2))); v2u w8;
                w8.x = (unsigned)__builtin_amdgcn_cvt_pk_fp8_f32(x[2], x[3], __builtin_amdgcn_cvt_pk_fp8_f32(x[0], x[1], 0, false), true);
                w8.y = (unsigned)__builtin_amdgcn_cvt_pk_fp8_f32(x[6], x[7], __builtin_amdgcn_cvt_pk_fp8_f32(x[4], x[5], 0, false), true);
                unsigned char* dp = (unsigned char*)dst + row * dst_ld + (long)si * dst_ss + e0;
#pragma unroll
                for (int r = 0; r < REP; ++r) *(v2u*)(dp + (long)r * dst_ss) = w8;
            } else {
            v4u w; w.x = pk2(x[0], x[1]); w.y = pk2(x[2], x[3]); w.z = pk2(x[4], x[5]); w.w = pk2(x[6], x[7]);
            bf16* dp = dst + row * dst_ld + (long)si * dst_ss + e0;
#pragma unroll
            for (int r = 0; r < REP; ++r) *(v4u*)(dp + (long)r * dst_ss) = w; } } }
    }
}
__device__ __forceinline__ void sincos_d(float ang, float& c, float& s) {
    const double a = (double)ang, k = __builtin_rint(a * 0.63661977236758134308), r = __builtin_fma(-k, 1.57079632679489661923, a) - k * 6.123233995736766e-17, r2 = r * r;
    double sp = -7.6471637318198164759e-13; sp = sp * r2 + 1.6059043836821614599e-10; sp = sp * r2 - 2.5052108385441718775e-08; sp = sp * r2 + 2.7557319223985890653e-06; sp = sp * r2 - 1.9841269841269841270e-04;
    sp = sp * r2 + 8.3333333333333333333e-03; sp = sp * r2 - 1.6666666666666666667e-01; sp = sp * r2 * r + r;
    double cp = 4.7794773323873852974e-14; cp = cp * r2 - 1.1470745597729724714e-11; cp = cp * r2 + 2.0876756987868098979e-09; cp = cp * r2 - 2.7557319223985890653e-07; cp = cp * r2 + 2.4801587301587301587e-05;
    cp = cp * r2 - 1.3888888888888888889e-03; cp = cp * r2 + 4.1666666666666666667e-02; cp = cp * r2 - 0.5; cp = cp * r2 + 1.0;
    const int q = ((int)k) & 3;
    const double cc = (q == 0) ? cp : (q == 1) ? -sp : (q == 2) ? -cp : sp, sv = (q == 0) ? sp : (q == 1) ? cp : (q == 2) ? -sp : -cp;
    c = (float)cc; s = (float)sv;
}
__device__ __forceinline__ float inv_freq(int axis_dim, int j) {
    constexpr float FA[16] = {1.f, 0.562341332f, 0.316227764f, 0.177827939f, 0.100000001f, 0.0562341325f, 0.0316227749f, 0.0177827943f, 0.00999999978f, 0.00562341325f, 0.00316227763f, 0.00177827943f, 0.00100000005f, 0.000562341302f, 0.000316227757f, 0.00017782794f};
    constexpr float FB[32] = {1.f, 0.749894261f, 0.562341332f, 0.421696514f, 0.316227764f, 0.237137377f, 0.177827939f, 0.133352131f, 0.100000001f, 0.0749894157f, 0.0562341325f, 0.0421696529f, 0.0316227749f, 0.0237137377f, 0.0177827943f, 0.0133352149f,
                              0.00999999978f, 0.00749894185f, 0.00562341325f, 0.00421696482f, 0.00316227763f, 0.00237137359f, 0.00177827943f, 0.00133352145f, 0.00100000005f, 0.000749894243f, 0.000562341302f, 0.000421696517f, 0.000316227757f, 0.00023713737f, 0.00017782794f, 0.00013335215f};
    return axis_dim == 32 ? FA[j] : FB[j];
}

#ifndef QM_FP8
#define QM_FP8 true
#endif
#ifndef ATT_RING_A
#define ATT_RING_A true
#endif
#ifndef ATT_RING_B
#define ATT_RING_B true
#endif
#ifndef ATT_SD_A
#define ATT_SD_A 1
#endif
#ifndef ATT_SD_B
#define ATT_SD_B 1
#endif
__device__ __forceinline__ void vt_fp8(const Frame& F, const bf16* V, int ldv, int NHV, unsigned char* VT) {
    const int lane = pg8::opq_lane(), ncb = NHV * 2, nitems = (M / 64) * ncb;
    LAS unsigned char* img = F.lds + RING_OFF + F.wave * 16384; constexpr int IROW = 132;
    for (int it = F.gw; it < nitems; it += F.NGW) {
        const int kt = it / ncb, ct = it - kt * ncb, k0 = 64 * kt, c = 64 * ct + lane, b = k0 / SEQ;
        const bf16* src = V + (size_t)(k0 + (lane >> 3)) * ldv + 64 * ct + 8 * (lane & 7);
        v4u t[8];
#pragma unroll
        for (int i = 0; i < 8; ++i) t[i] = *(const GAS v4u*)(src + (size_t)(8 * i) * ldv);
#pragma unroll
        for (int i = 0; i < 8; ++i) { LAS unsigned* d = (LAS unsigned*)(img + ((lane >> 3) + 8 * i) * IROW + 16 * (lane & 7)); d[0] = t[i].x; d[1] = t[i].y; d[2] = t[i].z; d[3] = t[i].w; }
        LDS_WAIT(); asm volatile("" ::: "memory");
        float v[64];
#pragma unroll
        for (int i = 0; i < 64; ++i) v[i] = __uint_as_float((unsigned)*(const LAS unsigned short*)(img + i * IROW + 2 * lane) << 16);
        LDS_WAIT(); asm volatile("" ::: "memory");
        unsigned char* dst = VT + ((size_t)(b * NHV + (c >> 7)) * 128 + (c & 127)) * SEQ + (k0 - b * SEQ);
#pragma unroll
        for (int g = 0; g < 2; ++g) { v4u w0, w1;
#pragma unroll
            for (int d = 0; d < 4; ++d) { const int kb = 32 * g + 8 * d;
                w0[d] = (unsigned)__builtin_amdgcn_cvt_pk_fp8_f32(v[kb + 2], v[kb + 3], __builtin_amdgcn_cvt_pk_fp8_f32(v[kb], v[kb + 1], 0, false), true);
                w1[d] = (unsigned)__builtin_amdgcn_cvt_pk_fp8_f32(v[kb + 6], v[kb + 7], __builtin_amdgcn_cvt_pk_fp8_f32(v[kb + 4], v[kb + 5], 0, false), true); }
            *(v4u*)(dst + 32 * g) = w0; *(v4u*)(dst + 32 * g + 16) = w1; }
    }
}
struct QRaw { att::bf16x8 v[4]; };
__device__ __forceinline__ QRaw q_load(const bf16* p) { QRaw r;
#pragma unroll
    for (int i = 0; i < 4; ++i) r.v[i] = *(const att::bf16x8*)(p + 8 * i);
    return r; }
__device__ __forceinline__ float q_ss(const QRaw& r) { float s = 0.f;
#pragma unroll
    for (int i = 0; i < 4; ++i)
#pragma unroll
        for (int e = 0; e < 8; ++e) { const float f = bf2f(r.v[i][e]); s += f * f; }
    return s; }
template <bool ROPE> __device__ __forceinline__ att::v8i_t q_fp8(const QRaw& r, float rstd, const float* gain32, const float* cos16, const float* sin16) {
    att::v8i_t o;
#pragma unroll
    for (int i = 0; i < 4; ++i) { const f32x4 g0 = *(const f32x4*)(gain32 + 8 * i), g1 = *(const f32x4*)(gain32 + 8 * i + 4); float x[8];
#pragma unroll
        for (int e = 0; e < 4; ++e) { x[e] = bf2f(r.v[i][e]) * rstd * g0[e]; x[4 + e] = bf2f(r.v[i][4 + e]) * rstd * g1[e]; }
        if (ROPE) { const f32x4 cv = *(const f32x4*)(cos16 + 4 * i), sv = *(const f32x4*)(sin16 + 4 * i);
#pragma unroll
            for (int p = 0; p < 4; ++p) { const float a = x[2 * p], c = x[2 * p + 1]; x[2 * p] = a * cv[p] - c * sv[p]; x[2 * p + 1] = a * sv[p] + c * cv[p]; } }
        o[2 * i] = __builtin_amdgcn_cvt_pk_fp8_f32(x[2], x[3], __builtin_amdgcn_cvt_pk_fp8_f32(x[0], x[1], 0, false), true);
        o[2 * i + 1] = __builtin_amdgcn_cvt_pk_fp8_f32(x[6], x[7], __builtin_amdgcn_cvt_pk_fp8_f32(x[4], x[5], 0, false), true); }
    return o; }
__device__ __forceinline__ int opq_i(int v) { asm volatile("" : "+s"(v)); return v; }
__device__ __forceinline__ Frame make_frame(LAS unsigned char* lds, const int wv) {
    Frame F; F.lds = lds; F.lane = pg8::opq_lane(); F.wave = opq_i(wv); F.tid = F.wave * 64 + F.lane;
    F.G = opq_i((int)gridDim.x); F.bx = opq_i((int)blockIdx.x); F.vcu = (F.G % 8 == 0) ? (F.bx % 8) * (F.G / 8) + F.bx / 8 : F.bx;
    F.gw = F.vcu * NWAVES + F.wave; F.NGW = F.G * NWAVES; return F;
}
template <class Epi, bool ABLK = false, bool FP8 = false, bool BBLK = false> __device__ __forceinline__ void gemm_site(LAS unsigned char* ldsp, const int wv, const void* A, const void* Bt, int Mr, int N, int K, const Epi& E, const int sc_w = 0x7f7f7f7f, const int sc_a = 0x7f7f7f7f) {
    const Frame F = make_frame(ldsp, wv);
    pg8::Gemm g{(const pg8::bf16_t*)A, (const pg8::bf16_t*)Bt, Mr, N, K}; pg8::StaticOrder S; S.init(Mr, N, F.G, F.bx);
    pg8::gemm_phase<Epi, pg8::StaticOrder, true, true, ABLK, FP8, BBLK>(F.lds + RING_OFF, g, S, E, wv, sc_w, sc_a);
}
__device__ __forceinline__ void conv_job(const Frame& F, const Args& args, unsigned char* ws, const int job) {
            const float* W; const float* gain = nullptr; int K, N, NS, kind = 0, row_off = 0; size_t dst; bool fp8 = false;
            if (job < 24) { const int l = job / 6, t = job % 6; const size_t lo = WS_W + (size_t)l * SZ_LAYER;
                if (t == 0)      { W = args.in[3] + (size_t)l * DM * 2 * DFF; K = DM; N = 2 * DFF; dst = lo + OFF_GU1; kind = 1; gain = args.in[2] + l * DM; }
                else if (t == 1) { W = args.in[4] + (size_t)l * DFF * DM; K = DFF; N = DM; dst = lo + OFF_DN1; }
                else if (t == 2) { W = args.in[12] + (size_t)l * DM * 2 * DFF; K = DM; N = 2 * DFF; dst = lo + OFF_GU2; kind = 1; gain = args.in[11] + l * DM; }
                else if (t == 3) { W = args.in[13] + (size_t)l * DFF * DM; K = DFF; N = DM; dst = lo + OFF_DN2; }
                else if (t == 4) { W = args.in[6] + (size_t)l * DM * DM; K = DM; N = DM; dst = lo + OFF_WO; fp8 = true; }
                else             { W = args.in[8] + (size_t)l * DM * 2048; K = DM; N = 2048; dst = WS_WMEM; row_off = l * 2048; gain = args.in[7] + l * DM; }
                NS = N;
            } else { const int j = (job - 24) / 6, t = (job - 24) % 6; const size_t ao = WS_WA + (size_t)j * SZ_A;
                if (t == 0)      { W = args.in[14] + (size_t)j * DM * A_IN; K = DM; N = 1600; NS = A_IN; dst = ao; gain = args.in[5] + (2 * j) * DM; fp8 = true; }
                else if (t == 1) { W = args.in[14] + (size_t)j * DM * A_IN + 1600; K = DM; N = 1024; NS = A_IN; dst = ao + OFF_AQM; gain = args.in[5] + (2 * j) * DM; fp8 = QM_FP8; }
                else if (t == 2) { W = args.in[17] + (size_t)j * A_QL * A_QBN; K = A_QL; N = A_QBN; NS = N; dst = ao + SZ_AIN; kind = 3; gain = args.in[15] + j * A_QL; fp8 = true; }
                else if (t == 3) { W = args.in[18] + (size_t)j * A_KVL * A_KVBN; K = A_KVL; N = A_KVBN; NS = N; dst = ao + SZ_AIN + SZ_AQB; kind = 4; gain = args.in[16] + j * A_KVL; fp8 = true; }
                else if (t == 4) { W = args.in[23] + (size_t)j * DM * B_IN; K = DM; N = 4608; NS = B_IN; dst = WS_WB + (size_t)j * SZ_BIN; gain = args.in[5] + (2 * j + 1) * DM; fp8 = true; }
                else             { W = args.in[23] + (size_t)j * DM * B_IN + 4608; K = DM; N = 1024; NS = B_IN; dst = WS_WB + (size_t)j * SZ_BIN + OFF_BQM; gain = args.in[5] + (2 * j + 1) * DM; fp8 = QM_FP8; }
            }
            const float wsc = (job < 24) ? 64.0f : ((((job - 24) % 6) == 2) ? 32.0f : ((((job - 24) % 6) == 3) ? 16.0f : 64.0f));
            convert_weight_wg(F, W, K, N, NS, (bf16*)(ws + dst), kind, row_off, gain, fp8, wsc);
}
__device__ __forceinline__ void conv_slot(LAS unsigned char* ldsp, const int wv, const Args& args, unsigned char* ws, const int l, const int k) {
    if (k > 6) return;
    const Frame F = make_frame(ldsp, wv);
    const int ln = l + 1, jb = 24 + (ln >> 1) * 6;
    if (k < 3) { conv_job(F, args, ws, l * 6 + (k == 0 ? 2 : k == 1 ? 3 : 4)); }
    else if (ln >= DEPTH) return;
    else if (k < 5) { conv_job(F, args, ws, ln * 6 + (k == 3 ? 0 : 1)); }
    else if ((ln & 1) == 0) { conv_job(F, args, ws, jb + (k == 5 ? 0 : 2)); conv_job(F, args, ws, jb + (k == 5 ? 1 : 3)); }
    else { conv_job(F, args, ws, jb + (k == 5 ? 4 : 5)); }
}
__global__ void __launch_bounds__(NWAVES * 64, 2) fwd_kernel(Args args) {
    extern __shared__ __attribute__((aligned(16))) unsigned char lds[];
    LAS unsigned char* const ldsp = (LAS unsigned char*)lds;
    unsigned char* const ws = args.ws;
    const int wv = __builtin_amdgcn_readfirstlane((int)threadIdx.x >> 6);
    { const int tid = threadIdx.x; for (int u = tid; u < (LDS_BYTES - LDSCTL_OFF) / 4; u += NWAVES * 64) ((LAS unsigned*)(ldsp + LDSCTL_OFF))[u] = 0u; }
    __syncthreads();
    XcdBarrier bar = xcd_barrier_post((unsigned*)(ws + WS_CTL) + CW_BAR, (volatile LAS unsigned*)(ldsp + MISC_OFF) + 8);
#define GRID_BAR() xcd_barrier(bar)
#define WSP (opq_ptr(ws))
#define OUTP ((float*)opq_ptr((unsigned char*)args.out))

#ifdef PROBE_PRO
    for (int rep_ = 0; rep_ < 2; ++rep_)
#endif
    {
        const Frame F = make_frame(ldsp, wv);
#ifdef PROBE_CONV
        for (int rep2_ = 0; rep2_ < 2; ++rep2_)
#endif
        for (int job = 0; job < 36; ++job) {
            if (!((job < 24 && ((job < 2 && F.G <= 64) || job % 6 == 5)) || (job >= 24 && job < 28))) continue;
            conv_job(F, args, ws, job);
        }
        { float* par = (float*)(ws + WS_PAR);
          for (int i = F.gw * 64 + F.lane; i < PAR_N; i += F.NGW * 64) {
              float v;
              if (i < PAR_QN) v = args.in[9][i]; else if (i < PAR_QP) v = args.in[19][i - PAR_QN]; else if (i < PAR_KN) v = args.in[20][i - PAR_QP]; else if (i < PAR_KP) v = args.in[21][i - PAR_KN];
              else if (i < PAR_BQ) v = args.in[22][i - PAR_KP]; else if (i < PAR_BK) v = args.in[24][i - PAR_BQ]; else v = args.in[25][i - PAR_BK];
              par[i] = v; } }
        { float* cA = (float*)(ws + WS_COSA); float* sA = (float*)(ws + WS_SINA); float* cB = (float*)(ws + WS_COSB); float* sB = (float*)(ws + WS_SINB);
          for (int i = F.gw * 64 + F.lane; i < SEQ * 32; i += F.NGW * 64) { const int t = i >> 5, p = i & 31; const float pos = (float)(p < 16 ? (t >> 6) : (t & 63)); float c, s; sincos_d(pos * inv_freq(32, p & 15), c, s); cA[i] = c; sA[i] = s; }
          for (int i = F.gw * 64 + F.lane; i < SEQ * 64; i += F.NGW * 64) { const int t = i >> 6, p = i & 63; const float pos = (float)(p < 32 ? (t >> 6) : (t & 63)); float c, s; sincos_d(pos * inv_freq(64, p & 31), c, s); cB[i] = c; sB[i] = s; } }
        xnorm_rows(F, args.in[1], (bf16*)(ws + WS_MEMN), MEMR);
        xcast_blocked(F, args.in[0], (bf16*)(ws + WS_XN), (float*)(ws + WS_RSTD), (float*)(ws + WS_RSP));
    }
    GRID_BAR();
    { const Frame F = make_frame(ldsp, wv);
      if (F.G > 64 && F.bx >= 64) { Frame Fc = F; Fc.vcu = F.bx - 64; Fc.G = F.G - 64; conv_job(Fc, args, ws, 0); conv_job(Fc, args, ws, 1); } }
    { unsigned char* const w = WSP; typedef pg8::EpiBf16One<WS_MEMKV, 8192> EpiT; const EpiT E{w, nullptr, nullptr};
      gemm_site<EpiT>(ldsp, wv, w + WS_MEMN, w + WS_WMEM, MEMR, 8192, DM, E); }
    GRID_BAR();
    {
        const Frame F = make_frame(ldsp, wv); unsigned char* const w = WSP;
        for (int l = 0; l < DEPTH; ++l)
            seg_norm<256, true, false, 1>(F, (const bf16*)(w + WS_MEMKV) + l * 2048, 8192, 256, 4, (long)MEMR * 4, (bf16*)(w + WS_MK) + (size_t)l * MEMR * 1024, 1024, 256, args.in[10] + l * MEMHD, nullptr, nullptr);
        const bf16* mkv = (const bf16*)(w + WS_MEMKV); bf16* vt = (bf16*)(w + WS_MVT);
        for (int i = F.gw * 64 + F.lane; i < DEPTH * BATCH * 4 * 256 * 32; i += F.NGW * 64) {
            const int col = i & 255, kc = (i >> 8) & 31, mh = (i >> 13) & 3, b = (i >> 15) & 1, l = i >> 16;
            const bf16* sp = mkv + (size_t)(b * 256 + kc * 8) * 8192 + l * 2048 + 1024 + mh * 256 + col;
            v4u o; o.x = (unsigned)sp[0] | ((unsigned)sp[8192] << 16); o.y = (unsigned)sp[2 * 8192] | ((unsigned)sp[3 * 8192] << 16); o.z = (unsigned)sp[4 * 8192] | ((unsigned)sp[5 * 8192] << 16); o.w = (unsigned)sp[6 * 8192] | ((unsigned)sp[7 * 8192] << 16);
            *(v4u*)(vt + ((size_t)((l * 2 + b) * 4 + mh) * 256 + col) * 256 + kc * 8) = o; }
    }

    for (int l = 0; l < DEPTH; ++l) {
        const size_t wl_off = WS_W + (size_t)l * SZ_LAYER;
#define isA ((opq_i(l) & 1) == 0)
#define j (opq_i(l) >> 1)
        for (int f = 0; f < 2; ++f) {
#ifdef PROBE_GU
            for (int rep_ = 0; rep_ < (f == 0 ? 2 : 1); ++rep_)
#endif
            { unsigned char* const w = WSP; const pg8::EpiSwiGLU E{(pg8::bf16_t*)(w + WS_H), DFF, (const float*)(w + WS_RSP), (LAS float*)(ldsp + EPI_RS_OFF)};
              gemm_site<pg8::EpiSwiGLU, true>(ldsp, wv, w + WS_XN, w + wl_off + (f ? OFF_GU2 : OFF_GU1), M, 2 * DFF, DM, E);
            GRID_BAR(); }
            if (opq_i(l) == DEPTH - 1 && opq_i(f) == 1) {
                unsigned char* const w = WSP; const pg8::EpiResidOut E{(const pg8::bf16_t*)(w + WS_XN), OUTP, DM, 0.5f};
                gemm_site<pg8::EpiResidOut, true>(ldsp, wv, w + WS_H, w + wl_off + OFF_DN2, M, DM, DFF, E);
                continue;
            }
            { unsigned char* const w = WSP; const pg8::EpiResidB E{(pg8::bf16_t*)(w + WS_XN), 0.5f, (float*)(w + WS_RSP), (LAS float*)(ldsp + EPI_RED_OFF), opq_i(f) == 0 ? w + WS_X8 : nullptr};
              gemm_site<pg8::EpiResidB, true>(ldsp, wv, w + WS_H, w + wl_off + (f ? OFF_DN2 : OFF_DN1), M, DM, DFF, E); }
            GRID_BAR();
            if (opq_i(f) != 0) continue;
#ifdef PROBE_WIN
            for (int rep_ = 0; rep_ < 2; ++rep_)
#endif
            {
                unsigned char* const w = WSP; const float* const rs = (const float*)(w + WS_RSP); LAS float* const rl = (LAS float*)(ldsp + EPI_RS_OFF);
                typedef pg8::EpiBf16Seg<true, (1 << 30), (1 << 30), (1 << 30), WS_QM, 0, 0, 0, 1024, 0, 0, 0> EpiQM;
                typedef pg8::EpiBf16Seg<true, 4, (1 << 30), (1 << 30), WS_CQ, WS_CKV, 0, 0, 1024, 768, 0, 0> EpiA; typedef pg8::EpiBf16Seg<true, 12, 15, (1 << 30), WS_QB, WS_KBR, WS_VB, 0, 3072, 768, 768, 0> EpiB;
                { const EpiQM E{w, rs, rl}; if constexpr (QM_FP8) gemm_site<EpiQM, true, true>(ldsp, wv, w + WS_X8, isA ? w + WS_WA + (size_t)j * SZ_A + OFF_AQM : w + WS_WB + (size_t)j * SZ_BIN + OFF_BQM, M, 1024, DM / 2, E, 0x79797979);
                  else gemm_site<EpiQM, true>(ldsp, wv, w + WS_XN, isA ? w + WS_WA + (size_t)j * SZ_A + OFF_AQM : w + WS_WB + (size_t)j * SZ_BIN + OFF_BQM, M, 1024, DM, E); }
                if (isA) { typedef pg8::EpiA8<WS_CQN, WS_CKVN, WS_CKV, 768, 512, WS_RSP, WS_RSPA, EPI_RED_OFF, EPI_RS_OFF> EpiA8; const EpiA8 E{w, ldsp};
                           gemm_site<EpiA8, true, true>(ldsp, wv, w + WS_X8, w + WS_WA + (size_t)j * SZ_A, M, 1792, DM / 2, E, 0x79797979); }
                else { unsigned char* const wb = w + WS_WB + (size_t)j * SZ_BIN;
                    typedef pg8::EpiKNR8<128, WS_QB, TOKW, WS_COSB, WS_SINB, SEQ, WS_RSP, WSL_OFF, WSL_OFF + 8192> EpiBQ; typedef pg8::EpiKNR8<128, WS_KB, B_KW, WS_COSB, WS_SINB, SEQ, WS_RSP, WSL_OFF, WSL_OFF + 8192> EpiBK; typedef pg8::EpiVT8<B_KVH * 128, SEQ, WS_VT8B, true, WS_RSP, EPI_RS_OFF> EpiBV;
                    { const EpiBQ E{w, (const float*)(w + WS_PAR) + PAR_BQ + j * 128, ldsp, att::Cfg<128>::SCALE * 1.4426950408889634f};
                      gemm_site<EpiBQ, true, true>(ldsp, wv, w + WS_X8, wb, M, 3072, DM / 2, E, 0x79797979); }
                    { const EpiBK E{w, (const float*)(w + WS_PAR) + PAR_BK + j * 128, ldsp, 1.0f};
                      gemm_site<EpiBK, true, true>(ldsp, wv, w + WS_X8, wb + (size_t)3072 * DM, M, B_KW, DM / 2, E, 0x79797979); }
                    { const EpiBV E{w, ldsp};
                      gemm_site<EpiBV, false, true, true>(ldsp, wv, wb + (size_t)3840 * DM, w + WS_X8, B_KW, M, DM / 2, E, 0x7f7f7f7f, 0x79797979); } }
            GRID_BAR(); }
            if (isA) {
#ifdef PROBE_ELT
                for (int rep_ = 0; rep_ < 2; ++rep_)
#endif
                {
                    const Frame F = make_frame(ldsp, wv); unsigned char* const w = WSP;
                    seg_norm<64, true, true, 24, true>(F, (const bf16*)(w + WS_CKV) + 512, 768, 0, 1, M, (bf16*)(w + WS_K192 + 128), A_KW, 192, (const float*)(w + WS_PAR) + PAR_KP + j * 64, (const float*)(w + WS_COSA), (const float*)(w + WS_SINA)); }
#ifdef PROBE_QKVB
                for (int rep_ = 0; rep_ < 2; ++rep_) {
#endif
                { unsigned char* const w = WSP; typedef pg8::EpiQA8<WS_QA, A_QBN, WS_COSA, WS_SINA, SEQ, WS_RSPA, WSL_OFF, WSL_OFF + 8192> EpiT;
                  const EpiT E{w, (const float*)(w + WS_PAR) + PAR_QN + j * 128, (const float*)(w + WS_PAR) + PAR_QP + j * 64, ldsp, att::Cfg<192>::SCALE * 1.4426950408889634f};
                  gemm_site<EpiT, false, true>(ldsp, wv, w + WS_CQN, w + WS_WA + (size_t)j * SZ_A + SZ_AIN, M, A_QBN, A_QL / 2, E, 0x7a7a7a7a); }
                { unsigned char* const w = WSP; typedef pg8::EpiKN8<192, true, 4, 2, 512> EpiT; const EpiT E{w + WS_K192, A_KW, (const float*)(w + WS_PAR) + PAR_KN + j * 128, (LAS float*)(ldsp + WSL_OFF), (const float*)(w + WS_RSPA), (LAS float*)(ldsp + WSL_OFF + 8192)};
                  gemm_site<EpiT, false, true>(ldsp, wv, w + WS_CKVN, w + WS_WA + (size_t)j * SZ_A + SZ_AIN + SZ_AQB, M, 3072, A_KVL / 2, E, 0x7b7b7b7b); }
                { unsigned char* const w = WSP; typedef pg8::EpiVT8<NH * 128, SEQ, WS_VT8A, true, WS_RSPA, EPI_RS_OFF, 4, 2, 512> EpiT; const EpiT E{w, ldsp};
                  gemm_site<EpiT, false, true>(ldsp, wv, w + WS_WA + (size_t)j * SZ_A + SZ_AIN + SZ_AQB + (size_t)3072 * A_KVL, w + WS_CKVN, NH * 128, M, A_KVL / 2, E, 0x7f7f7f7f, 0x7b7b7b7b); }
                GRID_BAR();
#ifdef PROBE_QKVB
                }
#endif
            }
            int ks = 0; const int kpos = opq_i((int)blockIdx.x) % 7;
            if (isA) {
                const Frame F0 = make_frame(ldsp, wv);
                for (int u = F0.vcu; u < BATCH * NH * (SEQ / 256); u += F0.G) {
                    const Frame F = make_frame(ldsp, wv); const int r32 = F.lane & 31, hi = F.lane >> 5;
                    unsigned char* const w = WSP;
                    const int bh = u >> 5, qb = u & 31, b = bh / NH, h = bh % NH;
                    const long row = (long)b * SEQ + qb * 256 + F.wave * 32 + r32;
                    const unsigned char* qrow = (const unsigned char*)(w + WS_QA) + row * A_QBN + h * 192 + 32 * hi;
                    att::v8i_t qr[3];
#pragma unroll
                    for (int s = 0; s < 3; ++s) { const v4u a = *(const GAS v4u*)(qrow + 64 * s), c = *(const GAS v4u*)(qrow + 64 * s + 16);
                        qr[s] = (att::v8i_t){(int)a.x, (int)a.y, (int)a.z, (int)a.w, (int)c.x, (int)c.y, (int)c.z, (int)c.w}; }
                    att::attn_unit<192, ATT_SD_A, ATT_RING_A>(qr, (const unsigned char*)(w + WS_K192) + (size_t)b * SEQ * A_KW + h * 192, A_KW, (const unsigned char*)(w + WS_VT8A) + (size_t)(b * NH + h) * 128 * SEQ, SEQ,
                                                  (unsigned char*)(w + WS_O) + ((size_t)b * SEQ + qb * 256) * DM + h * 128, DM, SEQ, (char*)lds + RING_OFF, wv);
                    if (ks == kpos) { for (int k2 = 0; k2 < 7; ++k2) conv_slot(ldsp, wv, args, WSP, opq_i(l), k2); } ++ks;
                }
            } else {
                const Frame F0 = make_frame(ldsp, wv);
                for (int u = F0.vcu; u < BATCH * NH * (SEQ / 256); u += F0.G) {
                    const Frame F = make_frame(ldsp, wv); const int r32 = F.lane & 31, hi = F.lane >> 5;
                    unsigned char* const w = WSP;
                    const int bh = u >> 5, qb = u & 31, b = bh / NH, h = bh % NH;
                    const long row = (long)b * SEQ + qb * 256 + F.wave * 32 + r32;
                    const unsigned char* qrow = (const unsigned char*)(w + WS_QB) + row * TOKW + h * 128 + 32 * hi;
                    att::v8i_t qr[2];
#pragma unroll
                    for (int s = 0; s < 2; ++s) { const v4u a = *(const GAS v4u*)(qrow + 64 * s), c = *(const GAS v4u*)(qrow + 64 * s + 16);
                        qr[s] = (att::v8i_t){(int)a.x, (int)a.y, (int)a.z, (int)a.w, (int)c.x, (int)c.y, (int)c.z, (int)c.w}; }
                    const int kvh = h >> 2;
                    att::attn_unit<128, ATT_SD_B, ATT_RING_B>(qr, (const unsigned char*)(w + WS_KB) + (size_t)b * SEQ * B_KW + kvh * 128, B_KW, (const unsigned char*)(w + WS_VT8B) + (size_t)(b * B_KVH + kvh) * 128 * SEQ, SEQ,
                                                  (unsigned char*)(w + WS_O) + ((size_t)b * SEQ + qb * 256) * DM + h * 128, DM, SEQ, (char*)lds + RING_OFF, wv);
                    if (ks == kpos) { for (int k2 = 0; k2 < 7; ++k2) conv_slot(ldsp, wv, args, WSP, opq_i(l), k2); } ++ks;
                }
            }
            __syncthreads();
#ifdef PROBE_MEM
            for (int rep_ = 0; rep_ < 2; ++rep_)
#endif
            {
                const Frame F0 = make_frame(ldsp, wv);
                for (int u = F0.vcu; u < BATCH * 4 * (SEQ / 256); u += F0.G) {
                    unsigned char* const w = WSP;
                    const int bm = u >> 5, qb = u & 31, b = bm >> 2, mh = bm & 3;
                    att::mem_attn_unit((const att::bf16_t*)(w + WS_QM) + ((size_t)b * SEQ + qb * 256) * MEMW + mh * 256, MEMW, (const float*)(w + WS_PAR) + PAR_MQ + l * MEMHD, EPS,
                                       (const att::bf16_t*)(w + WS_MK) + ((size_t)l * MEMR + b * 256) * 1024 + mh * 256, 1024, (const att::bf16_t*)(w + WS_MVT) + (size_t)((l * 2 + b) * 4 + mh) * 65536,
                                       (unsigned char*)(w + WS_O) + ((size_t)b * SEQ + qb * 256) * DM + TOKW + mh * 256, DM, (char*)lds + RING_OFF, (float*)((char*)lds + WSL_OFF), wv);
                    if (ks == kpos) { for (int k2 = 0; k2 < 7; ++k2) conv_slot(ldsp, wv, args, WSP, opq_i(l), k2); } ++ks;
                }
                if (ks <= kpos) { for (int k2 = 0; k2 < 7; ++k2) conv_slot(ldsp, wv, args, WSP, opq_i(l), k2); }
            }
            GRID_BAR();
            { unsigned char* const w = WSP; const pg8::EpiResidB E{(pg8::bf16_t*)(w + WS_XN), 1.0f, (float*)(w + WS_RSP), (LAS float*)(ldsp + EPI_RED_OFF), nullptr};
              gemm_site<pg8::EpiResidB, false, true>(ldsp, wv, w + WS_O, w + wl_off + OFF_WO, M, DM, DM / 2, E, 0x79797979, 0x79797979); }
            GRID_BAR();
        }
    }
#undef isA
#undef j
#undef GRID_BAR
#undef WSP
#undef OUTP
}

extern "C" void kernel_launch(void* const* d_in, const int* in_sizes, int n_in, void* d_out, int out_size, void* d_ws, size_t ws_size, hipStream_t stream) {
    static int grid = 0;
    if (grid == 0) {
        if (n_in != 26 || in_sizes[0] != M * DM || out_size != M * DM || ws_size < WS_END) { fprintf(stderr, "kernel_launch: unexpected shapes (n_in %d, in0 %d, out %d, ws %zu, need %zu); nothing launched\n", n_in, n_in > 0 ? in_sizes[0] : -1, out_size, ws_size, (size_t)WS_END); grid = -1; return; }
        int dev = 0, cus = 0, per_cu = 0;
        if (hipGetDevice(&dev) != hipSuccess || hipDeviceGetAttribute(&cus, hipDeviceAttributeMultiprocessorCount, dev) != hipSuccess) { grid = -1; return; }
        if (hipFuncSetAttribute((const void*)fwd_kernel, hipFuncAttributeMaxDynamicSharedMemorySize, LDS_BYTES) != hipSuccess) { fprintf(stderr, "kernel_launch: hipFuncSetAttribute failed\n"); grid = -1; return; }
        if (hipOccupancyMaxActiveBlocksPerMultiprocessor(&per_cu, (const void*)fwd_kernel, NWAVES * 64, LDS_BYTES) != hipSuccess || per_cu < 1) fprintf(stderr, "kernel_launch: occupancy query says %d\n", per_cu);
        (void)hipGetLastError();
        grid = cus;
    }
    if (grid < 0) return;
    if (hipMemsetAsync((char*)d_ws + WS_CTL, 0, CTL_ZERO_BYTES, stream) != hipSuccess) return;
    Args a{};
    for (int i = 0; i < 26; ++i) a.in[i] = (const float*)d_in[i];
    a.out = (float*)d_out; a.ws = (unsigned char*)d_ws;
    hipLaunchKernelGGL(fwd_kernel, dim3(grid), dim3(NWAVES * 64), LDS_BYTES, stream, a);
    const hipError_t le = hipPeekAtLastError();
    if (le != hipSuccess) fprintf(stderr, "kernel_launch: launch failed: %s\n", hipGetErrorName(le));
}
```

```cpp
#include <hip/hip_runtime.h>
#include <hip/hip_bf16.h>
#include <cstdio>
#include <cstdint>
namespace pg8 {
#define PG8_LAS __attribute__((address_space(3)))
typedef unsigned short bf16_t;
typedef short bf16x8 __attribute__((ext_vector_type(8)));
typedef float f32x4 __attribute__((ext_vector_type(4)));
typedef unsigned u32x4 __attribute__((ext_vector_type(4)));
typedef __bf16 bf16x2_t __attribute__((ext_vector_type(2)));
constexpr int BM = 256, BK = 64, HALF = 128, HTB = HALF * BK * 2  , STAGE_BYTES = 8 * HTB, NXCD = 8, WGM = 8;

__host__ __device__ __forceinline__ int lds_byte(int r, int c) { const int st = (r >> 4) * 2 + (c >> 5), rr = r & 15, cc = c & 31, ob = rr * 64 + cc * 2; return st * 1024 + (ob ^ (((ob >> 9) & 1) << 5)); }
__host__ __device__ __forceinline__ void stage_rc(int b, int& R, int& C) { const int st = b / 1024, sb = b % 1024, swz = sb ^ (((sb >> 9) & 1) << 5); R = (st >> 1) * 16 + swz / 64; C = (st & 1) * 32 + (swz % 64) / 2; }
__host__ __device__ __forceinline__ int perm32(int rho) { const int n = rho >> 4, i = rho & 15; return 8 * (i >> 2) + 4 * n + (i & 3); }

__device__ __forceinline__ int opq_lane() { int l; asm volatile("v_mbcnt_lo_u32_b32 %0, -1, 0\n\tv_mbcnt_hi_u32_b32 %0, -1, %0" : "=v"(l)); return l; }
typedef int v8i_t __attribute__((ext_vector_type(8)));
typedef int i32x4_t __attribute__((ext_vector_type(4)));
struct Unit { int pm, pn; };
struct Gemm { const bf16_t* A; const bf16_t* Bt; int M, N, K; };

struct StaticOrder {
    int nM, nN, nwg, G, c;
    __host__ __device__ void init(int M, int N, int G_, int c_) { nM = M / BM; nN = N / BM; nwg = nM * nN; G = G_; c = c_; }
    __host__ __device__ bool next(int i, Unit& u) const {
        const long L = (long)i * G + c; if (L >= nwg) return false;
        int wgid = (int)L; { const int q = nwg / NXCD, r = nwg % NXCD, xcd = wgid % NXCD, off = wgid / NXCD; wgid = (xcd < r ? xcd * (q + 1) : r * (q + 1) + (xcd - r) * q) + off; }
        const int nig = WGM * nN, gid = wgid / nig, fm = gid * WGM, gsz = (nM - fm) < WGM ? (nM - fm) : WGM;
        u.pm = fm + ((wgid % nig) % gsz); u.pn = (wgid % nig) / gsz; return true;
    }
    __device__ __forceinline__ void a_ready(const Unit&) const {}
    __device__ __forceinline__ void done(const Unit&) const {}
};

__device__ __forceinline__ unsigned cvt_pk_bf16(float lo, float hi) { unsigned r; asm volatile("v_cvt_pk_bf16_f32 %0, %1, %2" : "=v"(r) : "v"(lo), "v"(hi)); return r; }
typedef float f32x2 __attribute__((ext_vector_type(2)));
__device__ __forceinline__ void acc_zero(f32x4 (&acc)[2][2][4][2]) {
#pragma unroll
    for (int a = 0; a < 2; ++a)
#pragma unroll
        for (int b = 0; b < 2; ++b)
#pragma unroll
            for (int m = 0; m < 4; ++m)
#pragma unroll
                for (int n = 0; n < 2; ++n) acc[a][b][m][n] = (f32x4){0.f, 0.f, 0.f, 0.f};
}
__device__ __forceinline__ float epi_xor1(float v) { return v + __int_as_float(__builtin_amdgcn_ds_swizzle(__float_as_int(v), (1 << 10) | 0x1f)); }
__device__ __forceinline__ float epi_xor16(float v) { return v + __int_as_float(__builtin_amdgcn_ds_swizzle(__float_as_int(v), (16 << 10) | 0x1f)); }
__device__ __forceinline__ float epi_xor32(float v) { auto rr = __builtin_amdgcn_permlane32_swap(__float_as_uint(v), __float_as_uint(v), false, false); return __uint_as_float(rr[0]) + __uint_as_float(rr[1]); }
template <int P0, int NP, int CNT> __device__ __forceinline__ void rstd_init(const float* rsp, int row0, int wr, int wc, PG8_LAS float* rs_lds) {
    const int idx = (wr * 4 + wc) * 64 + opq_lane(), row = idx >> 1, half = idx & 1;
    __builtin_amdgcn_s_barrier();
    const float* p = rsp + ((size_t)(row0 + row) * 16 + P0 + half * (NP / 2)); float s;
    if constexpr (NP == 16) { const f32x4 a = *(const f32x4*)p, b = *(const f32x4*)(p + 4); s = ((a[0] + a[1]) + (a[2] + a[3])) + ((b[0] + b[1]) + (b[2] + b[3])); }
    else if constexpr (NP == 4) { s = p[0] + p[1]; }
    else { static_assert(NP == 2, "partials"); s = p[0]; }
    s = epi_xor1(s);
    rs_lds[row] = 1.0f / sqrtf(s * (1.0f / CNT) + 1e-6f);
}
struct EpiSwiGLU {
    static constexpr bool PERM = true, AFTER_DRAIN = false, LAUNDER = false;
    bf16_t* H; int ldh; const float* rsp; PG8_LAS float* rs_lds;
    __device__ __forceinline__ void init(f32x4 (&acc)[2][2][4][2], const Unit& u, int wr, int wc, int, int, int prev  ) const {
        acc_zero(acc);
        if (prev == u.pm) return;
        const int idx = (wr * 4 + wc) * 64 + opq_lane(), row = idx >> 1, half = idx & 1;
        __builtin_amdgcn_s_barrier();
        const f32x4* p = (const f32x4*)(rsp + ((size_t)(u.pm * BM + row) * 16 + half * 8));
        const f32x4 a = p[0], b = p[1];
        const float s = epi_xor1(((a[0] + a[1]) + (a[2] + a[3])) + ((b[0] + b[1]) + (b[2] + b[3])));
        rs_lds[row] = 1.0f / sqrtf(s * (1.0f / 4096.0f) + 1e-6f);
    }
    __device__ __forceinline__ void operator()(const f32x4 (&acc)[2][2][4][2], const Unit& u, int wr, int wc, int fr, int fq) const {
        float rs[2][4];
#pragma unroll
        for (int ai = 0; ai < 2; ++ai)
#pragma unroll
            for (int m = 0; m < 4; ++m) rs[ai][m] = rs_lds[ai * HALF + wr * 64 + m * 16 + fr];
#pragma unroll
        for (int ai = 0; ai < 2; ++ai)
#pragma unroll
            for (int m = 0; m < 4; ++m) { bf16_t* rowp = H + ((size_t)((u.pm * 16 + ai * 8 + wr * 4 + m) * (ldh >> 5) + (u.pn * 4 + wc)) * 16 + fr) * 32 + 8 * fq;
                const float r = rs[ai][m]; float h[8];
#pragma unroll
                for (int n = 0; n < 2; ++n)
#pragma unroll
                    for (int j = 0; j < 4; ++j) { const float g = acc[ai][0][m][n][j] * r, up = acc[ai][1][m][n][j] * r;
                        const float e = __builtin_amdgcn_exp2f(g * (-1.4426950408889634f)); h[n * 4 + j] = g * __builtin_amdgcn_rcpf(1.0f + e) * up; }
                u32x4 w; w.x = cvt_pk_bf16(h[0], h[1]); w.y = cvt_pk_bf16(h[2], h[3]); w.z = cvt_pk_bf16(h[4], h[5]); w.w = cvt_pk_bf16(h[6], h[7]);
                *(u32x4*)rowp = w; }
    }
};
__device__ __forceinline__ float bf_lo(unsigned w) { return __uint_as_float(w << 16); }
__device__ __forceinline__ float bf_hi(unsigned w) { return __uint_as_float(w & 0xffff0000u); }
struct EpiResidB {
    static constexpr bool PERM = true, AFTER_DRAIN = false, LAUNDER = false;
    bf16_t* xb; float alpha; float* rsp; PG8_LAS float* red; unsigned char* x8;
    __device__ __forceinline__ void init(f32x4 (&acc)[2][2][4][2], const Unit&, int, int, int, int, int) const { acc_zero(acc); }
    __device__ __forceinline__ void operator()(const f32x4 (&acc)[2][2][4][2], const Unit& u, int wr, int wc, int fr, int fq) const {
        bf16_t* p0 = xb + ((size_t)((u.pm * 16 + wr * 4) * 128 + (u.pn * 8 + wc)) * 16 + fr) * 32 + 8 * fq;
        float ss[2][4];
        u32x4 bs[2][4][2];
#pragma unroll
        for (int ai = 0; ai < 2; ++ai)
#pragma unroll
            for (int m = 0; m < 4; ++m)
#pragma unroll
                for (int bj = 0; bj < 2; ++bj) bs[ai][m][bj] = *(const u32x4*)(p0 + (size_t)((ai * 8 + m) * 128 + bj * 4) * 512);
#pragma unroll
        for (int ai = 0; ai < 2; ++ai)
#pragma unroll
            for (int m = 0; m < 4; ++m)
#pragma unroll
                for (int bj = 0; bj < 2; ++bj) { const u32x4 b = bs[ai][m][bj]; const f32x4 a0 = acc[ai][bj][m][0] * alpha, a1 = acc[ai][bj][m][1] * alpha;
                    u32x4 w; w.x = cvt_pk_bf16(bf_lo(b.x) + a0[0], bf_hi(b.x) + a0[1]); w.y = cvt_pk_bf16(bf_lo(b.y) + a0[2], bf_hi(b.y) + a0[3]);
                    w.z = cvt_pk_bf16(bf_lo(b.z) + a1[0], bf_hi(b.z) + a1[1]); w.w = cvt_pk_bf16(bf_lo(b.w) + a1[2], bf_hi(b.w) + a1[3]);
                    *(u32x4*)(p0 + (size_t)((ai * 8 + m) * 128 + bj * 4) * 512) = w;
                    float q = (bj == 0) ? 0.f : ss[ai][m]; float f[8];
#pragma unroll
                    for (int e = 0; e < 4; ++e) { f[2 * e] = bf_lo(w[e]); f[2 * e + 1] = bf_hi(w[e]); q += f[2 * e] * f[2 * e] + f[2 * e + 1] * f[2 * e + 1]; }
                    ss[ai][m] = q;
                    if (x8) { typedef unsigned v2u_t __attribute__((ext_vector_type(2))); v2u_t w8;
                        w8.x = (unsigned)__builtin_amdgcn_cvt_pk_fp8_f32(f[2], f[3], __builtin_amdgcn_cvt_pk_fp8_f32(f[0], f[1], 0, false), true);
                        w8.y = (unsigned)__builtin_amdgcn_cvt_pk_fp8_f32(f[6], f[7], __builtin_amdgcn_cvt_pk_fp8_f32(f[4], f[5], 0, false), true);
                        *(v2u_t*)(x8 + ((size_t)((u.pm * 16 + ai * 8 + wr * 4 + m) * 64 + u.pn * 4 + bj * 2 + (wc >> 1)) * 16 + fr) * 64 + (wc & 1) * 32 + 8 * fq) = w8; } }
#pragma unroll
        for (int ai = 0; ai < 2; ++ai) { float v = 0.f;
#pragma unroll
            for (int m = 0; m < 4; ++m) { const float t = epi_xor32(epi_xor16(ss[ai][m])); v = (fq == m) ? t : v; }
            red[wc * 256 + ai * HALF + wr * 64 + fq * 16 + fr] = v; }
        asm volatile("s_waitcnt lgkmcnt(0)" ::: "memory"); __builtin_amdgcn_s_barrier();
        if (wr * 4 + wc < 4) { const int row = (wr * 4 + wc) * 64 + fq * 16 + fr;
            rsp[(size_t)(u.pm * BM + row) * 16 + u.pn] = (red[row] + red[256 + row]) + (red[512 + row] + red[768 + row]); }
    }
};
struct EpiResidOut {
    static constexpr bool PERM = true, AFTER_DRAIN = false, LAUNDER = false;
    const bf16_t* xb; float* out; int ldc; float alpha;
    __device__ __forceinline__ void init(f32x4 (&acc)[2][2][4][2], const Unit&, int, int, int, int, int) const { acc_zero(acc); }
    __device__ __forceinline__ void operator()(const f32x4 (&acc)[2][2][4][2], const Unit& u, int wr, int wc, int fr, int fq) const {
        const bf16_t* p0 = xb + ((size_t)((u.pm * 16 + wr * 4) * 128 + (u.pn * 8 + wc)) * 16 + fr) * 32 + 8 * fq;
        float* o0 = out + (size_t)(u.pm * BM + wr * 64 + fr) * ldc + u.pn * BM + wc * 32 + 8 * fq;
#pragma unroll
        for (int ai = 0; ai < 2; ++ai)
#pragma unroll
            for (int m = 0; m < 4; ++m) {
#pragma unroll
                for (int bj = 0; bj < 2; ++bj) { const u32x4 b = *(const u32x4*)(p0 + (size_t)((ai * 8 + m) * 128 + bj * 4) * 512); const f32x4 a0 = acc[ai][bj][m][0] * alpha, a1 = acc[ai][bj][m][1] * alpha;
                    float* o = o0 + (size_t)(ai * HALF + m * 16) * ldc + bj * HALF;
                    *(f32x4*)o = (f32x4){bf_lo(b.x) + a0[0], bf_hi(b.x) + a0[1], bf_lo(b.y) + a0[2], bf_hi(b.y) + a0[3]};
                    *(f32x4*)(o + 4) = (f32x4){bf_lo(b.z) + a1[0], bf_hi(b.z) + a1[1], bf_lo(b.w) + a1[2], bf_hi(b.w) + a1[3]}; }
                if (m & 1) asm volatile("" ::: "memory"); }
    }
};
template <bool NORM, int T1, int T2, int T3, size_t O0, size_t O1, size_t O2, size_t O3, int L0, int L1, int L2, int L3, int P0 = 0, int NP = 16, int CNT = 4096> struct EpiBf16Seg {
    static constexpr bool PERM = true, AFTER_DRAIN = false, LAUNDER = (NP != 16);
    unsigned char* ws; const float* rsp; PG8_LAS float* rs_lds;
    __device__ __forceinline__ void init(f32x4 (&acc)[2][2][4][2], const Unit& u, int wr, int wc, int, int, int prev  ) const {
        acc_zero(acc);
        if constexpr (NORM) { if (prev != u.pm) rstd_init<P0, NP, CNT>(rsp, u.pm * BM, wr, wc, rs_lds); }
    }
    __device__ __forceinline__ void operator()(const f32x4 (&acc)[2][2][4][2], const Unit& u, int wr, int wc, int fr, int fq) const {
        const int pn = u.pn;
        const size_t off = pn >= T3 ? O3 : (pn >= T2 ? O2 : (pn >= T1 ? O1 : O0));
        const int ts = pn >= T3 ? T3 : (pn >= T2 ? T2 : (pn >= T1 ? T1 : 0)), ldc = pn >= T3 ? L3 : (pn >= T2 ? L2 : (pn >= T1 ? L1 : L0));
        bf16_t* base = (bf16_t*)(ws + off);
        const int row0 = u.pm * BM + wr * 64 + fr, col0 = (pn - ts) * BM + wc * 32 + 8 * fq;
        float rs[2][4];
#pragma unroll
        for (int ai = 0; ai < 2; ++ai)
#pragma unroll
            for (int m = 0; m < 4; ++m) rs[ai][m] = NORM ? rs_lds[ai * HALF + wr * 64 + m * 16 + fr] : 1.0f;
#pragma unroll
        for (int ai = 0; ai < 2; ++ai)
#pragma unroll
            for (int m = 0; m < 4; ++m) { bf16_t* rowp = base + (size_t)(row0 + ai * HALF + m * 16) * ldc + col0;
#pragma unroll
                for (int bj = 0; bj < 2; ++bj) { const f32x4 v0 = acc[ai][bj][m][0] * rs[ai][m], v1 = acc[ai][bj][m][1] * rs[ai][m];
                    u32x4 w; w.x = cvt_pk_bf16(v0[0], v0[1]); w.y = cvt_pk_bf16(v0[2], v0[3]); w.z = cvt_pk_bf16(v1[0], v1[1]); w.w = cvt_pk_bf16(v1[2], v1[3]);
                    *(u32x4*)(rowp + bj * HALF) = w; } }
    }
};
template <size_t O0, int L0> using EpiBf16One = EpiBf16Seg<false, (1 << 30), (1 << 30), (1 << 30), O0, 0, 0, 0, L0, 0, 0, 0>;
template <int NROWS, int SEQL, size_t OFF_VT, bool NORMC = false, size_t OFF_RSP = 0, int LDS_RS = 0, int P0 = 0, int NP = 16, int CNT = 4096> struct EpiVT8 {
    static constexpr bool PERM = true, AFTER_DRAIN = false, LAUNDER = true;
    unsigned char* ws; PG8_LAS unsigned char* lds;
    __device__ __forceinline__ void init(f32x4 (&acc)[2][2][4][2], const Unit& u, int wr, int wc, int, int, int prev  ) const {
        acc_zero(acc);
        if constexpr (NORMC) rstd_init<P0, NP, CNT>((const float*)(ws + OFF_RSP), u.pn * BM, wr, wc, (PG8_LAS float*)(lds + LDS_RS));
    }
    __device__ __forceinline__ void operator()(const f32x4 (&acc)[2][2][4][2], const Unit& u, int wr, int wc, int fr, int fq) const {
        const int key0 = u.pn * BM, b = key0 / SEQL, t0 = key0 - b * SEQL;
        unsigned char* const vt = ws + OFF_VT; PG8_LAS float* rs_lds = (PG8_LAS float*)(lds + LDS_RS);
        unsigned char* d0 = vt + ((size_t)b * NROWS + u.pm * BM + wr * 64 + fr) * SEQL + t0 + wc * 32 + 4 * fq;
        f32x4 cr[2][2];
#pragma unroll
        for (int bj = 0; bj < 2; ++bj)
#pragma unroll
            for (int n = 0; n < 2; ++n) cr[bj][n] = NORMC ? *(const PG8_LAS f32x4*)(rs_lds + bj * HALF + wc * 32 + 8 * fq + 4 * n) : (f32x4){1.f, 1.f, 1.f, 1.f};
#pragma unroll
        for (int ai = 0; ai < 2; ++ai)
#pragma unroll
            for (int m = 0; m < 4; ++m)
#pragma unroll
                for (int bj = 0; bj < 2; ++bj) { unsigned char* p = d0 + (size_t)(ai * HALF + m * 16) * SEQL + bj * HALF; const f32x4 v0 = acc[ai][bj][m][0] * cr[bj][0], v1 = acc[ai][bj][m][1] * cr[bj][1];
                    *(unsigned*)p = (unsigned)__builtin_amdgcn_cvt_pk_fp8_f32(v0[2], v0[3], __builtin_amdgcn_cvt_pk_fp8_f32(v0[0], v0[1], 0, false), true);
                    *(unsigned*)(p + 16) = (unsigned)__builtin_amdgcn_cvt_pk_fp8_f32(v1[2], v1[3], __builtin_amdgcn_cvt_pk_fp8_f32(v1[0], v1[1], 0, false), true); }
    }
};
template <int HSTRIDE, bool ROWN = false, int P0 = 0, int NP = 16, int CNT = 4096> struct EpiKN8 {
    static constexpr bool PERM = true, AFTER_DRAIN = false, LAUNDER = true;
    unsigned char* k8; int ldk; const float* gain; PG8_LAS float* red; const float* rsp; PG8_LAS float* rs_lds;
    __device__ __forceinline__ void init(f32x4 (&acc)[2][2][4][2], const Unit& u, int wr, int wc, int, int, int prev  ) const { acc_zero(acc); if constexpr (ROWN) { if (prev != u.pm) rstd_init<P0, NP, CNT>(rsp, u.pm * BM, wr, wc, rs_lds); } }
    __device__ __forceinline__ void operator()(const f32x4 (&acc)[2][2][4][2], const Unit& u, int wr, int wc, int fr, int fq) const {
        float rsx[2][4];
#pragma unroll
        for (int ai = 0; ai < 2; ++ai)
#pragma unroll
            for (int m = 0; m < 4; ++m) rsx[ai][m] = ROWN ? rs_lds[ai * HALF + wr * 64 + m * 16 + fr] : 1.0f;
#pragma unroll
        for (int ai = 0; ai < 2; ++ai)
#pragma unroll
            for (int bj = 0; bj < 2; ++bj) { float v = 0.f;
#pragma unroll
                for (int m = 0; m < 4; ++m) { const f32x4 a = acc[ai][bj][m][0], b = acc[ai][bj][m][1];
                    const float t = epi_xor32(epi_xor16(((a[0] * a[0] + a[1] * a[1]) + (a[2] * a[2] + a[3] * a[3]) + ((b[0] * b[0] + b[1] * b[1]) + (b[2] * b[2] + b[3] * b[3]))) * (rsx[ai][m] * rsx[ai][m]))); v = (fq == m) ? t : v; }
                red[((bj * 256 + ai * HALF + wr * 64 + fq * 16 + fr) << 2) + wc] = v; }
        asm volatile("s_waitcnt lgkmcnt(0)" ::: "memory"); __builtin_amdgcn_s_barrier();
        const f32x4 g0 = *(const f32x4*)(gain + wc * 32 + 8 * fq), g1 = *(const f32x4*)(gain + wc * 32 + 8 * fq + 4);
        unsigned char* d0 = k8 + (size_t)(u.pm * BM + wr * 64 + fr) * ldk + (u.pn * 2) * HSTRIDE + wc * 32 + 8 * fq;
        typedef unsigned v2u_t __attribute__((ext_vector_type(2)));
#pragma unroll
        for (int ai = 0; ai < 2; ++ai)
#pragma unroll
            for (int m = 0; m < 4; ++m)
#pragma unroll
                for (int bj = 0; bj < 2; ++bj) { const f32x4 s4 = *(const PG8_LAS f32x4*)(red + ((bj * 256 + ai * HALF + wr * 64 + m * 16 + fr) << 2));
                    const float rs = rsx[ai][m] * __builtin_amdgcn_rsqf(((s4[0] + s4[1]) + (s4[2] + s4[3])) * (1.0f / 128.0f) + 1e-6f);
                    const f32x4 a = acc[ai][bj][m][0] * rs * g0, b = acc[ai][bj][m][1] * rs * g1; v2u_t w8;
                    w8.x = (unsigned)__builtin_amdgcn_cvt_pk_fp8_f32(a[2], a[3], __builtin_amdgcn_cvt_pk_fp8_f32(a[0], a[1], 0, false), true);
                    w8.y = (unsigned)__builtin_amdgcn_cvt_pk_fp8_f32(b[2], b[3], __builtin_amdgcn_cvt_pk_fp8_f32(b[0], b[1], 0, false), true);
                    *(v2u_t*)(d0 + (size_t)(ai * HALF + m * 16) * ldk + bj * HSTRIDE) = w8; }
    }
};
template <int HSTRIDE, size_t OFF_K8, int ldk, size_t OFF_CS, size_t OFF_SN, int seq, size_t OFF_RSP, int LDS_RED, int LDS_RS> struct EpiKNR8 {
    static constexpr bool PERM = true, AFTER_DRAIN = false, LAUNDER = true;
    unsigned char* ws; const float* gain; PG8_LAS unsigned char* lds; float osc;
    __device__ __forceinline__ void init(f32x4 (&acc)[2][2][4][2], const Unit& u, int wr, int wc, int, int, int prev  ) const {
        acc_zero(acc);
        if (prev == u.pm) return;
        const int idx = (wr * 4 + wc) * 64 + opq_lane(), row = idx >> 1, half = idx & 1;
        __builtin_amdgcn_s_barrier();
        const float* rsp = (const float*)(ws + OFF_RSP); PG8_LAS float* rs_lds = (PG8_LAS float*)(lds + LDS_RS);
        const f32x4* p = (const f32x4*)(rsp + ((size_t)(u.pm * BM + row) * 16 + half * 8));
        const f32x4 a = p[0], b = p[1];
        const float s = epi_xor1(((a[0] + a[1]) + (a[2] + a[3])) + ((b[0] + b[1]) + (b[2] + b[3])));
        rs_lds[row] = 1.0f / sqrtf(s * (1.0f / 4096.0f) + 1e-6f);
    }
    __device__ __forceinline__ void operator()(const f32x4 (&acc)[2][2][4][2], const Unit& u, int wr, int wc, int fr, int fq) const {
        unsigned char* const k8 = ws + OFF_K8; const float* const cs = (const float*)(ws + OFF_CS); const float* const sn = (const float*)(ws + OFF_SN);
        PG8_LAS float* red = (PG8_LAS float*)(lds + LDS_RED); PG8_LAS float* rs_lds = (PG8_LAS float*)(lds + LDS_RS);
        float rsx[2][4];
#pragma unroll
        for (int ai = 0; ai < 2; ++ai)
#pragma unroll
            for (int m = 0; m < 4; ++m) rsx[ai][m] = rs_lds[ai * HALF + wr * 64 + m * 16 + fr];
#pragma unroll
        for (int ai = 0; ai < 2; ++ai)
#pragma unroll
            for (int bj = 0; bj < 2; ++bj) { float v = 0.f;
#pragma unroll
                for (int m = 0; m < 4; ++m) { const f32x4 a = acc[ai][bj][m][0], b = acc[ai][bj][m][1];
                    const float t = epi_xor32(epi_xor16(((a[0] * a[0] + a[1] * a[1]) + (a[2] * a[2] + a[3] * a[3]) + ((b[0] * b[0] + b[1] * b[1]) + (b[2] * b[2] + b[3] * b[3]))) * (rsx[ai][m] * rsx[ai][m]))); v = (fq == m) ? t : v; }
                red[((bj * 256 + ai * HALF + wr * 64 + fq * 16 + fr) << 2) + wc] = v; }
        asm volatile("s_waitcnt lgkmcnt(0)" ::: "memory"); __builtin_amdgcn_s_barrier();
        const f32x4 g0 = *(const f32x4*)(gain + wc * 32 + 8 * fq), g1 = *(const f32x4*)(gain + wc * 32 + 8 * fq + 4);
        const int row0 = u.pm * BM + wr * 64 + fr;
        unsigned char* d0 = k8 + (size_t)row0 * ldk + (u.pn * 2) * HSTRIDE + wc * 32 + 8 * fq;
        typedef unsigned v2u_t __attribute__((ext_vector_type(2)));
#pragma unroll
        for (int ai = 0; ai < 2; ++ai)
#pragma unroll
            for (int m = 0; m < 4; ++m) { const int pos = (row0 + ai * HALF + m * 16) % seq;
                const f32x4 cv = *(const f32x4*)(cs + (size_t)pos * 64 + wc * 16 + 4 * fq), sv = *(const f32x4*)(sn + (size_t)pos * 64 + wc * 16 + 4 * fq);
#pragma unroll
                for (int bj = 0; bj < 2; ++bj) { const f32x4 s4 = *(const PG8_LAS f32x4*)(red + ((bj * 256 + ai * HALF + wr * 64 + m * 16 + fr) << 2));
                    const float rs = rsx[ai][m] * osc * __builtin_amdgcn_rsqf(((s4[0] + s4[1]) + (s4[2] + s4[3])) * (1.0f / 128.0f) + 1e-6f);
                    const f32x4 a = acc[ai][bj][m][0] * rs * g0, b = acc[ai][bj][m][1] * rs * g1;
                    const float x0 = a[0] * cv[0] - a[1] * sv[0], x1 = a[0] * sv[0] + a[1] * cv[0], x2 = a[2] * cv[1] - a[3] * sv[1], x3 = a[2] * sv[1] + a[3] * cv[1];
                    const float x4 = b[0] * cv[2] - b[1] * sv[2], x5 = b[0] * sv[2] + b[1] * cv[2], x6 = b[2] * cv[3] - b[3] * sv[3], x7 = b[2] * sv[3] + b[3] * cv[3];
                    v2u_t w8;
                    w8.x = (unsigned)__builtin_amdgcn_cvt_pk_fp8_f32(x2, x3, __builtin_amdgcn_cvt_pk_fp8_f32(x0, x1, 0, false), true);
                    w8.y = (unsigned)__builtin_amdgcn_cvt_pk_fp8_f32(x6, x7, __builtin_amdgcn_cvt_pk_fp8_f32(x4, x5, 0, false), true);
                    *(v2u_t*)(d0 + (size_t)(ai * HALF + m * 16) * ldk + bj * HSTRIDE) = w8; } }
    }
};
template <size_t OFF_CQ8, size_t OFF_CKV8, size_t OFF_KPE, int LDKPE, int KPE0, size_t OFF_RSPX, size_t OFF_RSPA, int LDS_RED, int LDS_RS> struct EpiA8 {
    static constexpr bool PERM = true, AFTER_DRAIN = false, LAUNDER = true;
    unsigned char* ws; PG8_LAS unsigned char* lds;
    __device__ __forceinline__ void init(f32x4 (&acc)[2][2][4][2], const Unit& u, int wr, int wc, int, int, int prev  ) const { acc_zero(acc); if (prev != u.pm) rstd_init<0, 16, 4096>((const float*)(ws + OFF_RSPX), u.pm * BM, wr, wc, (PG8_LAS float*)(lds + LDS_RS)); }
    __device__ __forceinline__ void operator()(const f32x4 (&acc)[2][2][4][2], const Unit& u, int wr, int wc, int fr, int fq) const {
        PG8_LAS float* rs_lds = (PG8_LAS float*)(lds + LDS_RS); PG8_LAS float* red = (PG8_LAS float*)(lds + LDS_RED);
        const int pn = u.pn, row0 = u.pm * BM + wr * 64 + fr;
        float rs[2][4];
#pragma unroll
        for (int ai = 0; ai < 2; ++ai)
#pragma unroll
            for (int m = 0; m < 4; ++m) rs[ai][m] = rs_lds[ai * HALF + wr * 64 + m * 16 + fr];
        if (pn >= 6) {
            bf16_t* base = (bf16_t*)(ws + OFF_KPE) + KPE0 + wc * 32 + 8 * fq;
#pragma unroll
            for (int ai = 0; ai < 2; ++ai)
#pragma unroll
                for (int m = 0; m < 4; ++m) { bf16_t* rowp = base + (size_t)(row0 + ai * HALF + m * 16) * LDKPE;
#pragma unroll
                    for (int bj = 0; bj < 2; ++bj) { const f32x4 v0 = acc[ai][bj][m][0] * rs[ai][m], v1 = acc[ai][bj][m][1] * rs[ai][m];
                        u32x4 w; w.x = cvt_pk_bf16(v0[0], v0[1]); w.y = cvt_pk_bf16(v0[2], v0[3]); w.z = cvt_pk_bf16(v1[0], v1[1]); w.w = cvt_pk_bf16(v1[2], v1[3]);
                        *(u32x4*)(rowp + bj * HALF) = w; } }
            return; }
        unsigned char* d0 = (pn < 4 ? ws + OFF_CQ8 + (size_t)row0 * 1024 + pn * BM : ws + OFF_CKV8 + (size_t)row0 * 512 + (pn - 4) * BM) + wc * 32 + 8 * fq;
        const int ldo = pn < 4 ? 1024 : 512;
        typedef unsigned v2u_t __attribute__((ext_vector_type(2)));
        float ss[2][4];
#pragma unroll
        for (int ai = 0; ai < 2; ++ai)
#pragma unroll
            for (int m = 0; m < 4; ++m) { float q = 0.f;
#pragma unroll
                for (int bj = 0; bj < 2; ++bj) { const f32x4 a = acc[ai][bj][m][0] * rs[ai][m], b = acc[ai][bj][m][1] * rs[ai][m]; v2u_t w8;
                    q += ((a[0] * a[0] + a[1] * a[1]) + (a[2] * a[2] + a[3] * a[3])) + ((b[0] * b[0] + b[1] * b[1]) + (b[2] * b[2] + b[3] * b[3]));
                    w8.x = (unsigned)__builtin_amdgcn_cvt_pk_fp8_f32(a[2], a[3], __builtin_amdgcn_cvt_pk_fp8_f32(a[0], a[1], 0, false), true);
                    w8.y = (unsigned)__builtin_amdgcn_cvt_pk_fp8_f32(b[2], b[3], __builtin_amdgcn_cvt_pk_fp8_f32(b[0], b[1], 0, false), true);
                    *(v2u_t*)(d0 + (size_t)(ai * HALF + m * 16) * ldo + bj * HALF) = w8; }
                ss[ai][m] = q; }
#pragma unroll
        for (int ai = 0; ai < 2; ++ai) { float v = 0.f;
#pragma unroll
            for (int m = 0; m < 4; ++m) { const float t = epi_xor32(epi_xor16(ss[ai][m])); v = (fq == m) ? t : v; }
            red[wc * 256 + ai * HALF + wr * 64 + fq * 16 + fr] = v; }
        asm volatile("s_waitcnt lgkmcnt(0)" ::: "memory"); __builtin_amdgcn_s_barrier();
        if (wr * 4 + wc < 4) { const int row = (wr * 4 + wc) * 64 + fq * 16 + fr;
            ((float*)(ws + OFF_RSPA))[(size_t)(u.pm * BM + row) * 16 + pn] = (red[row] + red[256 + row]) + (red[512 + row] + red[768 + row]); }
    }
};
template <size_t OFF_Q8, int LDQ, size_t OFF_CS, size_t OFF_SN, int seq, size_t OFF_RSPA, int LDS_RED, int LDS_RS> struct EpiQA8 {
    static constexpr bool PERM = true, AFTER_DRAIN = false, LAUNDER = true;
    unsigned char* ws; const float* gn; const float* gp; PG8_LAS unsigned char* lds; float osc;
    __device__ __forceinline__ void init(f32x4 (&acc)[2][2][4][2], const Unit& u, int wr, int wc, int, int, int prev  ) const { acc_zero(acc); if (prev != u.pm) rstd_init<0, 4, 1024>((const float*)(ws + OFF_RSPA), u.pm * BM, wr, wc, (PG8_LAS float*)(lds + LDS_RS)); }
    __device__ __forceinline__ void operator()(const f32x4 (&acc)[2][2][4][2], const Unit& u, int wr, int wc, int fr, int fq) const {
        PG8_LAS float* red = (PG8_LAS float*)(lds + LDS_RED); PG8_LAS float* rs_lds = (PG8_LAS float*)(lds + LDS_RS);
        const bool pe = u.pn >= 12;
        float rsx[2][4];
#pragma unroll
        for (int ai = 0; ai < 2; ++ai)
#pragma unroll
            for (int m = 0; m < 4; ++m) rsx[ai][m] = rs_lds[ai * HALF + wr * 64 + m * 16 + fr];
#pragma unroll
        for (int ai = 0; ai < 2; ++ai)
#pragma unroll
            for (int bj = 0; bj < 2; ++bj) { float v = 0.f;
#pragma unroll
                for (int m = 0; m < 4; ++m) { const f32x4 a = acc[ai][bj][m][0], b = acc[ai][bj][m][1];
                    const float t = epi_xor32(epi_xor16(((a[0] * a[0] + a[1] * a[1]) + (a[2] * a[2] + a[3] * a[3]) + ((b[0] * b[0] + b[1] * b[1]) + (b[2] * b[2] + b[3] * b[3]))) * (rsx[ai][m] * rsx[ai][m]))); v = (fq == m) ? t : v; }
                red[((bj * 256 + ai * HALF + wr * 64 + fq * 16 + fr) << 2) + wc] = v; }
        asm volatile("s_waitcnt lgkmcnt(0)" ::: "memory"); __builtin_amdgcn_s_barrier();
        const int row0 = u.pm * BM + wr * 64 + fr;
        const int d0i = pe ? (wc & 1) * 32 + 8 * fq : wc * 32 + 8 * fq;
        const float* gv = pe ? gp + d0i : gn + d0i;
        const f32x4 g0 = *(const f32x4*)gv, g1 = *(const f32x4*)(gv + 4);
        unsigned char* d0 = ws + OFF_Q8 + (size_t)row0 * LDQ + (pe ? (4 * (u.pn - 12) + (wc >> 1)) * 192 + 128 : (2 * u.pn) * 192) + d0i;
        const int hstep = pe ? 2 * 192 : 192;
        const float inv_n = pe ? (1.0f / 64.0f) : (1.0f / 128.0f);
        typedef unsigned v2u_t __attribute__((ext_vector_type(2)));
#pragma unroll
        for (int ai = 0; ai < 2; ++ai)
#pragma unroll
            for (int m = 0; m < 4; ++m) { f32x4 cv = {1.f, 1.f, 1.f, 1.f}, sv = {0.f, 0.f, 0.f, 0.f};
                if (pe) { const int pos = (row0 + ai * HALF + m * 16) % seq; cv = *(const f32x4*)((const float*)(ws + OFF_CS) + (size_t)pos * 32 + (d0i >> 1)); sv = *(const f32x4*)((const float*)(ws + OFF_SN) + (size_t)pos * 32 + (d0i >> 1)); }
#pragma unroll
                for (int bj = 0; bj < 2; ++bj) { const f32x4 s4 = *(const PG8_LAS f32x4*)(red + ((bj * 256 + ai * HALF + wr * 64 + m * 16 + fr) << 2));
                    const float ssum = pe ? ((wc & 2) ? s4[2] + s4[3] : s4[0] + s4[1]) : (s4[0] + s4[1]) + (s4[2] + s4[3]);
                    const float rs = rsx[ai][m] * osc * __builtin_amdgcn_rsqf(ssum * inv_n + 1e-6f);
                    const f32x4 a = acc[ai][bj][m][0] * rs * g0, b = acc[ai][bj][m][1] * rs * g1;
                    const float x0 = a[0] * cv[0] - a[1] * sv[0], x1 = a[0] * sv[0] + a[1] * cv[0], x2 = a[2] * cv[1] - a[3] * sv[1], x3 = a[2] * sv[1] + a[3] * cv[1];
                    const float x4 = b[0] * cv[2] - b[1] * sv[2], x5 = b[0] * sv[2] + b[1] * cv[2], x6 = b[2] * cv[3] - b[3] * sv[3], x7 = b[2] * sv[3] + b[3] * cv[3];
                    v2u_t w8;
                    w8.x = (unsigned)__builtin_amdgcn_cvt_pk_fp8_f32(x2, x3, __builtin_amdgcn_cvt_pk_fp8_f32(x0, x1, 0, false), true);
                    w8.y = (unsigned)__builtin_amdgcn_cvt_pk_fp8_f32(x6, x7, __builtin_amdgcn_cvt_pk_fp8_f32(x4, x5, 0, false), true);
                    *(v2u_t*)(d0 + (size_t)(ai * HALF + m * 16) * LDQ + bj * hstep) = w8; } }
    }
};

template <class Epi, class Sched, bool ALIGN_EPI = false, bool SP2 = false, bool ABLK = false, bool FP8 = false, bool BBLK = false  >
__device__ __forceinline__ void gemm_phase(PG8_LAS unsigned char* lds, const Gemm g, const Sched& S, const Epi& E, const int wv  , const int sc_w = 0x7f7f7f7f  , const int sc_a = 0x7f7f7f7f  ) {
    int wid = wv; asm volatile("" : "+s"(wid));
    const int lane = opq_lane(), tid = wid * 64 + lane, wr = wid >> 2, wc = wid & 3, fr = lane & 15, fq = lane >> 4;
    const int K = g.K, nt = K / BK;
    unsigned voffA[2], voffB[2];
#pragma unroll
    for (int i = 0; i < 2; ++i) { int R, C; stage_rc(tid * 16 + i * 8192, R, C); const int Rb = Epi::PERM ? ((R & ~31) + perm32(R & 31)) : R;
        voffA[i] = ABLK ? (unsigned)((((R >> 4) * (K >> 5) + (C >> 5)) * 16 + (R & 15)) * 32 + (C & 31)) * 2u : (unsigned)(R * K + C) * 2u; voffB[i] = BBLK ? (unsigned)((((Rb >> 4) * (K >> 5) + (C >> 5)) * 16 + (Rb & 15)) * 32 + (C & 31)) * 2u : (unsigned)(Rb * K + C) * 2u; }
    const size_t kstep = BBLK ? (size_t)2048 : (size_t)(BK * 2);
    const size_t hstep = BBLK ? (size_t)8 * (K >> 5) * 1024 : (size_t)HALF * K * 2;
    const size_t tstep = 2 * hstep;
    const size_t kstepA = ABLK ? (size_t)2048 : (size_t)(BK * 2), hstepA = ABLK ? (size_t)8 * (K >> 5) * 1024 : (size_t)HALF * K * 2, tstepA = 2 * hstepA;
    const unsigned ldsw = (unsigned)wid * 1024u;
    const int aoff = lds_byte(wr * 64 + fr, fq * 8), boff = lds_byte(wc * 32 + fr, fq * 8);
#define PG8_SA(b, h) (((b) * 2 + (h)) * HTB)
#define PG8_SB(b, h) ((4 + (b) * 2 + (h)) * HTB)
#define PG8_STAGE(bufoff, gbase, voff) do { _Pragma("unroll") for (int _i = 0; _i < 2; ++_i) { unsigned vo_ = (voff)[_i]; if constexpr (BBLK || Epi::LAUNDER) asm volatile("" : "+v"(vo_));   \
        __builtin_amdgcn_global_load_lds((const unsigned*)((const char*)(gbase) + vo_), (PG8_LAS unsigned*)(lds + (bufoff) + ldsw + _i * 8192), 16, 0, 0); } } while (0)
#define PG8_LD16A(off) (*(const PG8_LAS i32x4_t*)(abase8 + (off)))
#define PG8_LD16B(off) (*(const PG8_LAS i32x4_t*)(bbase8 + (off)))
#define PG8_LDA(dst, b, h) do { _Pragma("unroll") for (int m = 0; m < 4; ++m) { if constexpr (FP8) dst##8[m] = __builtin_shufflevector(PG8_LD16A(PG8_SA(b, h) + m * 2048), PG8_LD16A(PG8_SA(b, h) + m * 2048 + 1024), 0, 1, 2, 3, 4, 5, 6, 7); \
        else { _Pragma("unroll") for (int k = 0; k < 2; ++k) dst[m][k] = *(const PG8_LAS bf16x8*)(lds + PG8_SA(b, h) + aoff + m * 2048 + k * 1024); } } } while (0)
#define PG8_LDB(dst, b, h) do { _Pragma("unroll") for (int n = 0; n < 2; ++n) { if constexpr (FP8) dst##8[n] = __builtin_shufflevector(PG8_LD16B(PG8_SB(b, h) - 4 * HTB + n * 2048), PG8_LD16B(PG8_SB(b, h) - 4 * HTB + n * 2048 + 1024), 0, 1, 2, 3, 4, 5, 6, 7); \
        else { _Pragma("unroll") for (int k = 0; k < 2; ++k) dst[n][k] = *(const PG8_LAS bf16x8*)(lds + PG8_SB(b, h) + boff + n * 2048 + k * 1024); } } } while (0)
#define PG8_MMA(ai, bj, At, Bt) do { if constexpr (FP8) PG8_SCHED;   __builtin_amdgcn_s_setprio(1); _Pragma("unroll") for (int m = 0; m < 4; ++m) _Pragma("unroll") for (int n = 0; n < 2; ++n) { \
        if constexpr (FP8) acc[ai][bj][m][n] = __builtin_amdgcn_mfma_scale_f32_16x16x128_f8f6f4(Bt##8[n], At##8[m], acc[ai][bj][m][n], 0, 0, 0, sc_w, 0, sc_a); \
        else { _Pragma("unroll") for (int k = 0; k < 2; ++k) acc[ai][bj][m][n] = __builtin_amdgcn_mfma_f32_16x16x32_bf16(Bt[n][k], At[m][k], acc[ai][bj][m][n], 0, 0, 0); } } \
        __builtin_amdgcn_s_setprio(0); if constexpr (FP8) { _Pragma("unroll") for (int m = 0; m < 4; ++m) _Pragma("unroll") for (int n = 0; n < 2; ++n) asm volatile("" : "+v"(acc[ai][bj][m][n]));   PG8_SCHED; } } while (0)
#define PG8_WAIT_V(n) asm volatile("s_waitcnt vmcnt(" #n ")" ::: "memory")
#define PG8_WAIT_L(n) asm volatile("s_waitcnt lgkmcnt(" #n ")" ::: "memory")
#define PG8_BAR __builtin_amdgcn_s_barrier()
#define PG8_SCHED __builtin_amdgcn_sched_barrier(0)
    Unit cur, nxt; int ui = 0;
    if (!S.next(0, cur)) return;
    f32x4 acc[2][2][4][2];
    E.init(acc, cur, wr, wc, fr, fq, -1);
    bf16x8 At[4][2], B0[2][2], B1[2][2];
    v8i_t At8[4], B08[2], B18[2];
    PG8_LAS unsigned char* abase8 = lds + aoff; PG8_LAS unsigned char* bbase8 = lds + 4 * HTB + boff;
    if constexpr (FP8) { asm volatile("" : "+v"(abase8)); asm volatile("" : "+v"(bbase8)); }
    const char* cA = (const char*)g.A + (size_t)cur.pm * tstepA; const char* cB = (const char*)g.Bt + (size_t)cur.pn * tstep;
    S.a_ready(cur);
    if constexpr (SP2) {
        PG8_STAGE(PG8_SB(0, 0), cB, voffB); PG8_STAGE(PG8_SB(0, 1), cB + hstep, voffB); PG8_STAGE(PG8_SA(0, 0), cA, voffA); PG8_STAGE(PG8_SA(0, 1), cA + hstepA, voffA);
        if (wr == 1) PG8_BAR;
        PG8_WAIT_V(2); PG8_BAR;
        PG8_STAGE(PG8_SB(1, 0), cB + kstep, voffB); PG8_STAGE(PG8_SA(1, 0), cA + kstepA, voffA); PG8_STAGE(PG8_SB(1, 1), cB + hstep + kstep, voffB);
        PG8_WAIT_V(6); PG8_BAR;
    } else {
        PG8_STAGE(PG8_SB(0, 0), cB, voffB); PG8_STAGE(PG8_SA(0, 0), cA, voffA); PG8_STAGE(PG8_SB(0, 1), cB + hstep, voffB); PG8_STAGE(PG8_SA(0, 1), cA + hstepA, voffA);
        if (wr == 1) PG8_BAR;
        PG8_WAIT_V(4); PG8_BAR;
        PG8_STAGE(PG8_SB(1, 0), cB + kstep, voffB); PG8_STAGE(PG8_SA(1, 0), cA + kstepA, voffA); PG8_STAGE(PG8_SB(1, 1), cB + hstep + kstep, voffB);
        PG8_WAIT_V(6); PG8_BAR;
    }
    for (;;) {
        const bool has_next = S.next(ui + 1, nxt);
        const char* nA = has_next ? (const char*)g.A + (size_t)nxt.pm * tstepA : cA; const char* nB = has_next ? (const char*)g.Bt + (size_t)nxt.pn * tstep : cB;
        for (int t = 0; t < nt; t += 2) {
            const bool last = (t == nt - 2);
            const char* a1 = cA + (size_t)(t + 1) * kstepA;
            const char* a2 = last ? nA : cA + (size_t)(t + 2) * kstepA; const char* b2 = last ? nB : cB + (size_t)(t + 2) * kstep;
            const char* a3 = a2 + kstepA; const char* b3 = b2 + kstep;
            if (last && has_next) S.a_ready(nxt);
            if constexpr (SP2) {
            PG8_LDB(B0, 0, 0); PG8_LDB(B1, 0, 1); PG8_SCHED; PG8_LDA(At, 0, 0); PG8_STAGE(PG8_SA(1, 1), a1 + hstepA, voffA);
            PG8_WAIT_V(8); PG8_WAIT_L(0); PG8_BAR; PG8_MMA(0, 0, At, B0); PG8_MMA(0, 1, At, B1); PG8_BAR; PG8_SCHED;
            PG8_LDA(At, 0, 1); PG8_STAGE(PG8_SB(0, 0), b2, voffB); PG8_STAGE(PG8_SB(0, 1), b2 + hstep, voffB); PG8_STAGE(PG8_SA(0, 0), a2, voffA);
            PG8_WAIT_V(8); PG8_WAIT_L(0); PG8_BAR; PG8_MMA(1, 0, At, B0); PG8_MMA(1, 1, At, B1); PG8_BAR; PG8_SCHED;
            PG8_LDB(B0, 1, 0); PG8_LDB(B1, 1, 1); PG8_SCHED; PG8_LDA(At, 1, 0); PG8_STAGE(PG8_SA(0, 1), a2 + hstepA, voffA);
            PG8_WAIT_V(8); PG8_WAIT_L(0); PG8_BAR; PG8_MMA(0, 0, At, B0); PG8_MMA(0, 1, At, B1); PG8_BAR; PG8_SCHED;
            PG8_LDA(At, 1, 1); PG8_STAGE(PG8_SB(1, 0), b3, voffB); PG8_STAGE(PG8_SB(1, 1), b3 + hstep, voffB); PG8_STAGE(PG8_SA(1, 0), a3, voffA);
            PG8_WAIT_V(8); PG8_WAIT_L(0); PG8_BAR; PG8_MMA(1, 0, At, B0); PG8_MMA(1, 1, At, B1); PG8_BAR; PG8_SCHED;
            } else {
            PG8_LDB(B0, 0, 0); PG8_SCHED; PG8_LDA(At, 0, 0); PG8_STAGE(PG8_SA(1, 1), a1 + hstepA, voffA);
            PG8_WAIT_L(8); PG8_BAR; PG8_WAIT_L(0); PG8_MMA(0, 0, At, B0); PG8_BAR; PG8_SCHED;
            PG8_LDB(B1, 0, 1); PG8_STAGE(PG8_SB(0, 0), b2, voffB);
            PG8_BAR; PG8_WAIT_L(0); PG8_MMA(0, 1, At, B1); PG8_BAR;
            PG8_LDA(At, 0, 1); PG8_STAGE(PG8_SA(0, 0), a2, voffA);
            PG8_BAR; PG8_WAIT_L(0); PG8_MMA(1, 0, At, B0); PG8_BAR; PG8_SCHED;
            PG8_STAGE(PG8_SB(0, 1), b2 + hstep, voffB);
            PG8_WAIT_V(6); PG8_BAR; PG8_MMA(1, 1, At, B1); PG8_BAR;
            PG8_LDB(B0, 1, 0); PG8_SCHED; PG8_LDA(At, 1, 0); PG8_STAGE(PG8_SA(0, 1), a2 + hstepA, voffA);
            PG8_WAIT_L(8); PG8_BAR; PG8_WAIT_L(0); PG8_MMA(0, 0, At, B0); PG8_BAR; PG8_SCHED;
            PG8_LDB(B1, 1, 1); PG8_STAGE(PG8_SB(1, 0), b3, voffB);
            PG8_BAR; PG8_WAIT_L(0); PG8_MMA(0, 1, At, B1); PG8_BAR;
            PG8_LDA(At, 1, 1); PG8_STAGE(PG8_SA(1, 0), a3, voffA);
            PG8_BAR; PG8_WAIT_L(0); PG8_MMA(1, 0, At, B0); PG8_BAR; PG8_SCHED;
            PG8_STAGE(PG8_SB(1, 1), b3 + hstep, voffB);
            PG8_WAIT_V(6); PG8_BAR; PG8_MMA(1, 1, At, B1); PG8_BAR;
            }
        }
        if constexpr (ALIGN_EPI) { if (wr == 0) PG8_BAR; }
        if constexpr (!Epi::AFTER_DRAIN) { const int l2_ = opq_lane();   E(acc, cur, wr, wc, l2_ & 15, l2_ >> 4); S.done(cur); }
        if (!has_next) break;
        E.init(acc, nxt, wr, wc, fr, fq, cur.pm);
        cur = nxt; cA = nA; cB = nB; ++ui;
        if constexpr (ALIGN_EPI) { if (wr == 1) PG8_BAR; }
    }
    PG8_WAIT_V(0);
    if constexpr (!ALIGN_EPI) { if (wr == 0) PG8_BAR; }
    PG8_BAR;
    if constexpr (Epi::AFTER_DRAIN) { E.fused(acc, cur, wr, wc, fr, fq, lds, wid, lane); S.done(cur); }
#undef PG8_SA
#undef PG8_SB
#undef PG8_STAGE
#undef PG8_LDA
#undef PG8_LD16A
#undef PG8_LD16B
#undef PG8_LDB
#undef PG8_MMA
#undef PG8_WAIT_V
#undef PG8_WAIT_L
#undef PG8_BAR
#undef PG8_SCHED
}
}
#ifndef ATT_EARLY_A
#define ATT_EARLY_A true
#endif
#ifndef ATT_EARLY_B
#define ATT_EARLY_B true
#endif
namespace att {
using bf16x8 = __attribute__((ext_vector_type(8))) short;
using s16x4  = __attribute__((ext_vector_type(4))) short;
using f32x16 = __attribute__((ext_vector_type(16))) float;
using f32x4  = __attribute__((ext_vector_type(4))) float;
using u32x4  = __attribute__((ext_vector_type(4))) unsigned;
typedef unsigned short bf16_t;
constexpr int NW = 8, QBLK = 32, KVBLK = 64, DV = 128, OIMG_OFF = 98304;
constexpr float THR = 6.f;
constexpr int VROW = KVBLK + 16, SHM_V = DV * VROW;
typedef int v8i_t __attribute__((ext_vector_type(8)));
template <int DQK> struct Cfg { static constexpr int KROW = DQK + 16  , SHM_K = KVBLK * KROW, NS = DQK / 64, NKC = (DQK / 16 + 7) / 8, LDS_BYTES = 3 * SHM_V + 3 * SHM_K + NW * 64 * 4;
    static constexpr float SCALE = DQK == 128 ? 0.088388347648318440f : 0.072168783648703220f; };
#define SBAR() __builtin_amdgcn_sched_barrier(0)
__device__ __forceinline__ int crow(int r, int hi) { return (r & 3) + 8 * (r >> 2) + 4 * hi; }
__device__ __forceinline__ unsigned cvtpk(float lo, float hi) { unsigned r; asm volatile("v_cvt_pk_bf16_f32 %0, %1, %2" : "=v"(r) : "v"(lo), "v"(hi)); return r; }
__device__ __forceinline__ float bf2f(short s) { return __uint_as_float(((unsigned)(unsigned short)s) << 16); }
template <int DQK> __device__ __forceinline__ int kswz(int row, int colB) { return row * Cfg<DQK>::KROW + colB; }

constexpr float THRL = THR * 1.4426950408889634f;
template <bool FIRST> __device__ __forceinline__ void partialSM(f32x16& p0, f32x16& p1, f32x16& negm, float& alpha) {
  float pmax = p0[0];
#pragma unroll
  for (int r = 1; r < 16; ++r) pmax = fmaxf(pmax, p0[r]);
#pragma unroll
  for (int r = 0; r < 16; ++r) pmax = fmaxf(pmax, p1[r]);
  { auto rr = __builtin_amdgcn_permlane32_swap(__float_as_uint(pmax), __float_as_uint(pmax), false, false);
    pmax = fmaxf(__uint_as_float(rr[0]), __uint_as_float(rr[1])); }
  if (!FIRST && __builtin_expect(__all(pmax <= THRL), 1)) { alpha = 1.f; }
  else { const float delta = FIRST ? pmax : fmaxf(pmax, 0.f); const float nm = negm[0] - delta; alpha = __builtin_amdgcn_exp2f(-delta);
#pragma unroll
    for (int r = 0; r < 16; ++r) { p0[r] -= delta; p1[r] -= delta; }
#pragma unroll
    for (int r = 0; r < 16; ++r) negm[r] = nm; }
#pragma unroll
  for (int r = 0; r < 16; ++r) p0[r] = __builtin_amdgcn_exp2f(p0[r]);
}
#define ATT_PK4(P, BASE, OUT) do { unsigned a0 = cvtpk(P[BASE + 0], P[BASE + 1]), a1 = cvtpk(P[BASE + 2], P[BASE + 3]);   \
    unsigned b0 = cvtpk(P[BASE + 4], P[BASE + 5]), b1 = cvtpk(P[BASE + 6], P[BASE + 7]);                              \
    auto r0 = __builtin_amdgcn_permlane32_swap(a0, b0, false, false); auto r1 = __builtin_amdgcn_permlane32_swap(a1, b1, false, false); \
    u32x4 w = {r0[0], r1[0], r0[1], r1[1]}; OUT = __builtin_bit_cast(bf16x8, w); } while (0)
__device__ __forceinline__ unsigned pk4_fp8(float a, float b, float c, float d) { return (unsigned)__builtin_amdgcn_cvt_pk_fp8_f32(c, d, __builtin_amdgcn_cvt_pk_fp8_f32(a, b, 0, false), true); }
__device__ __forceinline__ void finishSM(f32x16& p0, f32x16& p1, v8i_t& pa) {
#pragma unroll
  for (int r = 0; r < 16; ++r) p1[r] = __builtin_amdgcn_exp2f(p1[r]);
#pragma unroll
  for (int i = 0; i < 4; ++i) { const unsigned d0 = pk4_fp8(p0[4 * i], p0[4 * i + 1], p0[4 * i + 2], p0[4 * i + 3]), d1 = pk4_fp8(p1[4 * i], p1[4 * i + 1], p1[4 * i + 2], p1[4 * i + 3]);
    auto rr = __builtin_amdgcn_permlane32_swap(d0, d1, false, false); pa[i] = (int)rr[0]; pa[4 + i] = (int)rr[1]; }
}
template <int DQK> __device__ __forceinline__ void qkt(f32x16& p0, f32x16& p1, const char* Ks, const v8i_t (&qf)[DQK / 64], const f32x16& negm, int r32, int hi) {
  p0 = negm; p1 = negm;
#pragma unroll
  for (int s = 0; s < DQK / 64; ++s) { const char* k0 = Ks + kswz<DQK>(r32, 64 * s + 32 * hi); const char* k1 = Ks + kswz<DQK>(32 + r32, 64 * s + 32 * hi);
    const u32x4 a0 = *reinterpret_cast<const u32x4*>(k0), a1 = *reinterpret_cast<const u32x4*>(k0 + 16), b0 = *reinterpret_cast<const u32x4*>(k1), b1 = *reinterpret_cast<const u32x4*>(k1 + 16);
    const v8i_t ka = {(int)a0.x, (int)a0.y, (int)a0.z, (int)a0.w, (int)a1.x, (int)a1.y, (int)a1.z, (int)a1.w}, kb = {(int)b0.x, (int)b0.y, (int)b0.z, (int)b0.w, (int)b1.x, (int)b1.y, (int)b1.z, (int)b1.w};
    p0 = __builtin_amdgcn_mfma_scale_f32_32x32x64_f8f6f4(ka, qf[s], p0, 0, 0, 0, 0x7f7f7f7f, 0, 0x7f7f7f7f);
    p1 = __builtin_amdgcn_mfma_scale_f32_32x32x64_f8f6f4(kb, qf[s], p1, 0, 0, 0, 0x7f7f7f7f, 0, 0x7f7f7f7f); }
}
__device__ __forceinline__ void pv_d0(f32x16* o, f32x16& osum, const char* Vs, const v8i_t& pa, int r32, int hi) {
  { const v8i_t ones = {0x38383838, 0x38383838, 0x38383838, 0x38383838, 0x38383838, 0x38383838, 0x38383838, 0x38383838};
    osum = __builtin_amdgcn_mfma_scale_f32_32x32x64_f8f6f4(pa, ones, osum, 0, 0, 0, 0x7f7f7f7f, 0, 0x7f7f7f7f); }
#pragma unroll
  for (int cb = 0; cb < 4; ++cb) { const char* vp = Vs + (cb * 32 + r32) * VROW + 32 * hi;
    const u32x4 a0 = *reinterpret_cast<const u32x4*>(vp), a1 = *reinterpret_cast<const u32x4*>(vp + 16);
    const v8i_t vf = {(int)a0.x, (int)a0.y, (int)a0.z, (int)a0.w, (int)a1.x, (int)a1.y, (int)a1.z, (int)a1.w};
    o[cb] = __builtin_amdgcn_mfma_scale_f32_32x32x64_f8f6f4(pa, vf, o[cb], 0, 0, 0, 0x7f7f7f7f, 0, 0x7f7f7f7f); }
}
template <int DQK, int SDEPTH, bool RING>
__device__ __forceinline__ void attn_unit(const v8i_t (&qr)[DQK / 64], const unsigned char* __restrict__ Kh, int ldk  , const unsigned char* __restrict__ Vh  , int ldv  ,
                                          unsigned char* __restrict__ Ob  , int ldo, int seq, char* lds, const int wv) {
  using C = Cfg<DQK>; constexpr int SHM_K = C::SHM_K, NKC = C::NKC, CPR = DQK / 16;
  int wid = wv; asm volatile("" : "+s"(wid));
  const int lane = pg8::opq_lane(), tid = wid * 64 + lane, r32 = lane & 31, hi = lane >> 5;
  constexpr int NSLOT = RING ? 3 : 2; constexpr bool EARLY_LD = (DQK == 128) ? ATT_EARLY_B : ATT_EARLY_A;
  char* V_lds = lds; char* K_lds = lds + NSLOT * SHM_V;
  float* ws = (float*)(lds + NSLOT * SHM_V + NSLOT * SHM_K) + wid * 64; float* li_l = ws; float* al_l = ws + 32;
  f32x16 o[4] = {}; f32x16 osum = {}, negm = {};
  const int srow = tid >> 3, sch = tid & 7;
  const unsigned koff = (unsigned)(srow * ldk + sch * 16), voff = (unsigned)((tid >> 2) * ldv + (tid & 3) * 16);
  const int kdst = kswz<DQK>(srow, sch * 16), vdst = (tid >> 2) * VROW + (tid & 3) * 16;
  struct { bf16x8 vs[1], ks[NKC]; } sr_[SDEPTH];
#define ATT_LD8(p) (*reinterpret_cast<const bf16x8*>(p))
#define SLOAD(i, k0) do { const char* vg_ = (const char*)Vh + (k0); const char* kg_ = (const char*)Kh + (size_t)(k0) * ldk; \
    sr_[i].vs[0] = ATT_LD8(vg_ + voff); \
    _Pragma("unroll") for (int q_ = 0; q_ < NKC; ++q_) if (sch + 8 * q_ < CPR) sr_[i].ks[q_] = ATT_LD8(kg_ + koff + q_ * 128); } while (0)
#define SWRITE(b, i) do { *(bf16x8*)(V_lds + (b) * SHM_V + vdst) = sr_[i].vs[0]; \
    _Pragma("unroll") for (int q_ = 0; q_ < NKC; ++q_) if (sch + 8 * q_ < CPR) *(bf16x8*)(K_lds + (b) * SHM_K + kdst + q_ * 128) = sr_[i].ks[q_]; } while (0)
#define SWAIT() do { if constexpr (SDEPTH == 1) asm volatile("s_waitcnt vmcnt(0)" ::: "memory"); else if constexpr (NKC == 1) asm volatile("s_waitcnt vmcnt(2)" ::: "memory"); else asm volatile("s_waitcnt vmcnt(3)" ::: "memory"); } while (0)
#define RESC(a) do { if (__any((a) < 1.f)) { if (hi == 0) al_l[r32] = (a); asm volatile("s_waitcnt lgkmcnt(0)" ::: "memory"); \
    _Pragma("unroll") for (int r = 0; r < 16; ++r) { const float f_ = al_l[crow(r, hi)]; osum[r] *= f_; _Pragma("unroll") for (int d = 0; d < 4; ++d) o[d][r] *= f_; } } } while (0)
  f32x16 pA0, pA1, pB0, pB1; float alA, alB; v8i_t pa; const int NT = seq / KVBLK;
  if constexpr (RING) {
  static_assert(SDEPTH == 1, "the three-slot ring stages one tile ahead");
#define ATT_STEP(PX0, PX1, PY0, PY1, ALY, SC, SP, SN, JJ) do { \
    SBAR(); if constexpr (EARLY_LD) { SLOAD(0, ((JJ) + 1) * KVBLK); SBAR(); } qkt<DQK>(PY0, PY1, K_lds + (SC) * SHM_K, qr, negm, r32, hi); \
    finishSM(PX0, PX1, pa); SBAR(); \
    if constexpr (!EARLY_LD) { SLOAD(0, ((JJ) + 1) * KVBLK); SBAR(); } \
    pv_d0(o, osum, V_lds + (SP) * SHM_V, pa, r32, hi); partialSM<false>(PY0, PY1, negm, ALY); \
    SWAIT(); SWRITE(SN, 0); \
    RESC(ALY); __syncthreads(); } while (0)
  SLOAD(0, 0); asm volatile("s_waitcnt vmcnt(0)" ::: "memory"); SWRITE(0, 0); __syncthreads();
  qkt<DQK>(pA0, pA1, K_lds, qr, negm, r32, hi); partialSM<true>(pA0, pA1, negm, alA);
  SLOAD(0, KVBLK); SWAIT(); SWRITE(1, 0); __syncthreads();
  for (int j = 1; j + 1 < NT; j += 6) {
    ATT_STEP(pA0, pA1, pB0, pB1, alB, 1, 0, 2, j);
    ATT_STEP(pB0, pB1, pA0, pA1, alA, 2, 1, 0, j + 1);
    ATT_STEP(pA0, pA1, pB0, pB1, alB, 0, 2, 1, j + 2);
    ATT_STEP(pB0, pB1, pA0, pA1, alA, 1, 0, 2, j + 3);
    ATT_STEP(pA0, pA1, pB0, pB1, alB, 2, 1, 0, j + 4);
    ATT_STEP(pB0, pB1, pA0, pA1, alA, 0, 2, 1, j + 5);
  }
  SBAR(); qkt<DQK>(pB0, pB1, K_lds + 1 * SHM_K, qr, negm, r32, hi);
  finishSM(pA0, pA1, pa); SBAR();
  pv_d0(o, osum, V_lds, pa, r32, hi); partialSM<false>(pB0, pB1, negm, alB);
  RESC(alB);
  finishSM(pB0, pB1, pa); SBAR();
  pv_d0(o, osum, V_lds + 1 * SHM_V, pa, r32, hi);
#undef ATT_STEP
  } else {
  constexpr int SE = 0, SO = SDEPTH - 1;
  SLOAD(SE, 0); asm volatile("s_waitcnt vmcnt(0)" ::: "memory"); SWRITE(0, SE); __syncthreads();
  qkt<DQK>(pA0, pA1, K_lds, qr, negm, r32, hi); partialSM<true>(pA0, pA1, negm, alA);
  SLOAD(SO, KVBLK); if constexpr (SDEPTH == 2) { if (2 < NT) SLOAD(SE, 2 * KVBLK); }
  SWAIT(); SWRITE(1, SO); __syncthreads();
  for (int j = 1; j + 1 < NT; j += 2) {
    SBAR(); qkt<DQK>(pB0, pB1, K_lds + SHM_K, qr, negm, r32, hi);
    finishSM(pA0, pA1, pa); SBAR();
    SLOAD(SO, (j + SDEPTH) * KVBLK); SBAR();
    pv_d0(o, osum, V_lds, pa, r32, hi); partialSM<false>(pB0, pB1, negm, alB);
    __syncthreads(); SWAIT(); SWRITE(0, SE);
    RESC(alB); __syncthreads();
    SBAR(); qkt<DQK>(pA0, pA1, K_lds, qr, negm, r32, hi);
    finishSM(pB0, pB1, pa); SBAR();
    if (SDEPTH == 1 || j + 3 < NT) SLOAD(SE, (j + 1 + SDEPTH) * KVBLK); SBAR();
    pv_d0(o, osum, V_lds + SHM_V, pa, r32, hi); partialSM<false>(pA0, pA1, negm, alA);
    __syncthreads(); SWAIT(); SWRITE(1, SO);
    RESC(alA); __syncthreads();
  }
  SBAR(); qkt<DQK>(pB0, pB1, K_lds + SHM_K, qr, negm, r32, hi);
  finishSM(pA0, pA1, pa); SBAR();
  pv_d0(o, osum, V_lds, pa, r32, hi); partialSM<false>(pB0, pB1, negm, alB);
  __syncthreads(); RESC(alB);
  finishSM(pB0, pB1, pa); SBAR();
  pv_d0(o, osum, V_lds + SHM_V, pa, r32, hi);
  }
  float rli[16];
#pragma unroll
  for (int r = 0; r < 16; ++r) rli[r] = 64.0f * __builtin_amdgcn_rcpf(osum[r]);
  unsigned char* Ow = Ob + (long)(wid * QBLK) * ldo;
  static_assert(C::LDS_BYTES <= OIMG_OFF, "the output image sits above the K / V^T slots");
  char* oimg = lds + OIMG_OFF + wid * (QBLK * DV);
#pragma unroll
  for (int r = 0; r < 16; ++r) { const int orow = crow(r, hi);
    const unsigned w4 = (unsigned)__builtin_amdgcn_cvt_pk_fp8_f32(o[2][r] * rli[r], o[3][r] * rli[r], __builtin_amdgcn_cvt_pk_fp8_f32(o[0][r] * rli[r], o[1][r] * rli[r], 0, false), true);
    oimg[orow * DV + r32] = (char)(w4 & 0xff); oimg[orow * DV + 32 + r32] = (char)((w4 >> 8) & 0xff); oimg[orow * DV + 64 + r32] = (char)((w4 >> 16) & 0xff); oimg[orow * DV + 96 + r32] = (char)(w4 >> 24); }
  asm volatile("s_waitcnt lgkmcnt(0)" ::: "memory");
#pragma unroll
  for (int i = 0; i < 4; ++i) { const int c_ = i * 64 + lane, row_ = c_ >> 3, ch_ = c_ & 7;
    const u32x4 v_ = *reinterpret_cast<const u32x4*>(oimg + row_ * DV + ch_ * 16); *reinterpret_cast<u32x4*>(Ow + (long)row_ * ldo + ch_ * 16) = v_; }
  __syncthreads();
#undef SLOAD
#undef SWRITE
#undef SWAIT
#undef RESC
#undef ATT_LD8
}

constexpr int MROW = 528, MEM_LDS_BYTES = 256 * MROW;
__device__ __forceinline__ void mem_attn_unit(const bf16_t* __restrict__ Qb, int ldq, const float* __restrict__ gq, float eps, const bf16_t* __restrict__ Kt, int ldk, const bf16_t* __restrict__ VT,
                                              unsigned char* __restrict__ Ob  , int ldo, char* lds, float* wsl, const int wv) {
  int wid = wv; asm volatile("" : "+s"(wid));
  const int lane = pg8::opq_lane(), tid = wid * 64 + lane, r32 = lane & 31, hi = lane >> 5;
  const bf16_t* qp = Qb + (long)(wid * QBLK + r32) * ldq + hi * 8;
  float ss = 0.f;
#pragma unroll
  for (int d0 = 0; d0 < 16; ++d0) { const bf16x8 q = *reinterpret_cast<const bf16x8*>(qp + d0 * 16);
#pragma unroll
    for (int e = 0; e < 8; ++e) { const float f = bf2f(q[e]); ss += f * f; } }
  { auto rr = __builtin_amdgcn_permlane32_swap(__float_as_uint(ss), __float_as_uint(ss), false, false); ss = __uint_as_float(rr[0]) + __uint_as_float(rr[1]); }
  const float rstd = 1.0f / sqrtf(ss * (1.0f / 256.0f) + eps);
  { const int srow = tid >> 5, sch = tid & 31;
#pragma unroll 4
    for (int i = 0; i < 16; ++i) *(bf16x8*)(lds + (srow + 16 * i) * MROW + sch * 16) = *reinterpret_cast<const bf16x8*>(Kt + (long)(srow + 16 * i) * ldk + sch * 8); }
  __syncthreads();
  f32x16 s[8];
#pragma unroll
  for (int kb = 0; kb < 8; ++kb) s[kb] = f32x16{};
  typedef const __attribute__((address_space(3))) bf16x8* lds_frag_t;
  unsigned rd = (unsigned)(uintptr_t)lds + r32 * MROW + hi * 16;
  unsigned rd4 = rd + 4 * 32 * MROW;
  asm volatile("" : "+v"(rd)); asm volatile("" : "+v"(rd4));
#pragma unroll
  for (int d0 = 0; d0 < 16; ++d0) {
    const bf16x8 qraw = *reinterpret_cast<const bf16x8*>(qp + d0 * 16);
    const f32x4 g0 = *(const f32x4*)(gq + d0 * 16 + hi * 8), g1 = *(const f32x4*)(gq + d0 * 16 + hi * 8 + 4);
    float x[8];
#pragma unroll
    for (int e = 0; e < 4; ++e) { x[e] = bf2f(qraw[e]) * rstd * g0[e]; x[4 + e] = bf2f(qraw[4 + e]) * rstd * g1[e]; }
    const u32x4 w = {cvtpk(x[0], x[1]), cvtpk(x[2], x[3]), cvtpk(x[4], x[5]), cvtpk(x[6], x[7])}; const bf16x8 qf = __builtin_bit_cast(bf16x8, w);
#pragma unroll
    for (int kb = 0; kb < 8; ++kb) { const bf16x8 kf = *(lds_frag_t)((kb < 4 ? rd : rd4) + (kb & 3) * 32 * MROW + d0 * 32); s[kb] = __builtin_amdgcn_mfma_f32_32x32x16_bf16(kf, qf, s[kb], 0, 0, 0); } }
  constexpr float C = 0.0625f * 1.4426950408889634f;
  float mx = s[0][0];
#pragma unroll
  for (int kb = 0; kb < 8; ++kb)
#pragma unroll
    for (int r = 0; r < 16; ++r) mx = fmaxf(mx, s[kb][r]);
  { auto rr = __builtin_amdgcn_permlane32_swap(__float_as_uint(mx), __float_as_uint(mx), false, false); mx = fmaxf(__uint_as_float(rr[0]), __uint_as_float(rr[1])); }
  const float mC = -mx * C; float ps = 0.f;
#pragma unroll
  for (int kb = 0; kb < 8; ++kb)
#pragma unroll
    for (int r = 0; r < 16; ++r) { s[kb][r] = __builtin_amdgcn_exp2f(fmaf(s[kb][r], C, mC)); ps += s[kb][r]; }
  { auto rr = __builtin_amdgcn_permlane32_swap(__float_as_uint(ps), __float_as_uint(ps), false, false); ps = __uint_as_float(rr[0]) + __uint_as_float(rr[1]); }
  bf16x8 pa[16];
#pragma unroll
  for (int kb = 0; kb < 8; ++kb) { ATT_PK4(s[kb], 0, pa[2 * kb]); ATT_PK4(s[kb], 8, pa[2 * kb + 1]); }
  __syncthreads();
  { const int srow = tid >> 5, sch = tid & 31;
#pragma unroll 4
    for (int i = 0; i < 16; ++i) *(bf16x8*)(lds + (srow + 16 * i) * MROW + sch * 16) = *reinterpret_cast<const bf16x8*>(VT + (long)(srow + 16 * i) * 256 + sch * 8); }
  __syncthreads();
  float* li_l = wsl + wid * 64;
  if (hi == 0) li_l[r32] = ps; asm volatile("s_waitcnt lgkmcnt(0)" ::: "memory");
  unsigned char* Ow = Ob + (long)(wid * QBLK) * ldo;
#pragma unroll
  for (int half = 0; half < 2; ++half) {
    f32x16 o[4];
#pragma unroll
    for (int c = 0; c < 4; ++c) o[c] = f32x16{};
#pragma unroll
    for (int ks = 0; ks < 16; ++ks)
#pragma unroll
      for (int c = 0; c < 4; ++c) { const bf16x8 vf = *(lds_frag_t)((half == 0 ? rd : rd4) + c * 32 * MROW + ks * 32); o[c] = __builtin_amdgcn_mfma_f32_32x32x16_bf16(pa[ks], vf, o[c], 0, 0, 0); }
#pragma unroll
    for (int r = 0; r < 16; ++r) { const int orow = crow(r, hi); const float rl = 64.0f * __builtin_amdgcn_rcpf(li_l[orow]);
#pragma unroll
      for (int c = 0; c < 4; ++c) Ow[(long)orow * ldo + (half * 4 + c) * 32 + r32] = (unsigned char)(__builtin_amdgcn_cvt_pk_fp8_f32(o[c][r] * rl, 0.f, 0, false) & 0xff); } }
  __syncthreads();
}
#undef SBAR
#undef ATT_PK4
}

#define GAS __attribute__((address_space(1)))
#define LAS __attribute__((address_space(3)))
typedef unsigned short bf16;
typedef unsigned v4u __attribute__((ext_vector_type(4)));
typedef float f32x4 __attribute__((ext_vector_type(4)));
typedef short bf16x8 __attribute__((ext_vector_type(8)));
typedef GAS unsigned gu32;
typedef GAS unsigned long long gu64;
#define RLX_AGENT __ATOMIC_RELAXED, __HIP_MEMORY_SCOPE_AGENT
#define LDS_WAIT() asm volatile("s_waitcnt lgkmcnt(0)" ::: "memory")
#define VM_WAIT() asm volatile("s_waitcnt vmcnt(0)" ::: "memory")
__device__ __forceinline__ unsigned long long rt() { return __builtin_amdgcn_s_memrealtime(); }
__device__ __forceinline__ unsigned f2bf(float f) { unsigned u = __builtin_bit_cast(unsigned, f); return (u + 0x7fffu + ((u >> 16) & 1u)) >> 16; }
__device__ __forceinline__ unsigned pk2(float lo, float hi) { return f2bf(lo) | (f2bf(hi) << 16); }

#define XB_TMO      128
#define XB_XCNT(j)  (256  + 64 * (j))
#define XB_XSUB(j)  (1280 + 64 * (j))
#define XB_XGEN(j)  (2304 + 64 * (j))
#define XB_TOP      3328
#define XB_TOPGEN   3392
#define XCD_BAR_WORDS 3456
#define XB_SPIN_CAP (1u << 18)

__device__ __forceinline__ unsigned xb_ld(unsigned* p)              { return __hip_atomic_load(p, __ATOMIC_RELAXED, __HIP_MEMORY_SCOPE_AGENT); }
__device__ __forceinline__ unsigned xb_add(unsigned* p, unsigned v) { return __hip_atomic_fetch_add(p, v, __ATOMIC_RELAXED, __HIP_MEMORY_SCOPE_AGENT); }
__device__ __forceinline__ unsigned xb_xcc_id() { return (unsigned)__builtin_amdgcn_s_getreg((3 << 11) | 20) & 0xFu; }
#define XB_SPIN(cond, bar) do { unsigned _sp = 0; while (cond) { __builtin_amdgcn_s_sleep(1); \
    if ((++_sp & 255u) == 0u) { if (xb_ld(&(bar)[XB_TMO])) break; if (_sp > XB_SPIN_CAP) { atomicAdd(&(bar)[XB_TMO], 1u); break; } } } } while (0)

struct XcdBarrier {
    unsigned* bar; unsigned x;
    volatile LAS unsigned* st;
};

__device__ __forceinline__ XcdBarrier xcd_barrier_post(unsigned* bar, volatile LAS unsigned* st) {
    XcdBarrier b; b.bar = bar; b.x = xb_xcc_id(); b.st = st;
    if (threadIdx.x == 0) (void)xb_add(&bar[XB_XCNT(b.x)], 1u);
    return b;
}
__device__ __forceinline__ void xcd_barrier_complete(unsigned* bar, unsigned x, unsigned& nloc, unsigned& nx) {
    const unsigned G = gridDim.x * gridDim.y * gridDim.z;
    unsigned sum, cnt, mine, sp = 0u;
    for (;;) {
        sum = 0u; cnt = 0u; mine = 0u;
#pragma unroll
        for (unsigned j = 0; j < 16; ++j) { const unsigned c = xb_ld(&bar[XB_XCNT(j)]); sum += c; cnt += (c > 0u) ? 1u : 0u; mine = (j == x) ? c : mine; }
        if (sum == G) break;
        __builtin_amdgcn_s_sleep(1);
        if ((++sp & 255u) == 0u) { if (xb_ld(&bar[XB_TMO])) break; if (sp > XB_SPIN_CAP) { atomicAdd(&bar[XB_TMO], 1u); break; } }
    }
    nloc = mine > 0u ? mine : 1u; nx = cnt > 0u ? cnt : 1u;
}

__device__ __forceinline__ void xcd_barrier(const XcdBarrier& b) {
    asm volatile("s_waitcnt vmcnt(0)" ::: "memory");
    __syncthreads();
    if (threadIdx.x == 0) {
        unsigned* bar = b.bar;
        __builtin_amdgcn_s_waitcnt(0);
        unsigned nloc = b.st[0], nx = b.st[1];
        if (nloc == 0u) { xcd_barrier_complete(bar, b.x, nloc, nx); b.st[0] = nloc; b.st[1] = nx; }
        const unsigned old = xb_add(&bar[XB_XSUB(b.x)], 1u);
        const unsigned gen = old / nloc;
        if (old + 1u == (gen + 1u) * nloc) {
            __builtin_amdgcn_fence(__ATOMIC_RELEASE, "agent");
            asm volatile("s_waitcnt vmcnt(0)" ::: "memory");
            const unsigned og = xb_add(&bar[XB_TOP], 1u);
            const unsigned tg = og / nx;
            if (og + 1u == (tg + 1u) * nx) xb_add(&bar[XB_TOPGEN], 1u);
            else XB_SPIN(xb_ld(&bar[XB_TOPGEN]) == tg, bar);
            __builtin_amdgcn_fence(__ATOMIC_ACQUIRE, "agent");
            xb_add(&bar[XB_XGEN(b.x)], 1u);
            asm volatile("s_waitcnt vmcnt(0)" ::: "memory");
        } else {
            XB_SPIN(xb_ld(&bar[XB_XGEN(b.x)]) == gen, bar);
            __builtin_amdgcn_fence(__ATOMIC_ACQUIRE, "agent");
            asm volatile("s_waitcnt vmcnt(0)" ::: "memory");
        }
    }
    __syncthreads();
}

__device__ __forceinline__ void quad_barrier(unsigned* cnt, unsigned* tmo_bar, const unsigned epoch, const bool same_xcc  ) {
    asm volatile("s_waitcnt vmcnt(0)" ::: "memory");
    __syncthreads();
    if (threadIdx.x == 0) {
        __builtin_amdgcn_s_waitcnt(0);
        if (!same_xcc) { __builtin_amdgcn_fence(__ATOMIC_RELEASE, "agent"); asm volatile("s_waitcnt vmcnt(0)" ::: "memory"); }
        (void)xb_add(cnt, 1u);
        const unsigned target = 4u * epoch;
        XB_SPIN(xb_ld(cnt) < target, tmo_bar);
        __builtin_amdgcn_fence(__ATOMIC_ACQUIRE, "agent");
        asm volatile("s_waitcnt vmcnt(0)" ::: "memory");
    }
    __syncthreads();
}

constexpr int NWAVES = 8;
constexpr int BATCH = 2, SEQ = 8192, DM = 4096, DFF = 6144, DEPTH = 4, M = BATCH * SEQ;
constexpr int MEMT = 256, MEMR = BATCH * MEMT;
constexpr int NH = 24, HD = 128, TOKW = 3072, MEMW = 1024, MEMHD = 256;
constexpr int A_QL = 1024, A_KVL = 512, A_ROPE = 64, A_IN = 2624, A_INP = 2816, A_QBN = 4608, A_KVBN = 6144, A_KW = NH * 192;
constexpr int B_IN = 5632, B_KVH = 6, B_KW = B_KVH * HD;
constexpr float EPS = 1e-6f;

constexpr size_t MiB = 1u << 20;
constexpr size_t CTL_ZERO_BYTES = 1 * MiB;
constexpr size_t WS_CTL = 0;
constexpr size_t WS_ROPE = 1 * MiB;
constexpr size_t WS_COSA = WS_ROPE, WS_SINA = WS_ROPE + 1 * MiB, WS_COSB = WS_ROPE + 2 * MiB, WS_SINB = WS_ROPE + 4 * MiB;
constexpr size_t WS_PAR = 7 * MiB;
constexpr int PAR_MQ = 0, PAR_QN = 1024, PAR_QP = 1280, PAR_KN = 1408, PAR_KP = 1664, PAR_BQ = 1792, PAR_BK = 2048, PAR_N = 2304;
constexpr size_t WS_RSTD = 7 * MiB + 64 * 1024;
constexpr size_t WS_W = 8 * MiB;
constexpr size_t SZ_GU = (size_t)2 * DFF * DM * 2, SZ_DN = (size_t)DM * DFF * 2, SZ_WO = (size_t)DM * DM * 2;
constexpr size_t SZ_LAYER = 2 * SZ_GU + 2 * SZ_DN + SZ_WO;
constexpr size_t OFF_GU1 = 0, OFF_DN1 = SZ_GU, OFF_GU2 = SZ_GU + SZ_DN, OFF_DN2 = 2 * SZ_GU + SZ_DN, OFF_WO = 2 * SZ_GU + 2 * SZ_DN;
constexpr size_t WS_WMEM = WS_W + DEPTH * SZ_LAYER;
constexpr size_t SZ_AIN = (size_t)A_INP * DM * 2, SZ_AQB = (size_t)A_QBN * A_QL * 2, SZ_AKVB = (size_t)A_KVBN * A_KVL * 2, SZ_A = SZ_AIN + SZ_AQB + SZ_AKVB;
constexpr size_t WS_WA = WS_WMEM + 64 * MiB;
constexpr size_t SZ_BIN = (size_t)B_IN * DM * 2;
constexpr size_t WS_WB = WS_WA + 2 * SZ_A;
constexpr size_t WS_ACT = WS_WB + 2 * SZ_BIN;
constexpr size_t WS_XN = WS_ACT;
constexpr size_t WS_H = WS_XN + (size_t)M * DM * 2;
constexpr size_t WS_O = WS_H + (size_t)M * DFF * 2;
constexpr size_t WS_QM = WS_O + (size_t)M * DM * 2;
constexpr size_t WS_T0 = WS_QM + (size_t)M * MEMW * 2;
constexpr size_t WS_CQ = WS_T0, WS_CKV = WS_CQ + (size_t)M * 1024 * 2, WS_CQN = WS_CKV + (size_t)M * 768 * 2, WS_CKVN = WS_CQN + (size_t)M * 1024 * 2;
constexpr size_t WS_QA = WS_CKVN + (size_t)M * 512 * 2, WS_KVR = WS_QA + (size_t)M * A_QBN * 2, WS_K192 = WS_KVR + (size_t)M * A_KVBN * 2, WS_AEND = WS_K192 + (size_t)M * A_KW * 2;
constexpr size_t WS_QB = WS_T0, WS_KBR = WS_QB + (size_t)M * TOKW * 2, WS_VB = WS_KBR + (size_t)M * B_KW * 2, WS_KB = WS_VB + (size_t)M * B_KW * 2;
constexpr size_t WS_MEMN = WS_AEND;
constexpr size_t WS_MEMKV = WS_MEMN + (size_t)MEMR * DM * 2;
constexpr size_t WS_MK = WS_MEMKV + (size_t)MEMR * 8192 * 2;
constexpr size_t WS_MVT = WS_MK + (size_t)DEPTH * MEMR * 1024 * 2;
constexpr size_t WS_PROBE = WS_MVT + (size_t)DEPTH * MEMR * 1024 * 2;
constexpr size_t WS_RSP = WS_PROBE;
constexpr size_t WS_RSPA = WS_RSP + (size_t)M * 16 * 4;
constexpr size_t WS_END = WS_RSPA + (size_t)M * 16 * 4;
constexpr size_t WS_VT8A = WS_K192 + (size_t)M * A_KW, WS_VT8B = WS_KB + (size_t)M * B_KW;
constexpr size_t WS_X8 = WS_O + (size_t)M * DM;
constexpr size_t OFF_AQM = 8 * MiB, OFF_BQM = 20 * MiB;
constexpr int QW_BASE = 16384;
constexpr int CW_BAR = 4096;

constexpr int RING_OFF = 0, RING_BYTES = 131072;
constexpr int LDSCTL_OFF = att::MEM_LDS_BYTES, MISC_OFF = LDSCTL_OFF + 320, WSL_OFF = LDSCTL_OFF + 2048;
constexpr int EPI_RED_OFF = WSL_OFF + 2048, EPI_RS_OFF = EPI_RED_OFF + 4096;
constexpr int LDS_BYTES = 147456;
static_assert(2 * 66560 <= att::MEM_LDS_BYTES && att::Cfg<192>::LDS_BYTES <= RING_BYTES && att::MEM_LDS_BYTES >= RING_BYTES && EPI_RS_OFF + 1024 <= LDS_BYTES && EPI_RED_OFF + 8192 <= LDS_BYTES && WSL_OFF + 9216 <= LDS_BYTES, "LDS map");

typedef float f32x4 __attribute__((ext_vector_type(4)));
typedef short bf16x8 __attribute__((ext_vector_type(8)));

struct Args { const float* in[26]; float* out; unsigned char* ws; };

__device__ __forceinline__ unsigned char* opq_ptr(unsigned char* p) { GAS unsigned char* g = (GAS unsigned char*)p; asm volatile("" : "+s"(g)); return (unsigned char*)g; }
struct Frame { LAS unsigned char* lds; int tid, lane, wave, vcu, G, bx, gw, NGW; };

template <int O> __device__ __forceinline__ float xor_add(float v) {
    if constexpr (O == 32) { auto rr = __builtin_amdgcn_permlane32_swap(__float_as_uint(v), __float_as_uint(v), false, false); return __uint_as_float(rr[0]) + __uint_as_float(rr[1]); }
    else return v + __int_as_float(__builtin_amdgcn_ds_swizzle(__float_as_int(v), (O << 10) | 0x1f));
}
template <int LANES> __device__ __forceinline__ float group_sum(float v) {
    if constexpr (LANES > 1) v = xor_add<1>(v);
    if constexpr (LANES > 2) v = xor_add<2>(v);
    if constexpr (LANES > 4) v = xor_add<4>(v);
    if constexpr (LANES > 8) v = xor_add<8>(v);
    if constexpr (LANES > 16) v = xor_add<16>(v);
    if constexpr (LANES > 32) v = xor_add<32>(v);
    return v;
}
__device__ __forceinline__ float wave_sum(float v) { return group_sum<64>(v); }
__device__ __forceinline__ float bf2f(short s) { return __uint_as_float(((unsigned)(unsigned short)s) << 16); }

__device__ __forceinline__ int dst_row(int kind, int n0, int row_off) {
    switch (kind) {
        case 1: { const int up = n0 >= DFF, f = up ? n0 - DFF : n0; return 256 * (f >> 7) + (f & 127) + (up ? 128 : 0); }
        case 2: return n0 < 1024 ? n0 : (n0 < 1600 ? n0 + 1024 : (n0 < 2624 ? n0 - 576 : n0));
        case 3: { const int h = n0 / 192, d = n0 % 192; return d < 128 ? h * 128 + d : 3072 + h * 64 + (d - 128); }
        case 4: { const int h = n0 >> 8, d = n0 & 255; return d < 128 ? h * 128 + d : 3072 + h * 128 + (d - 128); }
        default: return n0 + row_off;
    }
}
struct TrItem { f32x4 a[8], b[8]; };
__device__ __forceinline__ void tr_load(TrItem& t, const float* W, int K, int N, const float* gain, int item, int lane) {
    const int nblk = N >> 6, kb = item / nblk, nb = item - kb * nblk, k0 = 64 * kb, n0 = 64 * nb, c4 = (lane & 15) * 4, rq = lane >> 4;
    const GAS f32x4* src = (const GAS f32x4*)(W + (size_t)(k0 + 2 * rq) * N + n0 + c4); const size_t rs = (size_t)(N >> 2);
#pragma unroll
    for (int i = 0; i < 8; ++i) { t.a[i] = src[(size_t)(8 * i) * rs]; t.b[i] = src[(size_t)(8 * i + 1) * rs]; }
    (void)K; (void)gain;
}
__device__ __forceinline__ void tr_store(const TrItem& t, int K, int N, bf16* WT, int kind, int row_off, const float* gain, LAS unsigned* scr, int item, int lane) {
    const int nblk = N >> 6, kb = item / nblk, nb = item - kb * nblk, k0 = 64 * kb, n0 = 64 * nb, c4 = (lane & 15) * 4, rq = lane >> 4;
    const int r0 = dst_row(kind, n0, row_off);
#pragma unroll
    for (int i = 0; i < 8; ++i) { const float ga = gain ? gain[k0 + 8 * i + 2 * rq] : 1.0f, gb = gain ? gain[k0 + 8 * i + 2 * rq + 1] : 1.0f;
#pragma unroll
        for (int c = 0; c < 4; ++c) scr[(c4 + c) * 33 + 4 * i + rq] = pg8::cvt_pk_bf16(t.a[i][c] * ga, t.b[i][c] * gb); }
    LDS_WAIT(); asm volatile("" ::: "memory");
    const int q = lane & 7;
#pragma unroll
    for (int j = 0; j < 8; ++j) { const int n = 8 * j + (lane >> 3); const LAS unsigned* sp = scr + n * 33 + 4 * q;
        v4u o; o.x = sp[0]; o.y = sp[1]; o.z = sp[2]; o.w = sp[3];
        *(GAS v4u*)(WT + (size_t)(r0 + n) * K + k0 + 8 * q) = o; }
    LDS_WAIT(); asm volatile("" ::: "memory");
}
__device__ __forceinline__ void convert_weight(const Frame& F, const float* W, int K, int N, bf16* WT, int kind, int row_off, const float* gain) {
    LAS unsigned* scr = (LAS unsigned*)(F.lds + RING_OFF + F.wave * 16384);
    const int nitems = (K >> 6) * (N >> 6); const int lane = F.lane;
    TrItem ta, tb; int it = F.gw;
    if (it < nitems) tr_load(ta, W, K, N, gain, it, lane);
    for (; it < nitems; it += 2 * F.NGW) {
        const int it1 = it + F.NGW, it2 = it + 2 * F.NGW;
        if (it1 < nitems) tr_load(tb, W, K, N, gain, it1, lane);
        tr_store(ta, K, N, WT, kind, row_off, gain, scr, it, lane);
        if (it1 < nitems) { if (it2 < nitems) tr_load(ta, W, K, N, gain, it2, lane);
                            tr_store(tb, K, N, WT, kind, row_off, gain, scr, it1, lane); }
    }
}
constexpr int TRW_ROW = 65, TRW_BUF = 256 * TRW_ROW * 4;
__device__ __forceinline__ void convert_weight_wg(const Frame& F, const float* W  , int K, int N  , int NS  , bf16* WT, int kind, int row_off, const float* gain, bool fp8, float wsc = 1.0f  ) {
    const int nblk = (N + 255) >> 8, ntiles = (K >> 7) * nblk, lane = F.lane, w = F.wave;
    f32x4 a[8], b[8]; int tile = F.vcu, par = 0;
    const size_t rs = (size_t)(NS >> 2);
#define TRW_LOAD(t_) do { const int kb_ = (t_) / nblk, nb_ = (t_) - kb_ * nblk; const GAS f32x4* src_ = (const GAS f32x4*)(W + (size_t)(128 * kb_ + 16 * w) * NS + 256 * nb_ + 4 * lane); \
        if (256 * nb_ + 4 * lane < N) { _Pragma("unroll") for (int i = 0; i < 8; ++i) { a[i] = src_[(size_t)(2 * i) * rs]; b[i] = src_[(size_t)(2 * i + 1) * rs]; } } \
        else { _Pragma("unroll") for (int i = 0; i < 8; ++i) { a[i] = (f32x4){0.f, 0.f, 0.f, 0.f}; b[i] = (f32x4){0.f, 0.f, 0.f, 0.f}; } } } while (0)
    if (tile < ntiles) TRW_LOAD(tile);
    for (; tile < ntiles; tile += F.G, par ^= 1) {
        const int kb = tile / nblk, nb = tile - kb * nblk, k0 = 128 * kb, n0 = 256 * nb;
        LAS unsigned* img = (LAS unsigned*)(F.lds + par * TRW_BUF);
        if (!fp8) {
#pragma unroll
        for (int i = 0; i < 8; ++i) { const float ga = gain ? gain[k0 + 16 * w + 2 * i] : 1.0f, gb = gain ? gain[k0 + 16 * w + 2 * i + 1] : 1.0f;
#pragma unroll
            for (int c = 0; c < 4; ++c) img[(c * 64 + lane) * TRW_ROW + 8 * w + i] = pg8::cvt_pk_bf16(a[i][c] * ga, b[i][c] * gb); }
        } else {
#pragma unroll
        for (int q = 0; q < 4; ++q) { const int kk = k0 + 16 * w + 4 * q; const float g0 = (gain ? gain[kk] : 1.0f) * wsc, g1 = (gain ? gain[kk + 1] : 1.0f) * wsc, g2 = (gain ? gain[kk + 2] : 1.0f) * wsc, g3 = (gain ? gain[kk + 3] : 1.0f) * wsc;
#pragma unroll
            for (int c = 0; c < 4; ++c) img[(c * 64 + lane) * TRW_ROW + 4 * w + q] = (unsigned)__builtin_amdgcn_cvt_pk_fp8_f32(a[2 * q + 1][c] * g2, b[2 * q + 1][c] * g3, __builtin_amdgcn_cvt_pk_fp8_f32(a[2 * q][c] * g0, b[2 * q][c] * g1, 0, false), true); }
        }
        if (tile + F.G < ntiles) TRW_LOAD(tile + F.G);
        asm volatile("s_waitcnt lgkmcnt(0)" ::: "memory"); __builtin_amdgcn_s_barrier(); asm volatile("" ::: "memory");
        if (!fp8) {
        const int q = lane & 15;
#pragma unroll
        for (int j = 0; j < 8; ++j) { const int r = 32 * w + 4 * j + (lane >> 4), n = 4 * (r & 63) + (r >> 6); const LAS unsigned* sp = img + r * TRW_ROW + 4 * q;
            v4u o; o.x = sp[0]; o.y = sp[1]; o.z = sp[2]; o.w = sp[3];
            const int dr = dst_row(kind, n0 + (n & ~63), row_off) + (n & 63);
            *(GAS v4u*)(WT + (size_t)dr * K + k0 + 8 * q) = o; }
        } else {
        const int q = lane & 7;
#pragma unroll
        for (int j = 0; j < 4; ++j) { const int r = 32 * w + 8 * j + (lane >> 3), n = 4 * (r & 63) + (r >> 6); const LAS unsigned* sp = img + r * TRW_ROW + 4 * q;
            v4u o; o.x = sp[0]; o.y = sp[1]; o.z = sp[2]; o.w = sp[3];
            const int dr = dst_row(kind, n0 + (n & ~63), row_off) + (n & 63);
            *(GAS v4u*)((unsigned char*)WT + (size_t)dr * K + k0 + 16 * q) = o; }
        }
    }
#undef TRW_LOAD
    asm volatile("s_waitcnt lgkmcnt(0)" ::: "memory"); __builtin_amdgcn_s_barrier(); asm volatile("" ::: "memory");
}
__device__ __forceinline__ void xnorm_rows(const Frame& F, const float* x, bf16* xn, int nrows) {
    const int lane = pg8::opq_lane();
    for (int m = F.gw; m < nrows; m += F.NGW) {
        const GAS f32x4* xr = (const GAS f32x4*)(x + (size_t)m * DM) + lane;
        f32x4 v[16]; float s = 0.f;
#pragma unroll
        for (int j = 0; j < 16; ++j) { v[j] = xr[64 * j]; s += (v[j].x * v[j].x + v[j].y * v[j].y) + (v[j].z * v[j].z + v[j].w * v[j].w); }
        const float rstd = 1.0f / sqrtf(wave_sum(s) * (1.0f / DM) + EPS);
        GAS unsigned long long* o8 = (GAS unsigned long long*)(xn + (size_t)m * DM) + lane;
#pragma unroll
        for (int j = 0; j < 16; ++j) o8[64 * j] = (unsigned long long)pk2(v[j].x * rstd, v[j].y * rstd) | ((unsigned long long)pk2(v[j].z * rstd, v[j].w * rstd) << 32);
    }
}
#ifndef RS_LO
#define RS_LO(w) __uint_as_float((w) << 16)
#define RS_HI(w) __uint_as_float((w) & 0xffff0000u)
#endif
__device__ __forceinline__ void row_stats(const Frame& F, const bf16* xb, float* rstd, unsigned char* x8  ) {
    const int lane = pg8::opq_lane();
    typedef unsigned v2u __attribute__((ext_vector_type(2)));
    for (int rb = F.gw; rb < M / 16; rb += F.NGW) {
        const GAS v4u* p = (const GAS v4u*)(xb + (size_t)rb * 128 * 512) + lane; float ss = 0.f;
        GAS unsigned char* q8 = (GAS unsigned char*)x8 + ((size_t)rb * 64 * 16 + (lane >> 2)) * 64 + 8 * (lane & 3);
#pragma unroll 1
        for (int c0 = 0; c0 < 128; c0 += 16) { v4u v[16];
#pragma unroll
            for (int c = 0; c < 16; ++c) v[c] = p[(c0 + c) * 64];
#pragma unroll
            for (int c = 0; c < 16; ++c) { float f[8];
#pragma unroll
                for (int e = 0; e < 4; ++e) { f[2 * e] = RS_LO(v[c][e]); f[2 * e + 1] = RS_HI(v[c][e]); ss += f[2 * e] * f[2 * e] + f[2 * e + 1] * f[2 * e + 1]; }
                if (x8) { v2u w8;
                    w8.x = (unsigned)__builtin_amdgcn_cvt_pk_fp8_f32(f[2], f[3], __builtin_amdgcn_cvt_pk_fp8_f32(f[0], f[1], 0, false), true);
                    w8.y = (unsigned)__builtin_amdgcn_cvt_pk_fp8_f32(f[6], f[7], __builtin_amdgcn_cvt_pk_fp8_f32(f[4], f[5], 0, false), true);
                    *(GAS v2u*)(q8 + (c >> 1) * 1024 + (c & 1) * 32) = w8; } }
            q8 += 8 * 1024; }
        ss = group_sum<4>(ss);
        if ((lane & 3) == 0) rstd[rb * 16 + (lane >> 2)] = 1.0f / sqrtf(ss * (1.0f / DM) + EPS);
    }
}
__device__ __forceinline__ void xcast_blocked(const Frame& F, const float* x, bf16* xb, float* rstd, float* rsp) {
    const int lane = pg8::opq_lane();
    for (int rb = F.gw; rb < M / 16; rb += F.NGW) {
        const GAS f32x4* src = (const GAS f32x4*)(x + (size_t)(rb * 16 + (lane >> 2)) * DM + 8 * (lane & 3)); GAS v4u* dst = (GAS v4u*)(xb + (size_t)rb * 128 * 512) + lane; float ss = 0.f;
#pragma unroll 2
        for (int c0 = 0; c0 < 128; c0 += 8) { f32x4 a[8], b[8];
#pragma unroll
            for (int c = 0; c < 8; ++c) { a[c] = src[(c0 + c) * 8]; b[c] = src[(c0 + c) * 8 + 1]; }
#pragma unroll
            for (int c = 0; c < 8; ++c) { v4u w; w.x = pk2(a[c].x, a[c].y); w.y = pk2(a[c].z, a[c].w); w.z = pk2(b[c].x, b[c].y); w.w = pk2(b[c].z, b[c].w); dst[(c0 + c) * 64] = w;
#pragma unroll
                for (int e = 0; e < 4; ++e) { const float lo = __uint_as_float(w[e] << 16), hi = __uint_as_float(w[e] & 0xffff0000u); ss += lo * lo + hi * hi; } } }
        ss = group_sum<4>(ss);
        if ((lane & 3) == 0) rstd[rb * 16 + (lane >> 2)] = 1.0f / sqrtf(ss * (1.0f / DM) + EPS);
        *(GAS f32x4*)(rsp + (size_t)(rb * 16 + (lane >> 2)) * 16 + 4 * (lane & 3)) = (f32x4){(lane & 3) == 0 ? ss : 0.f, 0.f, 0.f, 0.f};
    }
}
template <int L, bool GAIN, bool ROPE, int REP, bool OUT8 = false, int U = 1  >
__device__ __forceinline__ void seg_norm(const Frame& F, const bf16* src, long src_ld, int src_ss, int spr, long nseg, bf16* dst, long dst_ld, int dst_ss, const float* gain, const float* cs, const float* sn) {
    constexpr int LPS = (L / 8 >= 64) ? 64 : L / 8, CPL = L / 8 / LPS, SPW = 64 / LPS;
    const int lane = pg8::opq_lane(), sl = lane % LPS, sg = lane / LPS;
    const long step = (long)F.NGW * SPW;
    for (long s0 = (long)F.gw * SPW; s0 < nseg; s0 += step * U) {
        bf16x8 raw[U][CPL];
#pragma unroll
        for (int u = 0; u < U; ++u) { const long seg = s0 + u * step + sg; if (seg < nseg) { const long row = seg / spr; const int si = (int)(seg % spr); const bf16* sp = src + row * src_ld + (long)si * src_ss;
#pragma unroll
            for (int c = 0; c < CPL; ++c) raw[u][c] = *(const bf16x8*)(sp + (c * LPS + sl) * 8); } }
#pragma unroll
        for (int u = 0; u < U; ++u) { const long seg = s0 + u * step + sg; if (seg >= nseg) continue;
        const long row = seg / spr; const int si = (int)(seg % spr);
        float ss = 0.f;
#pragma unroll
        for (int c = 0; c < CPL; ++c)
#pragma unroll
            for (int e = 0; e < 8; ++e) { const float f = bf2f(raw[u][c][e]); ss += f * f; }
        ss = group_sum<LPS>(ss);
        const float rstd = 1.0f / sqrtf(ss * (1.0f / L) + EPS);
        const int pos = (int)(row % SEQ);
#pragma unroll
        for (int c = 0; c < CPL; ++c) { const int e0 = (c * LPS + sl) * 8; float x[8];
#pragma unroll
            for (int e = 0; e < 8; ++e) x[e] = bf2f(raw[u][c][e]) * rstd;
            if (GAIN) { const f32x4 g0 = *(const f32x4*)(gain + e0), g1 = *(const f32x4*)(gain + e0 + 4);
#pragma unroll
                for (int e = 0; e < 4; ++e) { x[e] *= g0[e]; x[4 + e] *= g1[e]; } }
            if (ROPE) { const f32x4 cv = *(const f32x4*)(cs + (size_t)pos * (L / 2) + e0 / 2), sv = *(const f32x4*)(sn + (size_t)pos * (L / 2) + e0 / 2);
#pragma unroll
                for (int p = 0; p < 4; ++p) { const float a = x[2 * p], b = x[2 * p + 1]; x[2 * p] = a * cv[p] - b * sv[p]; x[2 * p + 1] = a * sv[p] + b * cv[p]; } }
            if constexpr (OUT8) {
                typedef unsigned v2u __attribute__((ext_vector_type(2))); v2u w8;
                w8.x = (unsigned)__builtin_amdgcn_cvt_pk_fp8_f32(x[2], x[3], __builtin_amdgcn_cvt_pk_fp8_f32(x[0], x[1], 0, false), true);
                w8.y = (unsigned)__builtin_amdgcn_cvt_pk_fp8_f32(x[6], x[7], __builtin_amdgcn_cvt_pk_fp8_f32(x[4], x[5], 0, false), true);
                unsigned char* dp = (unsigned char*)dst + row * dst_ld + (long)si * dst_ss + e0;
#pragma unroll
                for (int r = 0; r < REP; ++r) *(v2u*)(dp + (long)r * dst_ss) = w8;
            } else {
            v4u w; w.x = pk2(x[0], x[1]); w.y = pk2(x[2], x[3]); w.z = pk2(x[4], x[5]); w.w = pk2(x[6], x[7]);
            bf16* dp = dst + row * dst_ld + (long)si * dst_ss + e0;
#pragma unroll
            for (int r = 0; r < REP; ++r) *(v4u*)(dp + (long)r * dst_ss) = w; } } }
    }
}
__device__ __forceinline__ void sincos_d(float ang, float& c, float& s) {
    const double a = (double)ang, k = __builtin_rint(a * 0.63661977236758134308), r = __builtin_fma(-k, 1.57079632679489661923, a) - k * 6.123233995736766e-17, r2 = r * r;
    double sp = -7.6471637318198164759e-13; sp = sp * r2 + 1.6059043836821614599e-10; sp = sp * r2 - 2.5052108385441718775e-08; sp = sp * r2 + 2.7557319223985890653e-06; sp = sp * r2 - 1.9841269841269841270e-04;
    sp = sp * r2 + 8.3333333333333333333e-03; sp = sp * r2 - 1.6666666666666666667e-01; sp = sp * r2 * r + r;
    double cp = 4.7794773323873852974e-14; cp = cp * r2 - 1.1470745597729724714e-11; cp = cp * r2 + 2.0876756987868098979e-09; cp = cp * r2 - 2.7557319223985890653e-07; cp = cp * r2 + 2.4801587301587301587e-05;
    cp = cp * r2 - 1.3888888888888888889e-03; cp = cp * r2 + 4.1666666666666666667e-02; cp = cp * r2 - 0.5; cp = cp * r2 + 1.0;
    const int q = ((int)k) & 3;
    const double cc = (q == 0) ? cp : (q == 1) ? -sp : (q == 2) ? -cp : sp, sv = (q == 0) ? sp : (q == 1) ? cp : (q == 2) ? -sp : -cp;
    c = (float)cc; s = (float)sv;
}
__device__ __forceinline__ float inv_freq(int axis_dim, int j) {
    constexpr float FA[16] = {1.f, 0.562341332f, 0.316227764f, 0.177827939f, 0.100000001f, 0.0562341325f, 0.0316227749f, 0.0177827943f, 0.00999999978f, 0.00562341325f, 0.00316227763f, 0.00177827943f, 0.00100000005f, 0.000562341302f, 0.000316227757f, 0.00017782794f};
    constexpr float FB[32] = {1.f, 0.749894261f, 0.562341332f, 0.421696514f, 0.316227764f, 0.237137377f, 0.177827939f, 0.133352131f, 0.100000001f, 0.0749894157f, 0.0562341325f, 0.0421696529f, 0.0316227749f, 0.0237137377f, 0.0177827943f, 0.0133352149f,
                              0.00999999978f, 0.00749894185f, 0.00562341325f, 0.00421696482f, 0.00316227763f, 0.00237137359f, 0.00177827943f, 0.00133352145f, 0.00100000005f, 0.000749894243f, 0.000562341302f, 0.000421696517f, 0.000316227757f, 0.00023713737f, 0.00017782794f, 0.00013335215f};
    return axis_dim == 32 ? FA[j] : FB[j];
}

#ifndef QM_FP8
#define QM_FP8 true
#endif
#ifndef ATT_RING_A
#define ATT_RING_A true
#endif
#ifndef ATT_RING_B
#define ATT_RING_B true
#endif
#ifndef ATT_SD_A
#define ATT_SD_A 1
#endif
#ifndef ATT_SD_B
#define ATT_SD_B 1
#endif
__device__ __forceinline__ void vt_fp8(const Frame& F, const bf16* V, int ldv, int NHV, unsigned char* VT) {
    const int lane = pg8::opq_lane(), ncb = NHV * 2, nitems = (M / 64) * ncb;
    LAS unsigned char* img = F.lds + RING_OFF + F.wave * 16384; constexpr int IROW = 132;
    for (int it = F.gw; it < nitems; it += F.NGW) {
        const int kt = it / ncb, ct = it - kt * ncb, k0 = 64 * kt, c = 64 * ct + lane, b = k0 / SEQ;
        const bf16* src = V + (size_t)(k0 + (lane >> 3)) * ldv + 64 * ct + 8 * (lane & 7);
        v4u t[8];
#pragma unroll
        for (int i = 0; i < 8; ++i) t[i] = *(const GAS v4u*)(src + (size_t)(8 * i) * ldv);
#pragma unroll
        for (int i = 0; i < 8; ++i) { LAS unsigned* d = (LAS unsigned*)(img + ((lane >> 3) + 8 * i) * IROW + 16 * (lane & 7)); d[0] = t[i].x; d[1] = t[i].y; d[2] = t[i].z; d[3] = t[i].w; }
        LDS_WAIT(); asm volatile("" ::: "memory");
        float v[64];
#pragma unroll
        for (int i = 0; i < 64; ++i) v[i] = __uint_as_float((unsigned)*(const LAS unsigned short*)(img + i * IROW + 2 * lane) << 16);
        LDS_WAIT(); asm volatile("" ::: "memory");
        unsigned char* dst = VT + ((size_t)(b * NHV + (c >> 7)) * 128 + (c & 127)) * SEQ + (k0 - b * SEQ);
#pragma unroll
        for (int g = 0; g < 2; ++g) { v4u w0, w1;
#pragma unroll
            for (int d = 0; d < 4; ++d) { const int kb = 32 * g + 8 * d;
                w0[d] = (unsigned)__builtin_amdgcn_cvt_pk_fp8_f32(v[kb + 2], v[kb + 3], __builtin_amdgcn_cvt_pk_fp8_f32(v[kb], v[kb + 1], 0, false), true);
                w1[d] = (unsigned)__builtin_amdgcn_cvt_pk_fp8_f32(v[kb + 6], v[kb + 7], __builtin_amdgcn_cvt_pk_fp8_f32(v[kb + 4], v[kb + 5], 0, false), true); }
            *(v4u*)(dst + 32 * g) = w0; *(v4u*)(dst + 32 * g + 16) = w1; }
    }
}
struct QRaw { att::bf16x8 v[4]; };
__device__ __forceinline__ QRaw q_load(const bf16* p) { QRaw r;
#pragma unroll
    for (int i = 0; i < 4; ++i) r.v[i] = *(const att::bf16x8*)(p + 8 * i);
    return r; }
__device__ __forceinline__ float q_ss(const QRaw& r) { float s = 0.f;
#pragma unroll
    for (int i = 0; i < 4; ++i)
#pragma unroll
        for (int e = 0; e < 8; ++e) { const float f = bf2f(r.v[i][e]); s += f * f; }
    return s; }
template <bool ROPE> __device__ __forceinline__ att::v8i_t q_fp8(const QRaw& r, float rstd, const float* gain32, const float* cos16, const float* sin16) {
    att::v8i_t o;
#pragma unroll
    for (int i = 0; i < 4; ++i) { const f32x4 g0 = *(const f32x4*)(gain32 + 8 * i), g1 = *(const f32x4*)(gain32 + 8 * i + 4); float x[8];
#pragma unroll
        for (int e = 0; e < 4; ++e) { x[e] = bf2f(r.v[i][e]) * rstd * g0[e]; x[4 + e] = bf2f(r.v[i][4 + e]) * rstd * g1[e]; }
        if (ROPE) { const f32x4 cv = *(const f32x4*)(cos16 + 4 * i), sv = *(const f32x4*)(sin16 + 4 * i);
#pragma unroll
            for (int p = 0; p < 4; ++p) { const float a = x[2 * p], c = x[2 * p + 1]; x[2 * p] = a * cv[p] - c * sv[p]; x[2 * p + 1] = a * sv[p] + c * cv[p]; } }
        o[2 * i] = __builtin_amdgcn_cvt_pk_fp8_f32(x[2], x[3], __builtin_amdgcn_cvt_pk_fp8_f32(x[0], x[1], 0, false), true);
        o[2 * i + 1] = __builtin_amdgcn_cvt_pk_fp8_f32(x[6], x[7], __builtin_amdgcn_cvt_pk_fp8_f32(x[4], x[5], 0, false), true); }
    return o; }
__device__ __forceinline__ int opq_i(int v) { asm volatile("" : "+s"(v)); return v; }
__device__ __forceinline__ Frame make_frame(LAS unsigned char* lds, const int wv) {
    Frame F; F.lds = lds; F.lane = pg8::opq_lane(); F.wave = opq_i(wv); F.tid = F.wave * 64 + F.lane;
    F.G = opq_i((int)gridDim.x); F.bx = opq_i((int)blockIdx.x); F.vcu = (F.G % 8 == 0) ? (F.bx % 8) * (F.G / 8) + F.bx / 8 : F.bx;
    F.gw = F.vcu * NWAVES + F.wave; F.NGW = F.G * NWAVES; return F;
}
template <class Epi, bool ABLK = false, bool FP8 = false, bool BBLK = false> __device__ __forceinline__ void gemm_site(LAS unsigned char* ldsp, const int wv, const void* A, const void* Bt, int Mr, int N, int K, const Epi& E, const int sc_w = 0x7f7f7f7f, const int sc_a = 0x7f7f7f7f) {
    const Frame F = make_frame(ldsp, wv);
    pg8::Gemm g{(const pg8::bf16_t*)A, (const pg8::bf16_t*)Bt, Mr, N, K}; pg8::StaticOrder S; S.init(Mr, N, F.G, F.bx);
    pg8::gemm_phase<Epi, pg8::StaticOrder, true, true, ABLK, FP8, BBLK>(F.lds + RING_OFF, g, S, E, wv, sc_w, sc_a);
}
__device__ __forceinline__ void conv_job(const Frame& F, const Args& args, unsigned char* ws, const int job) {
            const float* W; const float* gain = nullptr; int K, N, NS, kind = 0, row_off = 0; size_t dst; bool fp8 = false;
            if (job < 24) { const int l = job / 6, t = job % 6; const size_t lo = WS_W + (size_t)l * SZ_LAYER;
                if (t == 0)      { W = args.in[3] + (size_t)l * DM * 2 * DFF; K = DM; N = 2 * DFF; dst = lo + OFF_GU1; kind = 1; gain = args.in[2] + l * DM; }
                else if (t == 1) { W = args.in[4] + (size_t)l * DFF * DM; K = DFF; N = DM; dst = lo + OFF_DN1; }
                else if (t == 2) { W = args.in[12] + (size_t)l * DM * 2 * DFF; K = DM; N = 2 * DFF; dst = lo + OFF_GU2; kind = 1; gain = args.in[11] + l * DM; }
                else if (t == 3) { W = args.in[13] + (size_t)l * DFF * DM; K = DFF; N = DM; dst = lo + OFF_DN2; }
                else if (t == 4) { W = args.in[6] + (size_t)l * DM * DM; K = DM; N = DM; dst = lo + OFF_WO; fp8 = true; }
                else             { W = args.in[8] + (size_t)l * DM * 2048; K = DM; N = 2048; dst = WS_WMEM; row_off = l * 2048; gain = args.in[7] + l * DM; }
                NS = N;
            } else { const int j = (job - 24) / 6, t = (job - 24) % 6; const size_t ao = WS_WA + (size_t)j * SZ_A;
                if (t == 0)      { W = args.in[14] + (size_t)j * DM * A_IN; K = DM; N = 1600; NS = A_IN; dst = ao; gain = args.in[5] + (2 * j) * DM; fp8 = true; }
                else if (t == 1) { W = args.in[14] + (size_t)j * DM * A_IN + 1600; K = DM; N = 1024; NS = A_IN; dst = ao + OFF_AQM; gain = args.in[5] + (2 * j) * DM; fp8 = QM_FP8; }
                else if (t == 2) { W = args.in[17] + (size_t)j * A_QL * A_QBN; K = A_QL; N = A_QBN; NS = N; dst = ao + SZ_AIN; kind = 3; gain = args.in[15] + j * A_QL; fp8 = true; }
                else if (t == 3) { W = args.in[18] + (size_t)j * A_KVL * A_KVBN; K = A_KVL; N = A_KVBN; NS = N; dst = ao + SZ_AIN + SZ_AQB; kind = 4; gain = args.in[16] + j * A_KVL; fp8 = true; }
                else if (t == 4) { W = args.in[23] + (size_t)j * DM * B_IN; K = DM; N = 4608; NS = B_IN; dst = WS_WB + (size_t)j * SZ_BIN; gain = args.in[5] + (2 * j + 1) * DM; fp8 = true; }
                else             { W = args.in[23] + (size_t)j * DM * B_IN + 4608; K = DM; N = 1024; NS = B_IN; dst = WS_WB + (size_t)j * SZ_BIN + OFF_BQM; gain = args.in[5] + (2 * j + 1) * DM; fp8 = QM_FP8; }
            }
            const float wsc = (job < 24) ? 64.0f : ((((job - 24) % 6) == 2) ? 32.0f : ((((job - 24) % 6) == 3) ? 16.0f : 64.0f));
            convert_weight_wg(F, W, K, N, NS, (bf16*)(ws + dst), kind, row_off, gain, fp8, wsc);
}
__device__ __forceinline__ void conv_slot(LAS unsigned char* ldsp, const int wv, const Args& args, unsigned char* ws, const int l, const int k) {
    if (k > 6) return;
    const Frame F = make_frame(ldsp, wv);
    const int ln = l + 1, jb = 24 + (ln >> 1) * 6;
    if (k < 3) { conv_job(F, args, ws, l * 6 + (k == 0 ? 2 : k == 1 ? 3 : 4)); }
    else if (ln >= DEPTH) return;
    else if (k < 5) { conv_job(F, args, ws, ln * 6 + (k == 3 ? 0 : 1)); }
    else if ((ln & 1) == 0) { conv_job(F, args, ws, jb + (k == 5 ? 0 : 2)); conv_job(F, args, ws, jb + (k == 5 ? 1 : 3)); }
    else { conv_job(F, args, ws, jb + (k == 5 ? 4 : 5)); }
}
__global__ void __launch_bounds__(NWAVES * 64, 2) fwd_kernel(Args args) {
    extern __shared__ __attribute__((aligned(16))) unsigned char lds[];
    LAS unsigned char* const ldsp = (LAS unsigned char*)lds;
    unsigned char* const ws = args.ws;
    const int wv = __builtin_amdgcn_readfirstlane((int)threadIdx.x >> 6);
    { const int tid = threadIdx.x; for (int u = tid; u < (LDS_BYTES - LDSCTL_OFF) / 4; u += NWAVES * 64) ((LAS unsigned*)(ldsp + LDSCTL_OFF))[u] = 0u; }
    __syncthreads();
    XcdBarrier bar = xcd_barrier_post((unsigned*)(ws + WS_CTL) + CW_BAR, (volatile LAS unsigned*)(ldsp + MISC_OFF) + 8);
#define GRID_BAR() xcd_barrier(bar)
    unsigned qep = 0u; bool qsame = false;
    const bool quad_ok = (gridDim.x == 256u);
    { const unsigned c_ = (unsigned)blockIdx.x;
      if (threadIdx.x == 0) (void)__hip_atomic_fetch_or((unsigned*)(ws + WS_CTL) + QW_BASE + 64u * (8u * (c_ & 7u) + ((c_ >> 3) & 7u)) + 16u, 1u << bar.x, __ATOMIC_RELAXED, __HIP_MEMORY_SCOPE_AGENT); }
#define QUAD_BAR() do { if (quad_ok) { ++qep; const unsigned c_ = (unsigned)opq_i((int)blockIdx.x); \
        unsigned* qw_ = (unsigned*)(WSP + WS_CTL) + QW_BASE + 64u * (8u * (c_ & 7u) + ((c_ >> 3) & 7u)); \
        quad_barrier(qw_, (unsigned*)(WSP + WS_CTL) + CW_BAR, qep, qsame); } else GRID_BAR(); } while (0)
#define WSP (opq_ptr(ws))
#define OUTP ((float*)opq_ptr((unsigned char*)args.out))

#ifdef PROBE_PRO
    for (int rep_ = 0; rep_ < 2; ++rep_)
#endif
    {
        const Frame F = make_frame(ldsp, wv);
#ifdef PROBE_CONV
        for (int rep2_ = 0; rep2_ < 2; ++rep2_)
#endif
        for (int job = 0; job < 36; ++job) {
            if (!((job < 24 && ((job < 2 && F.G <= 64) || job % 6 == 5)) || (job >= 24 && job < 28))) continue;
            conv_job(F, args, ws, job);
        }
        { float* par = (float*)(ws + WS_PAR);
          for (int i = F.gw * 64 + F.lane; i < PAR_N; i += F.NGW * 64) {
              float v;
              if (i < PAR_QN) v = args.in[9][i]; else if (i < PAR_QP) v = args.in[19][i - PAR_QN]; else if (i < PAR_KN) v = args.in[20][i - PAR_QP]; else if (i < PAR_KP) v = args.in[21][i - PAR_KN];
              else if (i < PAR_BQ) v = args.in[22][i - PAR_KP]; else if (i < PAR_BK) v = args.in[24][i - PAR_BQ]; else v = args.in[25][i - PAR_BK];
              par[i] = v; } }
        { float* cA = (float*)(ws + WS_COSA); float* sA = (float*)(ws + WS_SINA); float* cB = (float*)(ws + WS_COSB); float* sB = (float*)(ws + WS_SINB);
          for (int i = F.gw * 64 + F.lane; i < SEQ * 32; i += F.NGW * 64) { const int t = i >> 5, p = i & 31; const float pos = (float)(p < 16 ? (t >> 6) : (t & 63)); float c, s; sincos_d(pos * inv_freq(32, p & 15), c, s); cA[i] = c; sA[i] = s; }
          for (int i = F.gw * 64 + F.lane; i < SEQ * 64; i += F.NGW * 64) { const int t = i >> 6, p = i & 63; const float pos = (float)(p < 32 ? (t >> 6) : (t & 63)); float c, s; sincos_d(pos * inv_freq(64, p & 31), c, s); cB[i] = c; sB[i] = s; } }
        xnorm_rows(F, args.in[1], (bf16*)(ws + WS_MEMN), MEMR);
        xcast_blocked(F, args.in[0], (bf16*)(ws + WS_XN), (float*)(ws + WS_RSTD), (float*)(ws + WS_RSP));
    }
    GRID_BAR();
    { const unsigned c_ = (unsigned)blockIdx.x; qsame = __builtin_popcount(xb_ld((unsigned*)(ws + WS_CTL) + QW_BASE + 64u * (8u * (c_ & 7u) + ((c_ >> 3) & 7u)) + 16u)) == 1; }
    { const Frame F = make_frame(ldsp, wv);
      if (F.G > 64 && F.bx >= 64) { Frame Fc = F; Fc.vcu = F.bx - 64; Fc.G = F.G - 64; conv_job(Fc, args, ws, 0); conv_job(Fc, args, ws, 1); } }
    { unsigned char* const w = WSP; typedef pg8::EpiBf16One<WS_MEMKV, 8192> EpiT; const EpiT E{w, nullptr, nullptr};
      gemm_site<EpiT>(ldsp, wv, w + WS_MEMN, w + WS_WMEM, MEMR, 8192, DM, E); }
    GRID_BAR();
    {
        const Frame F = make_frame(ldsp, wv); unsigned char* const w = WSP;
        for (int l = 0; l < DEPTH; ++l)
            seg_norm<256, true, false, 1>(F, (const bf16*)(w + WS_MEMKV) + l * 2048, 8192, 256, 4, (long)MEMR * 4, (bf16*)(w + WS_MK) + (size_t)l * MEMR * 1024, 1024, 256, args.in[10] + l * MEMHD, nullptr, nullptr);
        const bf16* mkv = (const bf16*)(w + WS_MEMKV); bf16* vt = (bf16*)(w + WS_MVT);
        for (int i = F.gw * 64 + F.lane; i < DEPTH * BATCH * 4 * 256 * 32; i += F.NGW * 64) {
            const int col = i & 255, kc = (i >> 8) & 31, mh = (i >> 13) & 3, b = (i >> 15) & 1, l = i >> 16;
            const bf16* sp = mkv + (size_t)(b * 256 + kc * 8) * 8192 + l * 2048 + 1024 + mh * 256 + col;
            v4u o; o.x = (unsigned)sp[0] | ((unsigned)sp[8192] << 16); o.y = (unsigned)sp[2 * 8192] | ((unsigned)sp[3 * 8192] << 16); o.z = (unsigned)sp[4 * 8192] | ((unsigned)sp[5 * 8192] << 16); o.w = (unsigned)sp[6 * 8192] | ((unsigned)sp[7 * 8192] << 16);
            *(v4u*)(vt + ((size_t)((l * 2 + b) * 4 + mh) * 256 + col) * 256 + kc * 8) = o; }
    }

    for (int l = 0; l < DEPTH; ++l) {
        const size_t wl_off = WS_W + (size_t)l * SZ_LAYER;
#define isA ((opq_i(l) & 1) == 0)
#define j (opq_i(l) >> 1)
        for (int f = 0; f < 2; ++f) {
#ifdef PROBE_GU
            for (int rep_ = 0; rep_ < (f == 0 ? 2 : 1); ++rep_)
#endif
            { unsigned char* const w = WSP; const pg8::EpiSwiGLU E{(pg8::bf16_t*)(w + WS_H), DFF, (const float*)(w + WS_RSP), (LAS float*)(ldsp + EPI_RS_OFF)};
              gemm_site<pg8::EpiSwiGLU, true>(ldsp, wv, w + WS_XN, w + wl_off + (f ? OFF_GU2 : OFF_GU1), M, 2 * DFF, DM, E);
            QUAD_BAR(); }
            if (opq_i(l) == DEPTH - 1 && opq_i(f) == 1) {
                unsigned char* const w = WSP; const pg8::EpiResidOut E{(const pg8::bf16_t*)(w + WS_XN), OUTP, DM, 0.5f};
                gemm_site<pg8::EpiResidOut, true>(ldsp, wv, w + WS_H, w + wl_off + OFF_DN2, M, DM, DFF, E);
                continue;
            }
            { unsigned char* const w = WSP; const pg8::EpiResidB E{(pg8::bf16_t*)(w + WS_XN), 0.5f, (float*)(w + WS_RSP), (LAS float*)(ldsp + EPI_RED_OFF), opq_i(f) == 0 ? w + WS_X8 : nullptr};
              gemm_site<pg8::EpiResidB, true>(ldsp, wv, w + WS_H, w + wl_off + (f ? OFF_DN2 : OFF_DN1), M, DM, DFF, E); }
            if (opq_i(f) != 0 || isA) QUAD_BAR(); else GRID_BAR();
            if (opq_i(f) != 0) continue;
#ifdef PROBE_WIN
            for (int rep_ = 0; rep_ < 2; ++rep_)
#endif
            {
                unsigned char* const w = WSP; const float* const rs = (const float*)(w + WS_RSP); LAS float* const rl = (LAS float*)(ldsp + EPI_RS_OFF);
                typedef pg8::EpiBf16Seg<true, (1 << 30), (1 << 30), (1 << 30), WS_QM, 0, 0, 0, 1024, 0, 0, 0> EpiQM;
                typedef pg8::EpiBf16Seg<true, 4, (1 << 30), (1 << 30), WS_CQ, WS_CKV, 0, 0, 1024, 768, 0, 0> EpiA; typedef pg8::EpiBf16Seg<true, 12, 15, (1 << 30), WS_QB, WS_KBR, WS_VB, 0, 3072, 768, 768, 0> EpiB;
                { const EpiQM E{w, rs, rl}; if constexpr (QM_FP8) gemm_site<EpiQM, true, true>(ldsp, wv, w + WS_X8, isA ? w + WS_WA + (size_t)j * SZ_A + OFF_AQM : w + WS_WB + (size_t)j * SZ_BIN + OFF_BQM, M, 1024, DM / 2, E, 0x79797979);
                  else gemm_site<EpiQM, true>(ldsp, wv, w + WS_XN, isA ? w + WS_WA + (size_t)j * SZ_A + OFF_AQM : w + WS_WB + (size_t)j * SZ_BIN + OFF_BQM, M, 1024, DM, E); }
                if (isA) { typedef pg8::EpiA8<WS_CQN, WS_CKVN, WS_CKV, 768, 512, WS_RSP, WS_RSPA, EPI_RED_OFF, EPI_RS_OFF> EpiA8; const EpiA8 E{w, ldsp};
                           gemm_site<EpiA8, true, true>(ldsp, wv, w + WS_X8, w + WS_WA + (size_t)j * SZ_A, M, 1792, DM / 2, E, 0x79797979); }
                else { unsigned char* const wb = w + WS_WB + (size_t)j * SZ_BIN;
                    typedef pg8::EpiKNR8<128, WS_QB, TOKW, WS_COSB, WS_SINB, SEQ, WS_RSP, WSL_OFF, WSL_OFF + 8192> EpiBQ; typedef pg8::EpiKNR8<128, WS_KB, B_KW, WS_COSB, WS_SINB, SEQ, WS_RSP, WSL_OFF, WSL_OFF + 8192> EpiBK; typedef pg8::EpiVT8<B_KVH * 128, SEQ, WS_VT8B, true, WS_RSP, EPI_RS_OFF> EpiBV;
                    { const EpiBQ E{w, (const float*)(w + WS_PAR) + PAR_BQ + j * 128, ldsp, att::Cfg<128>::SCALE * 1.4426950408889634f};
                      gemm_site<EpiBQ, true, true>(ldsp, wv, w + WS_X8, wb, M, 3072, DM / 2, E, 0x79797979); }
                    { const EpiBK E{w, (const float*)(w + WS_PAR) + PAR_BK + j * 128, ldsp, 1.0f};
                      gemm_site<EpiBK, true, true>(ldsp, wv, w + WS_X8, wb + (size_t)3072 * DM, M, B_KW, DM / 2, E, 0x79797979); }
                    { const EpiBV E{w, ldsp};
                      gemm_site<EpiBV, false, true, true>(ldsp, wv, wb + (size_t)3840 * DM, w + WS_X8, B_KW, M, DM / 2, E, 0x7f7f7f7f, 0x79797979); } }
            GRID_BAR(); }
            if (isA) {
#ifdef PROBE_ELT
                for (int rep_ = 0; rep_ < 2; ++rep_)
#endif
                {
                    const Frame F = make_frame(ldsp, wv); unsigned char* const w = WSP;
                    seg_norm<64, true, true, 24, true>(F, (const bf16*)(w + WS_CKV) + 512, 768, 0, 1, M, (bf16*)(w + WS_K192 + 128), A_KW, 192, (const float*)(w + WS_PAR) + PAR_KP + j * 64, (const float*)(w + WS_COSA), (const float*)(w + WS_SINA)); }
#ifdef PROBE_QKVB
                for (int rep_ = 0; rep_ < 2; ++rep_) {
#endif
                { unsigned char* const w = WSP; typedef pg8::EpiQA8<WS_QA, A_QBN, WS_COSA, WS_SINA, SEQ, WS_RSPA, WSL_OFF, WSL_OFF + 8192> EpiT;
                  const EpiT E{w, (const float*)(w + WS_PAR) + PAR_QN + j * 128, (const float*)(w + WS_PAR) + PAR_QP + j * 64, ldsp, att::Cfg<192>::SCALE * 1.4426950408889634f};
                  gemm_site<EpiT, false, true>(ldsp, wv, w + WS_CQN, w + WS_WA + (size_t)j * SZ_A + SZ_AIN, M, A_QBN, A_QL / 2, E, 0x7a7a7a7a); }
                { unsigned char* const w = WSP; typedef pg8::EpiKN8<192, true, 4, 2, 512> EpiT; const EpiT E{w + WS_K192, A_KW, (const float*)(w + WS_PAR) + PAR_KN + j * 128, (LAS float*)(ldsp + WSL_OFF), (const float*)(w + WS_RSPA), (LAS float*)(ldsp + WSL_OFF + 8192)};
                  gemm_site<EpiT, false, true>(ldsp, wv, w + WS_CKVN, w + WS_WA + (size_t)j * SZ_A + SZ_AIN + SZ_AQB, M, 3072, A_KVL / 2, E, 0x7b7b7b7b); }
                { unsigned char* const w = WSP; typedef pg8::EpiVT8<NH * 128, SEQ, WS_VT8A, true, WS_RSPA, EPI_RS_OFF, 4, 2, 512> EpiT; const EpiT E{w, ldsp};
                  gemm_site<EpiT, false, true>(ldsp, wv, w + WS_WA + (size_t)j * SZ_A + SZ_AIN + SZ_AQB + (size_t)3072 * A_KVL, w + WS_CKVN, NH * 128, M, A_KVL / 2, E, 0x7f7f7f7f, 0x7b7b7b7b); }
                GRID_BAR();
#ifdef PROBE_QKVB
                }
#endif
            }
            int ks = 0; const int kpos = opq_i((int)blockIdx.x) % 7;
            if (isA) {
                const Frame F0 = make_frame(ldsp, wv);
                for (int u = F0.vcu; u < BATCH * NH * (SEQ / 256); u += F0.G) {
                    const Frame F = make_frame(ldsp, wv); const int r32 = F.lane & 31, hi = F.lane >> 5;
                    unsigned char* const w = WSP;
                    const int bh = u >> 5, qb = u & 31, b = bh / NH, h = bh % NH;
                    const long row = (long)b * SEQ + qb * 256 + F.wave * 32 + r32;
                    const unsigned char* qrow = (const unsigned char*)(w + WS_QA) + row * A_QBN + h * 192 + 32 * hi;
                    att::v8i_t qr[3];
#pragma unroll
                    for (int s = 0; s < 3; ++s) { const v4u a = *(const GAS v4u*)(qrow + 64 * s), c = *(const GAS v4u*)(qrow + 64 * s + 16);
                        qr[s] = (att::v8i_t){(int)a.x, (int)a.y, (int)a.z, (int)a.w, (int)c.x, (int)c.y, (int)c.z, (int)c.w}; }
                    att::attn_unit<192, ATT_SD_A, ATT_RING_A>(qr, (const unsigned char*)(w + WS_K192) + (size_t)b * SEQ * A_KW + h * 192, A_KW, (const unsigned char*)(w + WS_VT8A) + (size_t)(b * NH + h) * 128 * SEQ, SEQ,
                                                  (unsigned char*)(w + WS_O) + ((size_t)b * SEQ + qb * 256) * DM + h * 128, DM, SEQ, (char*)lds + RING_OFF, wv);
                    if (ks == kpos) { for (int k2 = 0; k2 < 7; ++k2) conv_slot(ldsp, wv, args, WSP, opq_i(l), k2); } ++ks;
                }
            } else {
                const Frame F0 = make_frame(ldsp, wv);
                for (int u = F0.vcu; u < BATCH * NH * (SEQ / 256); u += F0.G) {
                    const Frame F = make_frame(ldsp, wv); const int r32 = F.lane & 31, hi = F.lane >> 5;
                    unsigned char* const w = WSP;
                    const int bh = u >> 5, qb = u & 31, b = bh / NH, h = bh % NH;
                    const long row = (long)b * SEQ + qb * 256 + F.wave * 32 + r32;
                    const unsigned char* qrow = (const unsigned char*)(w + WS_QB) + row * TOKW + h * 128 + 32 * hi;
                    att::v8i_t qr[2];
#pragma unroll
                    for (int s = 0; s < 2; ++s) { const v4u a = *(const GAS v4u*)(qrow + 64 * s), c = *(const GAS v4u*)(qrow + 64 * s + 16);
                        qr[s] = (att::v8i_t){(int)a.x, (int)a.y, (int)a.z, (int)a.w, (int)c.x, (int)c.y, (int)c.z, (int)c.w}; }
                    const int kvh = h >> 2;
                    att::attn_unit<128, ATT_SD_B, ATT_RING_B>(qr, (const unsigned char*)(w + WS_KB) + (size_t)b * SEQ * B_KW + kvh * 128, B_KW, (const unsigned char*)(w + WS_VT8B) + (size_t)(b * B_KVH + kvh) * 128 * SEQ, SEQ,
                                                  (unsigned char*)(w + WS_O) + ((size_t)b * SEQ + qb * 256) * DM + h * 128, DM, SEQ, (char*)lds + RING_OFF, wv);
                    if (ks == kpos) { for (int k2 = 0; k2 < 7; ++k2) conv_slot(ldsp, wv, args, WSP, opq_i(l), k2); } ++ks;
                }
            }
            __syncthreads();
#ifdef PROBE_MEM
            for (int rep_ = 0; rep_ < 2; ++rep_)
#endif
            {
                const Frame F0 = make_frame(ldsp, wv);
                for (int u = F0.vcu; u < BATCH * 4 * (SEQ / 256); u += F0.G) {
                    unsigned char* const w = WSP;
                    const int bm = u >> 5, qb = u & 31, b = bm >> 2, mh = bm & 3;
                    att::mem_attn_unit((const att::bf16_t*)(w + WS_QM) + ((size_t)b * SEQ + qb * 256) * MEMW + mh * 256, MEMW, (const float*)(w + WS_PAR) + PAR_MQ + l * MEMHD, EPS,
                                       (const att::bf16_t*)(w + WS_MK) + ((size_t)l * MEMR + b * 256) * 1024 + mh * 256, 1024, (const att::bf16_t*)(w + WS_MVT) + (size_t)((l * 2 + b) * 4 + mh) * 65536,
                                       (unsigned char*)(w + WS_O) + ((size_t)b * SEQ + qb * 256) * DM + TOKW + mh * 256, DM, (char*)lds + RING_OFF, (float*)((char*)lds + WSL_OFF), wv);
                    if (ks == kpos) { for (int k2 = 0; k2 < 7; ++k2) conv_slot(ldsp, wv, args, WSP, opq_i(l), k2); } ++ks;
                }
                if (ks <= kpos) { for (int k2 = 0; k2 < 7; ++k2) conv_slot(ldsp, wv, args, WSP, opq_i(l), k2); }
            }
            GRID_BAR();
            { unsigned char* const w = WSP; const pg8::EpiResidB E{(pg8::bf16_t*)(w + WS_XN), 1.0f, (float*)(w + WS_RSP), (LAS float*)(ldsp + EPI_RED_OFF), nullptr};
              gemm_site<pg8::EpiResidB, false, true>(ldsp, wv, w + WS_O, w + wl_off + OFF_WO, M, DM, DM / 2, E, 0x79797979, 0x79797979); }
            QUAD_BAR();
        }
    }
#undef isA
#undef j
#undef GRID_BAR
#undef QUAD_BAR
#undef WSP
#undef OUTP
}

extern "C" void kernel_launch(void* const* d_in, const int* in_sizes, int n_in, void* d_out, int out_size, void* d_ws, size_t ws_size, hipStream_t stream) {
    static int grid = 0;
    if (grid == 0) {
        if (n_in != 26 || in_sizes[0] != M * DM || out_size != M * DM || ws_size < WS_END) { fprintf(stderr, "kernel_launch: unexpected shapes (n_in %d, in0 %d, out %d, ws %zu, need %zu); nothing launched\n", n_in, n_in > 0 ? in_sizes[0] : -1, out_size, ws_size, (size_t)WS_END); grid = -1; return; }
        int dev = 0, cus = 0, per_cu = 0;
        if (hipGetDevice(&dev) != hipSuccess || hipDeviceGetAttribute(&cus, hipDeviceAttributeMultiprocessorCount, dev) != hipSuccess) { grid = -1; return; }
        if (hipFuncSetAttribute((const void*)fwd_kernel, hipFuncAttributeMaxDynamicSharedMemorySize, LDS_BYTES) != hipSuccess) { fprintf(stderr, "kernel_launch: hipFuncSetAttribute failed\n"); grid = -1; return; }
        if (hipOccupancyMaxActiveBlocksPerMultiprocessor(&per_cu, (const void*)fwd_kernel, NWAVES * 64, LDS_BYTES) != hipSuccess || per_cu < 1) fprintf(stderr, "kernel_launch: occupancy query says %d\n", per_cu);
        (void)hipGetLastError();
        grid = cus;
    }
    if (grid < 0) return;
    if (hipMemsetAsync((char*)d_ws + WS_CTL, 0, CTL_ZERO_BYTES, stream) != hipSuccess) return;
    Args a{};
    for (int i = 0; i < 26; ++i) a.in[i] = (const float*)d_in[i];
    a.out = (float*)d_out; a.ws = (unsigned char*)d_ws;
    hipLaunchKernelGGL(fwd_kernel, dim3(grid), dim3(NWAVES * 64), LDS_BYTES, stream, a);
    const hipError_t le = hipPeekAtLastError();
    if (le != hipSuccess) fprintf(stderr, "kernel_launch: launch failed: %s\n", hipGetErrorName(le));
}
```
